# Optimizing an MI355X kernel written in HIP

```python
import math
import jax
import jax.numpy as jnp
from jax import lax
import numpy as np

D_MODEL = 1024
BATCH = 8
SEQ = 4096
DEPTH = 1

CHUNK = 64
Q_BLOCK = 128
A_HEADS = 4
A_HEAD_DIM = 64
A_WIDTH = A_HEADS * 2 * A_HEAD_DIM
B_HEADS = 8
B_HEAD_DIM = 64
B_WIDTH = B_HEADS * B_HEAD_DIM
B_PAST_CHUNKS = 8
B_BAND = B_PAST_CHUNKS + 1
REL_CLIP = 256
MIX_WIDTH = A_WIDTH + B_WIDTH
N_EXPERTS = 32
TOP_K = 4
D_FF_EXPERT = D_MODEL
SWIGLU_ALPHA = 1.702
SWIGLU_LIMIT = 7.0
MOE_BLOCK = 512
LN_EPS = 1e-5
RMS_EPS = 1e-5
DEEPNORM_ALPHA = (2 * DEPTH) ** 0.25
DEEPNORM_BETA = (8 * DEPTH) ** -0.25

kernel_name = 'hybrid_diffattn_chunkband_moe_deepnorm'


def layer_norm(x, g, b):
    xf = x.astype(jnp.float32)
    mu = jnp.mean(xf, axis=-1, keepdims=True)
    var = jnp.mean(jnp.square(xf - mu), axis=-1, keepdims=True)
    y = (xf - mu) * lax.rsqrt(var + LN_EPS) * g.astype(jnp.float32) + b.astype(jnp.float32)
    return y.astype(x.dtype)


def rms_norm(x, g):
    xf = x.astype(jnp.float32)
    y = xf * lax.rsqrt(jnp.mean(jnp.square(xf), axis=-1, keepdims=True) + RMS_EPS) * g.astype(jnp.float32)
    return y.astype(x.dtype)


def alibi_slopes():
    return jnp.exp2(-8.0 * jnp.arange(1, A_HEADS + 1, dtype=jnp.float32) / A_HEADS)


def diff_attention(q, k, v, lam, subln_g, lam_init):
    bsz, seq = q.shape[0], q.shape[1]
    nb = seq // Q_BLOCK
    scale = A_HEAD_DIM ** -0.5
    slopes = alibi_slopes()
    kpos = jnp.arange(seq)
    qb = jnp.moveaxis(q.reshape(bsz, nb, Q_BLOCK, A_HEADS, 2, A_HEAD_DIM), 1, 0)

    def block(args):
        q_blk, bi = args
        qpos = bi * Q_BLOCK + jnp.arange(Q_BLOCK)
        dist = jnp.abs(qpos[:, None] - kpos[None, :]).astype(jnp.float32)
        allowed = (kpos[None, :] // CHUNK) <= (qpos[:, None] // CHUNK)
        alibi = -slopes[:, None, None] * dist[None]
        s = jnp.einsum('bqhmd,bkhmd->bhmqk', q_blk, k, preferred_element_type=jnp.float32) * scale
        s = jnp.where(allowed, s + alibi[None, :, None], -jnp.inf)
        p = jax.nn.softmax(s, axis=-1)
        a = p[:, :, 0] - lam * p[:, :, 1]
        return jnp.einsum('bhqk,bkhe->bqhe', a.astype(v.dtype), v)

    o = lax.map(block, (qb, jnp.arange(nb)))
    o = jnp.moveaxis(o, 0, 1).reshape(bsz, seq, A_HEADS, 2 * A_HEAD_DIM)
    o = rms_norm(o, subln_g) * (1.0 - lam_init)
    return o.reshape(bsz, seq, A_WIDTH)


def chunk_band_attention(q, k, v, rel_bias):
    bsz, seq = q.shape[0], q.shape[1]
    nc = seq // CHUNK
    band = B_BAND * CHUNK
    scale = B_HEAD_DIM ** -0.5
    qc = q.reshape(bsz, nc, CHUNK, B_HEADS, B_HEAD_DIM)
    pad = ((0, 0), (B_PAST_CHUNKS, 0), (0, 0), (0, 0), (0, 0))
    kc = jnp.pad(k.reshape(bsz, nc, CHUNK, B_HEADS, B_HEAD_DIM), pad)
    vc = jnp.pad(v.reshape(bsz, nc, CHUNK, B_HEADS, B_HEAD_DIM), pad)
    band_idx = jnp.arange(nc)[:, None] + jnp.arange(B_BAND)[None, :]
    kb = kc[:, band_idx].reshape(bsz, nc, band, B_HEADS, B_HEAD_DIM)
    vb = vc[:, band_idx].reshape(bsz, nc, band, B_HEADS, B_HEAD_DIM)
    qi = jnp.arange(CHUNK)
    kj = jnp.arange(band)
    rel = qi[:, None] + B_PAST_CHUNKS * CHUNK - kj[None, :]
    rel_idx = jnp.clip(rel, -REL_CLIP, REL_CLIP) + REL_CLIP
    bias = rel_bias[:, rel_idx].astype(jnp.float32)
    valid = (jnp.arange(nc)[:, None] - B_PAST_CHUNKS + kj[None, :] // CHUNK) >= 0
    s = jnp.einsum('bcqhd,bckhd->bhcqk', qc, kb, preferred_element_type=jnp.float32) * scale
    s = jnp.where(valid[None, None, :, None, :], s + bias[:, None], -jnp.inf)
    p = jax.nn.softmax(s, axis=-1)
    o = jnp.einsum('bhcqk,bckhd->bcqhd', p.astype(v.dtype), vb)
    return o.reshape(bsz, seq, B_WIDTH)


def moe_ffn(h, router_w, router_b, w1, b1, w2, b2):
    bsz, seq, d = h.shape
    t = h.reshape(-1, d)
    n_tok = t.shape[0]
    logits = jnp.einsum('td,de->te', t, router_w, preferred_element_type=jnp.float32) + router_b.astype(jnp.float32)
    top_logits, top_idx = lax.top_k(logits, TOP_K)
    gates = jax.nn.softmax(top_logits, axis=-1)
    m = n_tok * TOP_K
    flat_e = top_idx.reshape(m)
    order = jnp.argsort(flat_e)
    sorted_e = flat_e[order]
    counts = jnp.zeros((N_EXPERTS,), jnp.int32).at[flat_e].add(1)
    padded = (counts + MOE_BLOCK - 1) // MOE_BLOCK * MOE_BLOCK
    start = jnp.cumsum(counts) - counts
    pend = jnp.cumsum(padded)
    pstart = pend - padded
    dest = pstart[sorted_e] + jnp.arange(m) - start[sorted_e]
    n_blocks = -(-m // MOE_BLOCK) + N_EXPERTS
    n_slots = n_blocks * MOE_BLOCK
    slot_token = jnp.full((n_slots,), n_tok, jnp.int32).at[dest].set((order // TOP_K).astype(jnp.int32))
    slot_gate = jnp.zeros((n_slots,), jnp.float32).at[dest].set(gates.reshape(m)[order])
    block_expert = jnp.minimum(jnp.searchsorted(pend, jnp.arange(n_blocks) * MOE_BLOCK, side='right'), N_EXPERTS - 1)
    t_pad = jnp.concatenate([t, jnp.zeros((1, d), t.dtype)], axis=0)
    xs = t_pad[slot_token].reshape(n_blocks, MOE_BLOCK, d)

    def expert_block(args):
        xb, e = args
        hid = xb @ w1[e] + b1[e]
        x_glu = jnp.minimum(hid[:, ::2], SWIGLU_LIMIT)
        x_lin = jnp.clip(hid[:, 1::2], -SWIGLU_LIMIT, SWIGLU_LIMIT)
        act = x_glu * jax.nn.sigmoid(SWIGLU_ALPHA * x_glu) * (x_lin + 1.0)
        return act @ w2[e] + b2[e]

    ys = lax.map(expert_block, (xs, block_expert)).reshape(n_slots, d)
    y = jax.ops.segment_sum(ys * slot_gate[:, None].astype(ys.dtype), slot_token, num_segments=n_tok + 1)[:n_tok]
    return y.reshape(bsz, seq, d)


def setup_inputs(seed: int = 0) -> dict:
    key = jax.random.key(seed)
    ks = jax.random.split(key, 24)
    nrm = jax.random.normal
    f32 = jnp.float32
    x = nrm(ks[0], (BATCH, SEQ, D_MODEL), f32)
    ln_in_g = 1.0 + 0.02 * nrm(ks[1], (D_MODEL,), f32)
    ln_in_b = 0.02 * nrm(ks[2], (D_MODEL,), f32)
    beta = DEEPNORM_BETA
    col_scale = jnp.concatenate([
        jnp.ones((2 * A_WIDTH,), f32), jnp.full((A_WIDTH,), beta, f32),
        jnp.ones((2 * B_WIDTH,), f32), jnp.full((B_WIDTH,), beta, f32)])
    w_in = nrm(ks[3], (DEPTH, D_MODEL, 3 * MIX_WIDTH), f32) * D_MODEL ** -0.5 * col_scale
    lambda_q1 = 0.1 * nrm(ks[4], (DEPTH, A_HEAD_DIM), f32)
    lambda_k1 = 0.1 * nrm(ks[5], (DEPTH, A_HEAD_DIM), f32)
    lambda_q2 = 0.1 * nrm(ks[6], (DEPTH, A_HEAD_DIM), f32)
    lambda_k2 = 0.1 * nrm(ks[7], (DEPTH, A_HEAD_DIM), f32)
    subln_g = 1.0 + 0.02 * nrm(ks[8], (DEPTH, 2 * A_HEAD_DIM), f32)
    rel_bias = 0.1 * nrm(ks[9], (DEPTH, B_HEADS, 2 * REL_CLIP + 1), f32)
    w_out = nrm(ks[10], (DEPTH, MIX_WIDTH, D_MODEL), f32) * MIX_WIDTH ** -0.5 * beta
    ln1_g = 1.0 + 0.02 * nrm(ks[11], (DEPTH, D_MODEL), f32)
    ln1_b = 0.02 * nrm(ks[12], (DEPTH, D_MODEL), f32)
    router_w = nrm(ks[13], (DEPTH, D_MODEL, N_EXPERTS), f32) * D_MODEL ** -0.5
    router_b = 0.01 * nrm(ks[14], (DEPTH, N_EXPERTS), f32)
    w1 = nrm(ks[15], (DEPTH, N_EXPERTS, D_MODEL, 2 * D_FF_EXPERT), f32) * D_MODEL ** -0.5
    b1 = 0.01 * nrm(ks[16], (DEPTH, N_EXPERTS, 2 * D_FF_EXPERT), f32)
    w2 = nrm(ks[17], (DEPTH, N_EXPERTS, D_FF_EXPERT, D_MODEL), f32) * D_FF_EXPERT ** -0.5 * beta
    b2 = 0.01 * nrm(ks[18], (DEPTH, N_EXPERTS, D_MODEL), f32)
    ln2_g = 1.0 + 0.02 * nrm(ks[19], (DEPTH, D_MODEL), f32)
    ln2_b = 0.02 * nrm(ks[20], (DEPTH, D_MODEL), f32)
    return {'x': x, 'ln_in_g': ln_in_g, 'ln_in_b': ln_in_b, 'w_in': w_in,
            'lambda_q1': lambda_q1, 'lambda_k1': lambda_k1, 'lambda_q2': lambda_q2, 'lambda_k2': lambda_k2,
            'subln_g': subln_g, 'rel_bias': rel_bias, 'w_out': w_out, 'ln1_g': ln1_g, 'ln1_b': ln1_b,
            'router_w': router_w, 'router_b': router_b, 'w1': w1, 'b1': b1, 'w2': w2, 'b2': b2,
            'ln2_g': ln2_g, 'ln2_b': ln2_b}


def reference(x, ln_in_g, ln_in_b, w_in, lambda_q1, lambda_k1, lambda_q2, lambda_k2, subln_g, rel_bias,
              w_out, ln1_g, ln1_b, router_w, router_b, w1, b1, w2, b2, ln2_g, ln2_b):
    bsz, seq, _ = x.shape
    f32 = jnp.float32
    split_at = [A_WIDTH, 2 * A_WIDTH, 3 * A_WIDTH, 3 * A_WIDTH + B_WIDTH, 3 * A_WIDTH + 2 * B_WIDTH]
    h = layer_norm(x, ln_in_g, ln_in_b)
    for l in range(DEPTH):
        lam_init = 0.8 - 0.6 * math.exp(-0.3 * l)
        lam = (jnp.exp(jnp.sum(lambda_q1[l].astype(f32) * lambda_k1[l].astype(f32)))
               - jnp.exp(jnp.sum(lambda_q2[l].astype(f32) * lambda_k2[l].astype(f32))) + lam_init)
        proj = jnp.einsum('bsd,de->bse', h, w_in[l])
        a_q, a_k, a_v, b_q, b_k, b_v = jnp.split(proj, split_at, axis=-1)
        o_a = diff_attention(a_q.reshape(bsz, seq, A_HEADS, 2, A_HEAD_DIM),
                             a_k.reshape(bsz, seq, A_HEADS, 2, A_HEAD_DIM),
                             a_v.reshape(bsz, seq, A_HEADS, 2 * A_HEAD_DIM),
                             lam, subln_g[l], lam_init)
        o_b = chunk_band_attention(b_q.reshape(bsz, seq, B_HEADS, B_HEAD_DIM),
                                   b_k.reshape(bsz, seq, B_HEADS, B_HEAD_DIM),
                                   b_v.reshape(bsz, seq, B_HEADS, B_HEAD_DIM),
                                   rel_bias[l])
        mix = jnp.einsum('bse,ed->bsd', jnp.concatenate([o_a, o_b], axis=-1), w_out[l])
        h = layer_norm(DEEPNORM_ALPHA * h + mix, ln1_g[l], ln1_b[l])
        ffn = moe_ffn(h, router_w[l], router_b[l], w1[l], b1[l], w2[l], b2[l])
        h = layer_norm(DEEPNORM_ALPHA * h + ffn, ln2_g[l], ln2_b[l])
    return h
```

```cpp
#include <hip/hip_runtime.h>
#include <cstdint>
#include <cstdio>

typedef unsigned short u16;
typedef short bf16x8 __attribute__((ext_vector_type(8)));
typedef float f32x4 __attribute__((ext_vector_type(4)));
typedef unsigned u32x4 __attribute__((ext_vector_type(4)));
typedef unsigned u32x2 __attribute__((ext_vector_type(2)));
#define LAS __attribute__((address_space(3)))

constexpr int NTOK = 32768, DM = 1024, SEQ = 4096, NBATCH = 8;
constexpr int QKVP = 3072;
constexpr int NEXP = 32;
constexpr float LOG2E = 1.4426950408889634f;
constexpr float QSCALE = 0.125f * LOG2E;
constexpr float DN_ALPHA = 1.189207115002721f;
constexpr float LN_EPS = 1e-5f;

constexpr size_t MiB = 1u << 20;
constexpr size_t WS_CTL = 0, CTL_BYTES = 1 * MiB;
constexpr size_t WS_WIN = 2 * MiB, WS_WOUT = 8 * MiB, WS_W1 = 16 * MiB, WS_W2 = 144 * MiB;
constexpr size_t WS_H1 = 208 * MiB, WS_LIST = 272 * MiB, WS_GATE = 276 * MiB;
constexpr size_t WS_H0 = 280 * MiB, WS_QKV = 344 * MiB, WS_O = 536 * MiB, WS_U = 344 * MiB, WS_ACT = 280 * MiB;
constexpr size_t WS_YS = 600 * MiB, WS_END = 856 * MiB;

__device__ __forceinline__ float bf2f(u16 v) { return __uint_as_float((unsigned)v << 16); }
__device__ __forceinline__ u16 f2bf(float f) { unsigned u = __float_as_uint(f); return (u16)((u + 0x7fffu + ((u >> 16) & 1u)) >> 16); }
__device__ __forceinline__ unsigned pk2(float lo, float hi) { return (unsigned)f2bf(lo) | ((unsigned)f2bf(hi) << 16); }
__device__ __forceinline__ float wave_sum(float v) {
#pragma unroll
    for (int o = 1; o < 64; o <<= 1) v += __shfl_xor(v, o);
    return v;
}

__global__ __launch_bounds__(256) void k_transpose_w(const float* __restrict__ W, u16* __restrict__ WT, int K, int N) {
    __shared__ float t[64][65];
    const float* Wg = W + (size_t)blockIdx.z * K * N; u16* WTg = WT + (size_t)blockIdx.z * K * N;
    const int n0 = blockIdx.x * 64, k0 = blockIdx.y * 64, tid = threadIdx.x;
#pragma unroll
    for (int i = 0; i < 16; ++i) { const int k = i * 4 + (tid >> 6), n = tid & 63; t[k][n] = Wg[(size_t)(k0 + k) * N + n0 + n]; }
    __syncthreads();
#pragma unroll
    for (int i = 0; i < 2; ++i) {
        const int n = (tid >> 3) + 32 * i, kc = (tid & 7) * 8;
        u32x4 o; o.x = pk2(t[kc][n], t[kc + 1][n]); o.y = pk2(t[kc + 2][n], t[kc + 3][n]); o.z = pk2(t[kc + 4][n], t[kc + 5][n]); o.w = pk2(t[kc + 6][n], t[kc + 7][n]);
        *(u32x4*)(WTg + (size_t)(n0 + n) * K + k0 + kc) = o;
    }
}

__global__ __launch_bounds__(256) void k_ln_in(const float* __restrict__ x, const float* __restrict__ g, const float* __restrict__ b, u16* __restrict__ H0) {
    const int lane = threadIdx.x & 63, row = blockIdx.x * 4 + (threadIdx.x >> 6);
    const f32x4* xr = (const f32x4*)(x + (size_t)row * DM) + lane;
    f32x4 v[4]; float s = 0.f;
#pragma unroll
    for (int j = 0; j < 4; ++j) { v[j] = xr[64 * j]; s += (v[j].x + v[j].y) + (v[j].z + v[j].w); }
    const float mean = wave_sum(s) * (1.f / DM); float s2 = 0.f;
#pragma unroll
    for (int j = 0; j < 4; ++j) { v[j] = v[j] - mean; s2 += (v[j].x * v[j].x + v[j].y * v[j].y) + (v[j].z * v[j].z + v[j].w * v[j].w); }
    const float rstd = 1.f / sqrtf(wave_sum(s2) * (1.f / DM) + LN_EPS);
    u32x2* o8 = (u32x2*)(H0 + (size_t)row * DM) + lane;
#pragma unroll
    for (int j = 0; j < 4; ++j) {
        const f32x4 gg = ((const f32x4*)g)[lane + 64 * j], bb = ((const f32x4*)b)[lane + 64 * j];
        u32x2 w; w.x = pk2(v[j].x * rstd * gg.x + bb.x, v[j].y * rstd * gg.y + bb.y); w.y = pk2(v[j].z * rstd * gg.z + bb.z, v[j].w * rstd * gg.w + bb.w);
        o8[64 * j] = w;
    }
}

struct GArgs { const u16* A; const u16* Bt; u16* out; const u16* H0; const int* cnt; const int* list; const float* gate; const float* bias; int N; int K; };
template <int MODE> __global__ __launch_bounds__(256, 2) void k_gemm128(GArgs g) {
    __shared__ __attribute__((aligned(16))) u16 shm[2 * 4096];
    const int tid = threadIdx.x, e = blockIdx.z, rt = blockIdx.y, ct = blockIdx.x;
    int cnt = 0, abase = 0;
    if (MODE >= 2) { cnt = g.cnt[e]; if (rt * 128 >= cnt) return; for (int q = 0; q < e; ++q) abase += (g.cnt[q] + 255) & ~255; }
    const int K = g.K, N = g.N;
    const u16* Bg = g.Bt + (MODE >= 2 ? (size_t)e * N * K : (size_t)0);
    const int brow = rt * 128, bcol = ct * 128;
    const int wid = tid >> 6, lane = tid & 63, wr = wid >> 1, wc = wid & 1, fr = lane & 15, fq = lane >> 4;
    const u16* ap[2]; const u16* bp[2];
#pragma unroll
    for (int i = 0; i < 2; ++i) {
        const int b = tid * 16 + i * 4096, r = b / 64, c = (b % 64) / 2;
        size_t grow;
        if (MODE == 2) { const int idx = brow + r; const int ent = g.list[(size_t)e * NTOK + (idx < cnt ? idx : 0)]; grow = (size_t)(ent >> 2); }
        else if (MODE == 3) grow = (size_t)(abase + brow + r);
        else grow = (size_t)(brow + r);
        ap[i] = g.A + grow * K + c; bp[i] = Bg + (size_t)(bcol + r) * K + c;
    }
    LAS u16* SA = (LAS u16*)shm; LAS u16* SB = SA + 4096;
    f32x4 acc[4][4];
#pragma unroll
    for (int m = 0; m < 4; ++m)
#pragma unroll
        for (int n = 0; n < 4; ++n) acc[m][n] = (f32x4){0.f, 0.f, 0.f, 0.f};
    for (int t = 0; t < K / 32; ++t) {
#pragma unroll
        for (int i = 0; i < 2; ++i) {
            const int b = tid * 16 + i * 4096;
            __builtin_amdgcn_global_load_lds((const unsigned*)(ap[i] + t * 32), (LAS unsigned*)((LAS char*)SA + b), 16, 0, 0);
            __builtin_amdgcn_global_load_lds((const unsigned*)(bp[i] + t * 32), (LAS unsigned*)((LAS char*)SB + b), 16, 0, 0);
        }
        asm volatile("s_waitcnt vmcnt(0)" ::: "memory"); __syncthreads();
        bf16x8 At[4], Btl[4];
#pragma unroll
        for (int m = 0; m < 4; ++m) {
            At[m] = *(const LAS bf16x8*)((LAS char*)SA + (wr * 64 + m * 16 + fr) * 64 + fq * 16);
            Btl[m] = *(const LAS bf16x8*)((LAS char*)SB + (wc * 64 + m * 16 + fr) * 64 + fq * 16);
        }
#pragma unroll
        for (int m = 0; m < 4; ++m)
#pragma unroll
            for (int n = 0; n < 4; ++n) acc[m][n] = __builtin_amdgcn_mfma_f32_16x16x32_bf16(At[m], Btl[n], acc[m][n], 0, 0, 0);
        __syncthreads();
    }
#pragma unroll
    for (int m = 0; m < 4; ++m)
#pragma unroll
        for (int n = 0; n < 4; ++n)
#pragma unroll
            for (int j = 0; j < 4; ++j) {
                const int rl = wr * 64 + m * 16 + fq * 4 + j, col = bcol + wc * 64 + n * 16 + fr;
                float v = acc[m][n][j];
                if (MODE == 0) {
                    if (col < 512 || (col >= 1536 && col < 2048)) v *= QSCALE;
                    g.out[(size_t)(brow + rl) * QKVP + col] = f2bf(v);
                } else if (MODE == 1) {
                    const size_t off = (size_t)(brow + rl) * DM + col;
                    g.out[off] = f2bf(DN_ALPHA * bf2f(g.H0[off]) + v);
                } else if (MODE == 2) {
                    v += g.bias[(size_t)e * 2048 + col];
                    const float pv = __shfl_xor(v, 1);
                    const float glu = (fr & 1) ? pv : v, lin = (fr & 1) ? v : pv;
                    const float xg = fminf(glu, 7.0f), xl = fminf(fmaxf(lin, -7.0f), 7.0f);
                    const float a = xg * (1.0f / (1.0f + __expf(-1.702f * xg))) * (xl + 1.0f);
                    if (!(fr & 1)) g.out[(size_t)(abase + brow + rl) * 1024 + (col >> 1)] = f2bf(a);
                } else {
                    const int idx = brow + rl;
                    if (idx < cnt) {
                        const int ent = g.list[(size_t)e * NTOK + idx];
                        v = (v + g.bias[(size_t)e * 1024 + col]) * g.gate[ent];
                        g.out[(size_t)ent * 1024 + col] = f2bf(v);
                    }
                }
            }
}

template <bool ISA> __global__ __launch_bounds__(256) void k_attn_naive(const u16* __restrict__ QKV, u16* __restrict__ O, const float* __restrict__ relb,
                                                                          const float* lq1, const float* lk1, const float* lq2, const float* lk2, const float* subg) {
    constexpr int DV = ISA ? 128 : 64, DVT = DV / 4;
    __shared__ float Qs[64][65]; __shared__ float Ks[32][65]; __shared__ float Vs[32][DV + 4]; __shared__ float Ps[64][33];
    const int c = blockIdx.x, h = blockIdx.y, b = blockIdx.z, tid = threadIdx.x;
    const int row = tid >> 2, cg = tid & 3;
    const size_t tok0 = (size_t)b * SEQ;
    const int qcol = ISA ? h * 128 : 1536 + h * 64, kcol = ISA ? 512 + h * 128 : 2048 + h * 64, vcol = ISA ? 1024 + h * 128 : 2560 + h * 64;
    const float slope2 = exp2f(-2.0f * (float)(h + 1)) * LOG2E;
    float keep[DVT];
#pragma unroll
    for (int e = 0; e < DVT; ++e) keep[e] = 0.f;
    float o[DVT];
    constexpr int NMAP = ISA ? 2 : 1;
#pragma unroll 1
    for (int m = 0; m < NMAP; ++m) {
        __syncthreads();
        for (int i = tid; i < 64 * 64; i += 256) { const int r = i >> 6, d = i & 63; Qs[r][d] = bf2f(QKV[(tok0 + c * 64 + r) * QKVP + qcol + m * 64 + d]); }
        float mrun = -INFINITY, lrun = 0.f;
#pragma unroll
        for (int e = 0; e < DVT; ++e) o[e] = 0.f;
        const int kc0 = ISA ? 0 : (c > 8 ? c - 8 : 0);
        for (int st = kc0 * 2; st < (c + 1) * 2; ++st) {
            __syncthreads();
            const int key0 = st * 32;
            for (int i = tid; i < 32 * 64; i += 256) { const int r = i >> 6, d = i & 63; Ks[r][d] = bf2f(QKV[(tok0 + key0 + r) * QKVP + kcol + m * 64 + d]); }
            for (int i = tid; i < 32 * DV; i += 256) { const int r = i / DV, d = i % DV; Vs[r][d] = bf2f(QKV[(tok0 + key0 + r) * QKVP + vcol + d]); }
            __syncthreads();
            float s[8];
#pragma unroll
            for (int j = 0; j < 8; ++j) s[j] = 0.f;
            for (int d = 0; d < 64; ++d) { const float q = Qs[row][d];
#pragma unroll
                for (int j = 0; j < 8; ++j) s[j] += q * Ks[cg * 8 + j][d]; }
            const int qpos = c * 64 + row;
            float mx = -INFINITY;
#pragma unroll
            for (int j = 0; j < 8; ++j) {
                const int kpos = key0 + cg * 8 + j;
                if (ISA) s[j] -= slope2 * fabsf((float)(qpos - kpos));
                else { int rel = qpos - kpos; rel = rel < -256 ? -256 : (rel > 256 ? 256 : rel); s[j] += relb[h * 513 + rel + 256] * LOG2E; }
                mx = fmaxf(mx, s[j]);
            }
            mx = fmaxf(mx, __shfl_xor(mx, 1)); mx = fmaxf(mx, __shfl_xor(mx, 2));
            const float mnew = fmaxf(mrun, mx), a = exp2f(mrun - mnew);
            float ps = 0.f;
#pragma unroll
            for (int j = 0; j < 8; ++j) { const float p = exp2f(s[j] - mnew); Ps[row][cg * 8 + j] = p; ps += p; }
            ps += __shfl_xor(ps, 1); ps += __shfl_xor(ps, 2);
            lrun = lrun * a + ps; mrun = mnew;
#pragma unroll
            for (int e = 0; e < DVT; ++e) o[e] *= a;
            __syncthreads();
            for (int j = 0; j < 32; ++j) { const float p = Ps[row][j];
#pragma unroll
                for (int e = 0; e < DVT; ++e) o[e] += p * Vs[j][cg * DVT + e]; }
        }
        const float inv = 1.f / lrun;
        if (m == 0) {
#pragma unroll
            for (int e = 0; e < DVT; ++e) keep[e] = o[e] * inv;
        } else {
#pragma unroll
            for (int e = 0; e < DVT; ++e) o[e] *= inv;
        }
    }
    u16* orow = O + (tok0 + c * 64 + row) * DM;
    if (ISA) {
        float d1 = 0.f, d2 = 0.f;
        for (int i = 0; i < 64; ++i) { d1 += lq1[i] * lk1[i]; d2 += lq2[i] * lk2[i]; }
        const float lam = expf(d1) - expf(d2) + 0.2f;
        float ss = 0.f;
#pragma unroll
        for (int e = 0; e < DVT; ++e) { keep[e] = keep[e] - lam * o[e]; ss += keep[e] * keep[e]; }
        ss += __shfl_xor(ss, 1); ss += __shfl_xor(ss, 2);
        const float r = 1.f / sqrtf(ss * (1.f / 128.f) + 1e-5f);
#pragma unroll
        for (int e = 0; e < DVT; ++e) orow[h * 128 + cg * DVT + e] = f2bf(keep[e] * r * subg[cg * DVT + e] * 0.8f);
    } else {
#pragma unroll
        for (int e = 0; e < DVT; ++e) orow[512 + h * 64 + cg * DVT + e] = f2bf(keep[e]);
    }
}

__global__ __launch_bounds__(256) void k_router(const u16* __restrict__ U, const float* __restrict__ g1, const float* __restrict__ b1, const float* __restrict__ rw, const float* __restrict__ rb,
                                                 u16* __restrict__ H1, int* cnt, int* list, float* gate) {
    const int lane = threadIdx.x & 63, t = blockIdx.x * 4 + (threadIdx.x >> 6);
    const u32x2* ur = (const u32x2*)(U + (size_t)t * DM) + lane;
    float v[16]; float s = 0.f;
#pragma unroll
    for (int j = 0; j < 4; ++j) { const u32x2 w = ur[64 * j]; v[4 * j] = __uint_as_float(w.x << 16); v[4 * j + 1] = __uint_as_float(w.x & 0xffff0000u); v[4 * j + 2] = __uint_as_float(w.y << 16); v[4 * j + 3] = __uint_as_float(w.y & 0xffff0000u);
        s += (v[4 * j] + v[4 * j + 1]) + (v[4 * j + 2] + v[4 * j + 3]); }
    const float mean = wave_sum(s) * (1.f / DM); float s2 = 0.f;
#pragma unroll
    for (int i = 0; i < 16; ++i) { v[i] -= mean; s2 += v[i] * v[i]; }
    const float rstd = 1.f / sqrtf(wave_sum(s2) * (1.f / DM) + LN_EPS);
    u32x2* o8 = (u32x2*)(H1 + (size_t)t * DM) + lane;
#pragma unroll
    for (int j = 0; j < 4; ++j) {
        const f32x4 gg = ((const f32x4*)g1)[lane + 64 * j], bb = ((const f32x4*)b1)[lane + 64 * j];
        v[4 * j] = v[4 * j] * rstd * gg.x + bb.x; v[4 * j + 1] = v[4 * j + 1] * rstd * gg.y + bb.y; v[4 * j + 2] = v[4 * j + 2] * rstd * gg.z + bb.z; v[4 * j + 3] = v[4 * j + 3] * rstd * gg.w + bb.w;
        u32x2 w; w.x = pk2(v[4 * j], v[4 * j + 1]); w.y = pk2(v[4 * j + 2], v[4 * j + 3]); o8[64 * j] = w;
    }
    float lg[32];
#pragma unroll
    for (int e = 0; e < 32; ++e) lg[e] = 0.f;
#pragma unroll
    for (int j = 0; j < 4; ++j)
#pragma unroll
        for (int q = 0; q < 4; ++q) {
            const int col = lane * 4 + 256 * j + q; const f32x4* w = (const f32x4*)(rw + (size_t)col * 32); const float hv = v[4 * j + q];
#pragma unroll
            for (int k = 0; k < 8; ++k) { const f32x4 wv = w[k]; lg[4 * k] += hv * wv.x; lg[4 * k + 1] += hv * wv.y; lg[4 * k + 2] += hv * wv.z; lg[4 * k + 3] += hv * wv.w; }
        }
#pragma unroll
    for (int e = 0; e < 32; ++e) lg[e] = wave_sum(lg[e]) + rb[e];
    unsigned used = 0u; float tv[4]; int ti[4];
#pragma unroll
    for (int k = 0; k < 4; ++k) {
        float best = -INFINITY; int bi = 0;
#pragma unroll
        for (int e = 0; e < 32; ++e) { const bool ok = !((used >> e) & 1u) && lg[e] > best; best = ok ? lg[e] : best; bi = ok ? e : bi; }
        used |= 1u << bi; tv[k] = best; ti[k] = bi;
    }
    const float e1 = __expf(tv[1] - tv[0]), e2 = __expf(tv[2] - tv[0]), e3 = __expf(tv[3] - tv[0]);
    const float inv = 1.f / (1.f + e1 + e2 + e3);
    if (lane < 4) {
        const int me = lane == 0 ? ti[0] : lane == 1 ? ti[1] : lane == 2 ? ti[2] : ti[3];
        const float mg = (lane == 0 ? 1.f : lane == 1 ? e1 : lane == 2 ? e2 : e3) * inv;
        const int pos = atomicAdd(&cnt[me], 1);
        list[(size_t)me * NTOK + pos] = t * 4 + lane; gate[t * 4 + lane] = mg;
    }
}

__global__ __launch_bounds__(256) void k_final(const u16* __restrict__ H1, const u16* __restrict__ YS, const float* __restrict__ g2, const float* __restrict__ b2, float* __restrict__ out) {
    const int lane = threadIdx.x & 63, t = blockIdx.x * 4 + (threadIdx.x >> 6);
    float v[16]; float s = 0.f;
#pragma unroll
    for (int j = 0; j < 4; ++j) {
        const u32x2 w = ((const u32x2*)(H1 + (size_t)t * DM) + lane)[64 * j];
        float a0 = DN_ALPHA * __uint_as_float(w.x << 16), a1 = DN_ALPHA * __uint_as_float(w.x & 0xffff0000u), a2 = DN_ALPHA * __uint_as_float(w.y << 16), a3 = DN_ALPHA * __uint_as_float(w.y & 0xffff0000u);
#pragma unroll
        for (int k = 0; k < 4; ++k) {
            const u32x2 y = ((const u32x2*)(YS + ((size_t)t * 4 + k) * DM) + lane)[64 * j];
            a0 += __uint_as_float(y.x << 16); a1 += __uint_as_float(y.x & 0xffff0000u); a2 += __uint_as_float(y.y << 16); a3 += __uint_as_float(y.y & 0xffff0000u);
        }
        v[4 * j] = a0; v[4 * j + 1] = a1; v[4 * j + 2] = a2; v[4 * j + 3] = a3; s += (a0 + a1) + (a2 + a3);
    }
    const float mean = wave_sum(s) * (1.f / DM); float s2 = 0.f;
#pragma unroll
    for (int i = 0; i < 16; ++i) { v[i] -= mean; s2 += v[i] * v[i]; }
    const float rstd = 1.f / sqrtf(wave_sum(s2) * (1.f / DM) + LN_EPS);
    f32x4* o = (f32x4*)(out + (size_t)t * DM) + lane;
#pragma unroll
    for (int j = 0; j < 4; ++j) {
        const f32x4 gg = ((const f32x4*)g2)[lane + 64 * j], bb = ((const f32x4*)b2)[lane + 64 * j];
        o[64 * j] = (f32x4){v[4 * j] * rstd * gg.x + bb.x, v[4 * j + 1] * rstd * gg.y + bb.y, v[4 * j + 2] * rstd * gg.z + bb.z, v[4 * j + 3] * rstd * gg.w + bb.w};
    }
}

extern "C" void kernel_launch(void* const* d_in, const int* in_sizes, int n_in, void* d_out, int out_size, void* d_ws, size_t ws_size, hipStream_t stream) {
    if (n_in != 21 || in_sizes[0] != NTOK * DM || out_size != NTOK * DM || ws_size < WS_END) { fprintf(stderr, "kernel_launch: unexpected shapes / workspace (%d inputs, ws %zu)\n", n_in, ws_size); return; }
    const float* x = (const float*)d_in[0]; const float* ln_in_g = (const float*)d_in[1]; const float* ln_in_b = (const float*)d_in[2]; const float* w_in = (const float*)d_in[3];
    const float* lq1 = (const float*)d_in[4]; const float* lk1 = (const float*)d_in[5]; const float* lq2 = (const float*)d_in[6]; const float* lk2 = (const float*)d_in[7];
    const float* subg = (const float*)d_in[8]; const float* relb = (const float*)d_in[9]; const float* w_out = (const float*)d_in[10];
    const float* ln1_g = (const float*)d_in[11]; const float* ln1_b = (const float*)d_in[12]; const float* rw = (const float*)d_in[13]; const float* rb = (const float*)d_in[14];
    const float* w1 = (const float*)d_in[15]; const float* b1 = (const float*)d_in[16]; const float* w2 = (const float*)d_in[17]; const float* b2 = (const float*)d_in[18];
    const float* ln2_g = (const float*)d_in[19]; const float* ln2_b = (const float*)d_in[20];
    char* ws = (char*)d_ws;
    u16* WIN = (u16*)(ws + WS_WIN); u16* WOUT = (u16*)(ws + WS_WOUT); u16* W1T = (u16*)(ws + WS_W1); u16* W2T = (u16*)(ws + WS_W2);
    u16* H1 = (u16*)(ws + WS_H1); int* LIST = (int*)(ws + WS_LIST); float* GATE = (float*)(ws + WS_GATE);
    u16* H0 = (u16*)(ws + WS_H0); u16* QKV = (u16*)(ws + WS_QKV); u16* O = (u16*)(ws + WS_O); u16* U = (u16*)(ws + WS_U); u16* ACT = (u16*)(ws + WS_ACT); u16* YS = (u16*)(ws + WS_YS);
    int* CNT = (int*)(ws + WS_CTL);
    hipMemsetAsync(ws + WS_CTL, 0, CTL_BYTES, stream);
    k_transpose_w<<<dim3(3072 / 64, 1024 / 64, 1), 256, 0, stream>>>(w_in, WIN, 1024, 3072);
    k_transpose_w<<<dim3(1024 / 64, 1024 / 64, 1), 256, 0, stream>>>(w_out, WOUT, 1024, 1024);
    k_transpose_w<<<dim3(2048 / 64, 1024 / 64, 32), 256, 0, stream>>>(w1, W1T, 1024, 2048);
    k_transpose_w<<<dim3(1024 / 64, 1024 / 64, 32), 256, 0, stream>>>(w2, W2T, 1024, 1024);
    k_ln_in<<<NTOK / 4, 256, 0, stream>>>(x, ln_in_g, ln_in_b, H0);
    { GArgs a{}; a.A = H0; a.Bt = WIN; a.out = QKV; a.N = 3072; a.K = 1024; k_gemm128<0><<<dim3(3072 / 128, NTOK / 128, 1), 256, 0, stream>>>(a); }
    k_attn_naive<true><<<dim3(64, 4, 8), 256, 0, stream>>>(QKV, O, relb, lq1, lk1, lq2, lk2, subg);
    k_attn_naive<false><<<dim3(64, 8, 8), 256, 0, stream>>>(QKV, O, relb, lq1, lk1, lq2, lk2, subg);
    { GArgs a{}; a.A = O; a.Bt = WOUT; a.out = U; a.H0 = H0; a.N = 1024; a.K = 1024; k_gemm128<1><<<dim3(1024 / 128, NTOK / 128, 1), 256, 0, stream>>>(a); }
    k_router<<<NTOK / 4, 256, 0, stream>>>(U, ln1_g, ln1_b, rw, rb, H1, CNT, LIST, GATE);
    { GArgs a{}; a.A = H1; a.Bt = W1T; a.out = ACT; a.cnt = CNT; a.list = LIST; a.bias = b1; a.N = 2048; a.K = 1024; k_gemm128<2><<<dim3(2048 / 128, NTOK / 128, 32), 256, 0, stream>>>(a); }
    { GArgs a{}; a.A = ACT; a.Bt = W2T; a.out = YS; a.cnt = CNT; a.list = LIST; a.gate = GATE; a.bias = b2; a.N = 1024; a.K = 1024; k_gemm128<3><<<dim3(1024 / 128, NTOK / 128, 32), 256, 0, stream>>>(a); }
    k_final<<<NTOK / 4, 256, 0, stream>>>(H1, YS, ln2_g, ln2_b, (float*)d_out);
}
```

```cpp
#include <hip/hip_runtime.h>
#include <cstdint>
#include <cstdio>

typedef unsigned short u16;
typedef short bf16x8 __attribute__((ext_vector_type(8)));
typedef float f32x4 __attribute__((ext_vector_type(4)));
typedef unsigned u32x4 __attribute__((ext_vector_type(4)));
typedef unsigned u32x2 __attribute__((ext_vector_type(2)));
#define LAS __attribute__((address_space(3)))

constexpr int NTOK = 32768, DM = 1024, SEQ = 4096, NBATCH = 8;
constexpr int QKVP = 3072;
constexpr int NEXP = 32;
constexpr float LOG2E = 1.4426950408889634f;
constexpr float QSCALE = 0.125f * LOG2E;
constexpr float DN_ALPHA = 1.189207115002721f;
constexpr float LN_EPS = 1e-5f;

constexpr size_t MiB = 1u << 20;
constexpr size_t WS_CTL = 0, CTL_BYTES = 1 * MiB;
constexpr size_t WS_WIN = 2 * MiB, WS_WOUT = 8 * MiB, WS_W1 = 16 * MiB, WS_W2 = 144 * MiB;
constexpr size_t WS_H1 = 208 * MiB, WS_LIST = 272 * MiB, WS_GATE = 276 * MiB;
constexpr size_t WS_H0 = 280 * MiB, WS_QKV = 344 * MiB, WS_O = 536 * MiB, WS_U = 344 * MiB, WS_ACT = 280 * MiB;
constexpr size_t WS_YS = 600 * MiB, WS_END = 856 * MiB;

__device__ __forceinline__ float bf2f(u16 v) { return __uint_as_float((unsigned)v << 16); }
__device__ __forceinline__ u16 f2bf(float f) { unsigned u = __float_as_uint(f); return (u16)((u + 0x7fffu + ((u >> 16) & 1u)) >> 16); }
__device__ __forceinline__ unsigned pk2(float lo, float hi) { return (unsigned)f2bf(lo) | ((unsigned)f2bf(hi) << 16); }
__device__ __forceinline__ float wave_sum(float v) {
#pragma unroll
    for (int o = 1; o < 64; o <<= 1) v += __shfl_xor(v, o);
    return v;
}

__global__ __launch_bounds__(256) void k_transpose_w(const float* __restrict__ W, u16* __restrict__ WT, int K, int N) {
    __shared__ float t[64][65];
    const float* Wg = W + (size_t)blockIdx.z * K * N; u16* WTg = WT + (size_t)blockIdx.z * K * N;
    const int n0 = blockIdx.x * 64, k0 = blockIdx.y * 64, tid = threadIdx.x;
#pragma unroll
    for (int i = 0; i < 16; ++i) { const int k = i * 4 + (tid >> 6), n = tid & 63; t[k][n] = Wg[(size_t)(k0 + k) * N + n0 + n]; }
    __syncthreads();
#pragma unroll
    for (int i = 0; i < 2; ++i) {
        const int n = (tid >> 3) + 32 * i, kc = (tid & 7) * 8;
        u32x4 o; o.x = pk2(t[kc][n], t[kc + 1][n]); o.y = pk2(t[kc + 2][n], t[kc + 3][n]); o.z = pk2(t[kc + 4][n], t[kc + 5][n]); o.w = pk2(t[kc + 6][n], t[kc + 7][n]);
        *(u32x4*)(WTg + (size_t)(n0 + n) * K + k0 + kc) = o;
    }
}

__global__ __launch_bounds__(256) void k_ln_in(const float* __restrict__ x, const float* __restrict__ g, const float* __restrict__ b, u16* __restrict__ H0) {
    const int lane = threadIdx.x & 63, row = blockIdx.x * 4 + (threadIdx.x >> 6);
    const f32x4* xr = (const f32x4*)(x + (size_t)row * DM) + lane;
    f32x4 v[4]; float s = 0.f;
#pragma unroll
    for (int j = 0; j < 4; ++j) { v[j] = xr[64 * j]; s += (v[j].x + v[j].y) + (v[j].z + v[j].w); }
    const float mean = wave_sum(s) * (1.f / DM); float s2 = 0.f;
#pragma unroll
    for (int j = 0; j < 4; ++j) { v[j] = v[j] - mean; s2 += (v[j].x * v[j].x + v[j].y * v[j].y) + (v[j].z * v[j].z + v[j].w * v[j].w); }
    const float rstd = 1.f / sqrtf(wave_sum(s2) * (1.f / DM) + LN_EPS);
    u32x2* o8 = (u32x2*)(H0 + (size_t)row * DM) + lane;
#pragma unroll
    for (int j = 0; j < 4; ++j) {
        const f32x4 gg = ((const f32x4*)g)[lane + 64 * j], bb = ((const f32x4*)b)[lane + 64 * j];
        u32x2 w; w.x = pk2(v[j].x * rstd * gg.x + bb.x, v[j].y * rstd * gg.y + bb.y); w.y = pk2(v[j].z * rstd * gg.z + bb.z, v[j].w * rstd * gg.w + bb.w);
        o8[64 * j] = w;
    }
}

struct GArgs { const u16* A; const u16* Bt; u16* out; const u16* H0; const int* cnt; const int* list; const float* gate; const float* bias; int N; int K; };
template <int MODE> __global__ __launch_bounds__(256, 2) void k_gemm128(GArgs g) {
    __shared__ __attribute__((aligned(16))) u16 shm[2 * 4096];
    const int tid = threadIdx.x, e = blockIdx.z, rt = blockIdx.y, ct = blockIdx.x;
    int cnt = 0, abase = 0;
    if (MODE >= 2) { cnt = g.cnt[e]; if (rt * 128 >= cnt) return; for (int q = 0; q < e; ++q) abase += (g.cnt[q] + 255) & ~255; }
    const int K = g.K, N = g.N;
    const u16* Bg = g.Bt + (MODE >= 2 ? (size_t)e * N * K : (size_t)0);
    const int brow = rt * 128, bcol = ct * 128;
    const int wid = tid >> 6, lane = tid & 63, wr = wid >> 1, wc = wid & 1, fr = lane & 15, fq = lane >> 4;
    const u16* ap[2]; const u16* bp[2];
#pragma unroll
    for (int i = 0; i < 2; ++i) {
        const int b = tid * 16 + i * 4096, r = b / 64, c = (b % 64) / 2;
        size_t grow;
        if (MODE == 2) { const int idx = brow + r; const int ent = g.list[(size_t)e * NTOK + (idx < cnt ? idx : 0)]; grow = (size_t)(ent >> 2); }
        else if (MODE == 3) grow = (size_t)(abase + brow + r);
        else grow = (size_t)(brow + r);
        ap[i] = g.A + grow * K + c; bp[i] = Bg + (size_t)(bcol + r) * K + c;
    }
    LAS u16* SA = (LAS u16*)shm; LAS u16* SB = SA + 4096;
    f32x4 acc[4][4];
#pragma unroll
    for (int m = 0; m < 4; ++m)
#pragma unroll
        for (int n = 0; n < 4; ++n) acc[m][n] = (f32x4){0.f, 0.f, 0.f, 0.f};
    for (int t = 0; t < K / 32; ++t) {
#pragma unroll
        for (int i = 0; i < 2; ++i) {
            const int b = tid * 16 + i * 4096;
            __builtin_amdgcn_global_load_lds((const unsigned*)(ap[i] + t * 32), (LAS unsigned*)((LAS char*)SA + b), 16, 0, 0);
            __builtin_amdgcn_global_load_lds((const unsigned*)(bp[i] + t * 32), (LAS unsigned*)((LAS char*)SB + b), 16, 0, 0);
        }
        asm volatile("s_waitcnt vmcnt(0)" ::: "memory"); __syncthreads();
        bf16x8 At[4], Btl[4];
#pragma unroll
        for (int m = 0; m < 4; ++m) {
            At[m] = *(const LAS bf16x8*)((LAS char*)SA + (wr * 64 + m * 16 + fr) * 64 + fq * 16);
            Btl[m] = *(const LAS bf16x8*)((LAS char*)SB + (wc * 64 + m * 16 + fr) * 64 + fq * 16);
        }
#pragma unroll
        for (int m = 0; m < 4; ++m)
#pragma unroll
            for (int n = 0; n < 4; ++n) acc[m][n] = __builtin_amdgcn_mfma_f32_16x16x32_bf16(At[m], Btl[n], acc[m][n], 0, 0, 0);
        __syncthreads();
    }
#pragma unroll
    for (int m = 0; m < 4; ++m)
#pragma unroll
        for (int n = 0; n < 4; ++n)
#pragma unroll
            for (int j = 0; j < 4; ++j) {
                const int rl = wr * 64 + m * 16 + fq * 4 + j, col = bcol + wc * 64 + n * 16 + fr;
                float v = acc[m][n][j];
                if (MODE == 0) {
                    if (col < 512 || (col >= 1536 && col < 2048)) v *= QSCALE;
                    g.out[(size_t)(brow + rl) * QKVP + col] = f2bf(v);
                } else if (MODE == 1) {
                    const size_t off = (size_t)(brow + rl) * DM + col;
                    g.out[off] = f2bf(DN_ALPHA * bf2f(g.H0[off]) + v);
                } else if (MODE == 2) {
                    v += g.bias[(size_t)e * 2048 + col];
                    const float pv = __shfl_xor(v, 1);
                    const float glu = (fr & 1) ? pv : v, lin = (fr & 1) ? v : pv;
                    const float xg = fminf(glu, 7.0f), xl = fminf(fmaxf(lin, -7.0f), 7.0f);
                    const float a = xg * (1.0f / (1.0f + __expf(-1.702f * xg))) * (xl + 1.0f);
                    if (!(fr & 1)) g.out[(size_t)(abase + brow + rl) * 1024 + (col >> 1)] = f2bf(a);
                } else {
                    const int idx = brow + rl;
                    if (idx < cnt) {
                        const int ent = g.list[(size_t)e * NTOK + idx];
                        v = (v + g.bias[(size_t)e * 1024 + col]) * g.gate[ent];
                        g.out[(size_t)ent * 1024 + col] = f2bf(v);
                    }
                }
            }
}

template <bool ISA> __global__ __launch_bounds__(256) void k_attn_naive(const u16* __restrict__ QKV, u16* __restrict__ O, const float* __restrict__ relb,
                                                                          const float* lq1, const float* lk1, const float* lq2, const float* lk2, const float* subg) {
    constexpr int DV = ISA ? 128 : 64, DVT = DV / 4;
    __shared__ float Qs[64][65]; __shared__ float Ks[32][65]; __shared__ float Vs[32][DV + 4]; __shared__ float Ps[64][33];
    const int c = blockIdx.x, h = blockIdx.y, b = blockIdx.z, tid = threadIdx.x;
    const int row = tid >> 2, cg = tid & 3;
    const size_t tok0 = (size_t)b * SEQ;
    const int qcol = ISA ? h * 128 : 1536 + h * 64, kcol = ISA ? 512 + h * 128 : 2048 + h * 64, vcol = ISA ? 1024 + h * 128 : 2560 + h * 64;
    const float slope2 = exp2f(-2.0f * (float)(h + 1)) * LOG2E;
    float keep[DVT];
#pragma unroll
    for (int e = 0; e < DVT; ++e) keep[e] = 0.f;
    float o[DVT];
    constexpr int NMAP = ISA ? 2 : 1;
#pragma unroll 1
    for (int m = 0; m < NMAP; ++m) {
        __syncthreads();
        for (int i = tid; i < 64 * 64; i += 256) { const int r = i >> 6, d = i & 63; Qs[r][d] = bf2f(QKV[(tok0 + c * 64 + r) * QKVP + qcol + m * 64 + d]); }
        float mrun = -INFINITY, lrun = 0.f;
#pragma unroll
        for (int e = 0; e < DVT; ++e) o[e] = 0.f;
        const int kc0 = ISA ? 0 : (c > 8 ? c - 8 : 0);
        for (int st = kc0 * 2; st < (c + 1) * 2; ++st) {
            __syncthreads();
            const int key0 = st * 32;
            for (int i = tid; i < 32 * 64; i += 256) { const int r = i >> 6, d = i & 63; Ks[r][d] = bf2f(QKV[(tok0 + key0 + r) * QKVP + kcol + m * 64 + d]); }
            for (int i = tid; i < 32 * DV; i += 256) { const int r = i / DV, d = i % DV; Vs[r][d] = bf2f(QKV[(tok0 + key0 + r) * QKVP + vcol + d]); }
            __syncthreads();
            float s[8];
#pragma unroll
            for (int j = 0; j < 8; ++j) s[j] = 0.f;
            for (int d = 0; d < 64; ++d) { const float q = Qs[row][d];
#pragma unroll
                for (int j = 0; j < 8; ++j) s[j] += q * Ks[cg * 8 + j][d]; }
            const int qpos = c * 64 + row;
            float mx = -INFINITY;
#pragma unroll
            for (int j = 0; j < 8; ++j) {
                const int kpos = key0 + cg * 8 + j;
                if (ISA) s[j] -= slope2 * fabsf((float)(qpos - kpos));
                else { int rel = qpos - kpos; rel = rel < -256 ? -256 : (rel > 256 ? 256 : rel); s[j] += relb[h * 513 + rel + 256] * LOG2E; }
                mx = fmaxf(mx, s[j]);
            }
            mx = fmaxf(mx, __shfl_xor(mx, 1)); mx = fmaxf(mx, __shfl_xor(mx, 2));
            const float mnew = fmaxf(mrun, mx), a = exp2f(mrun - mnew);
            float ps = 0.f;
#pragma unroll
            for (int j = 0; j < 8; ++j) { const float p = exp2f(s[j] - mnew); Ps[row][cg * 8 + j] = p; ps += p; }
            ps += __shfl_xor(ps, 1); ps += __shfl_xor(ps, 2);
            lrun = lrun * a + ps; mrun = mnew;
#pragma unroll
            for (int e = 0; e < DVT; ++e) o[e] *= a;
            __syncthreads();
            for (int j = 0; j < 32; ++j) { const float p = Ps[row][j];
#pragma unroll
                for (int e = 0; e < DVT; ++e) o[e] += p * Vs[j][cg * DVT + e]; }
        }
        const float inv = 1.f / lrun;
        if (m == 0) {
#pragma unroll
            for (int e = 0; e < DVT; ++e) keep[e] = o[e] * inv;
        } else {
#pragma unroll
            for (int e = 0; e < DVT; ++e) o[e] *= inv;
        }
    }
    u16* orow = O + (tok0 + c * 64 + row) * DM;
    if (ISA) {
        float d1 = 0.f, d2 = 0.f;
        for (int i = 0; i < 64; ++i) { d1 += lq1[i] * lk1[i]; d2 += lq2[i] * lk2[i]; }
        const float lam = expf(d1) - expf(d2) + 0.2f;
        float ss = 0.f;
#pragma unroll
        for (int e = 0; e < DVT; ++e) { keep[e] = keep[e] - lam * o[e]; ss += keep[e] * keep[e]; }
        ss += __shfl_xor(ss, 1); ss += __shfl_xor(ss, 2);
        const float r = 1.f / sqrtf(ss * (1.f / 128.f) + 1e-5f);
#pragma unroll
        for (int e = 0; e < DVT; ++e) orow[h * 128 + cg * DVT + e] = f2bf(keep[e] * r * subg[cg * DVT + e] * 0.8f);
    } else {
#pragma unroll
        for (int e = 0; e < DVT; ++e) orow[512 + h * 64 + cg * DVT + e] = f2bf(keep[e]);
    }
}

__global__ __launch_bounds__(256) void k_router(const u16* __restrict__ U, const float* __restrict__ g1, const float* __restrict__ b1, const float* __restrict__ rw, const float* __restrict__ rb,
                                                 u16* __restrict__ H1, int* cnt, int* list, float* gate) {
    const int lane = threadIdx.x & 63, t = blockIdx.x * 4 + (threadIdx.x >> 6);
    const u32x2* ur = (const u32x2*)(U + (size_t)t * DM) + lane;
    float v[16]; float s = 0.f;
#pragma unroll
    for (int j = 0; j < 4; ++j) { const u32x2 w = ur[64 * j]; v[4 * j] = __uint_as_float(w.x << 16); v[4 * j + 1] = __uint_as_float(w.x & 0xffff0000u); v[4 * j + 2] = __uint_as_float(w.y << 16); v[4 * j + 3] = __uint_as_float(w.y & 0xffff0000u);
        s += (v[4 * j] + v[4 * j + 1]) + (v[4 * j + 2] + v[4 * j + 3]); }
    const float mean = wave_sum(s) * (1.f / DM); float s2 = 0.f;
#pragma unroll
    for (int i = 0; i < 16; ++i) { v[i] -= mean; s2 += v[i] * v[i]; }
    const float rstd = 1.f / sqrtf(wave_sum(s2) * (1.f / DM) + LN_EPS);
    u32x2* o8 = (u32x2*)(H1 + (size_t)t * DM) + lane;
#pragma unroll
    for (int j = 0; j < 4; ++j) {
        const f32x4 gg = ((const f32x4*)g1)[lane + 64 * j], bb = ((const f32x4*)b1)[lane + 64 * j];
        v[4 * j] = v[4 * j] * rstd * gg.x + bb.x; v[4 * j + 1] = v[4 * j + 1] * rstd * gg.y + bb.y; v[4 * j + 2] = v[4 * j + 2] * rstd * gg.z + bb.z; v[4 * j + 3] = v[4 * j + 3] * rstd * gg.w + bb.w;
        u32x2 w; w.x = pk2(v[4 * j], v[4 * j + 1]); w.y = pk2(v[4 * j + 2], v[4 * j + 3]); o8[64 * j] = w;
    }
    float lg[32];
#pragma unroll
    for (int e = 0; e < 32; ++e) lg[e] = 0.f;
#pragma unroll
    for (int j = 0; j < 4; ++j)
#pragma unroll
        for (int q = 0; q < 4; ++q) {
            const int col = lane * 4 + 256 * j + q; const f32x4* w = (const f32x4*)(rw + (size_t)col * 32); const float hv = v[4 * j + q];
#pragma unroll
            for (int k = 0; k < 8; ++k) { const f32x4 wv = w[k]; lg[4 * k] += hv * wv.x; lg[4 * k + 1] += hv * wv.y; lg[4 * k + 2] += hv * wv.z; lg[4 * k + 3] += hv * wv.w; }
        }
#pragma unroll
    for (int e = 0; e < 32; ++e) lg[e] = wave_sum(lg[e]) + rb[e];
    unsigned used = 0u; float tv[4]; int ti[4];
#pragma unroll
    for (int k = 0; k < 4; ++k) {
        float best = -INFINITY; int bi = 0;
#pragma unroll
        for (int e = 0; e < 32; ++e) { const bool ok = !((used >> e) & 1u) && lg[e] > best; best = ok ? lg[e] : best; bi = ok ? e : bi; }
        used |= 1u << bi; tv[k] = best; ti[k] = bi;
    }
    const float e1 = __expf(tv[1] - tv[0]), e2 = __expf(tv[2] - tv[0]), e3 = __expf(tv[3] - tv[0]);
    const float inv = 1.f / (1.f + e1 + e2 + e3);
    if (lane < 4) {
        const int me = lane == 0 ? ti[0] : lane == 1 ? ti[1] : lane == 2 ? ti[2] : ti[3];
        const float mg = (lane == 0 ? 1.f : lane == 1 ? e1 : lane == 2 ? e2 : e3) * inv;
        const int pos = atomicAdd(&cnt[me], 1);
        list[(size_t)me * NTOK + pos] = t * 4 + lane; gate[t * 4 + lane] = mg;
    }
}

__global__ __launch_bounds__(256) void k_final(const u16* __restrict__ H1, const u16* __restrict__ YS, const float* __restrict__ g2, const float* __restrict__ b2, float* __restrict__ out) {
    const int lane = threadIdx.x & 63, t = blockIdx.x * 4 + (threadIdx.x >> 6);
    float v[16]; float s = 0.f;
#pragma unroll
    for (int j = 0; j < 4; ++j) {
        const u32x2 w = ((const u32x2*)(H1 + (size_t)t * DM) + lane)[64 * j];
        float a0 = DN_ALPHA * __uint_as_float(w.x << 16), a1 = DN_ALPHA * __uint_as_float(w.x & 0xffff0000u), a2 = DN_ALPHA * __uint_as_float(w.y << 16), a3 = DN_ALPHA * __uint_as_float(w.y & 0xffff0000u);
#pragma unroll
        for (int k = 0; k < 4; ++k) {
            const u32x2 y = ((const u32x2*)(YS + ((size_t)t * 4 + k) * DM) + lane)[64 * j];
            a0 += __uint_as_float(y.x << 16); a1 += __uint_as_float(y.x & 0xffff0000u); a2 += __uint_as_float(y.y << 16); a3 += __uint_as_float(y.y & 0xffff0000u);
        }
        v[4 * j] = a0; v[4 * j + 1] = a1; v[4 * j + 2] = a2; v[4 * j + 3] = a3; s += (a0 + a1) + (a2 + a3);
    }
    const float mean = wave_sum(s) * (1.f / DM); float s2 = 0.f;
#pragma unroll
    for (int i = 0; i < 16; ++i) { v[i] -= mean; s2 += v[i] * v[i]; }
    const float rstd = 1.f / sqrtf(wave_sum(s2) * (1.f / DM) + LN_EPS);
    f32x4* o = (f32x4*)(out + (size_t)t * DM) + lane;
#pragma unroll
    for (int j = 0; j < 4; ++j) {
        const f32x4 gg = ((const f32x4*)g2)[lane + 64 * j], bb = ((const f32x4*)b2)[lane + 64 * j];
        o[64 * j] = (f32x4){v[4 * j] * rstd * gg.x + bb.x, v[4 * j + 1] * rstd * gg.y + bb.y, v[4 * j + 2] * rstd * gg.z + bb.z, v[4 * j + 3] * rstd * gg.w + bb.w};
    }
}


#define GAS __attribute__((address_space(1)))
typedef GAS unsigned gu32;
#define RLX_AGENT __ATOMIC_RELAXED, __HIP_MEMORY_SCOPE_AGENT
#define LDS_WAIT() asm volatile("s_waitcnt lgkmcnt(0)" ::: "memory")
#define VM_WAIT() asm volatile("s_waitcnt vmcnt(0)" ::: "memory")

constexpr int NWAVES = 8, NTHR = 512;
constexpr int RING_OFF = 0, RING_BYTES = 131072, TAB_OFF = 131072, TAB_BYTES = 24576, MISC_OFF = TAB_OFF + TAB_BYTES, LDS_BYTES = MISC_OFF + 1024;
constexpr int CW_CNT = 0;
constexpr int CW_BAR = 4096;

#define XB_TMO      128
#define XB_XCNT(j)  (256  + 64 * (j))
#define XB_XSUB(j)  (1280 + 64 * (j))
#define XB_XGEN(j)  (2304 + 64 * (j))
#define XB_TOP      3328
#define XB_TOPGEN   3392
#define XCD_BAR_WORDS 3456
#define XB_SPIN_CAP (1u << 20)
__device__ __forceinline__ unsigned xb_ld(unsigned* p)              { return __hip_atomic_load(p, __ATOMIC_RELAXED, __HIP_MEMORY_SCOPE_AGENT); }
__device__ __forceinline__ unsigned xb_add(unsigned* p, unsigned v) { return __hip_atomic_fetch_add(p, v, __ATOMIC_RELAXED, __HIP_MEMORY_SCOPE_AGENT); }
__device__ __forceinline__ unsigned xb_xcc_id() { return (unsigned)__builtin_amdgcn_s_getreg((3 << 11) | 20) & 0xFu; }
#define XB_SPIN(cond, bar) do { unsigned _sp = 0; while (cond) { __builtin_amdgcn_s_sleep(1); \
    if ((++_sp & 255u) == 0u) { if (xb_ld(&(bar)[XB_TMO])) break; if (_sp > XB_SPIN_CAP) { atomicAdd(&(bar)[XB_TMO], 1u); break; } } } } while (0)
struct XcdBarrier { unsigned* bar; unsigned x; volatile LAS unsigned* st; };
__device__ __forceinline__ XcdBarrier xcd_barrier_post(unsigned* bar, volatile LAS unsigned* st) {
    XcdBarrier b; b.bar = bar; b.x = xb_xcc_id(); b.st = st;
    if (threadIdx.x == 0) (void)xb_add(&bar[XB_XCNT(b.x)], 1u);
    return b;
}
__device__ __forceinline__ void xcd_barrier_complete(unsigned* bar, unsigned x, unsigned& nloc, unsigned& nx) {
    const unsigned G = gridDim.x * gridDim.y * gridDim.z;
    unsigned sum, cnt, mine, sp = 0u;
    for (;;) {
        sum = 0u; cnt = 0u; mine = 0u;
#pragma unroll
        for (unsigned j = 0; j < 16; ++j) { const unsigned c = xb_ld(&bar[XB_XCNT(j)]); sum += c; cnt += (c > 0u) ? 1u : 0u; mine = (j == x) ? c : mine; }
        if (sum == G) break;
        __builtin_amdgcn_s_sleep(1);
        if ((++sp & 255u) == 0u) { if (xb_ld(&bar[XB_TMO])) break; if (sp > XB_SPIN_CAP) { atomicAdd(&bar[XB_TMO], 1u); break; } }
    }
    nloc = mine > 0u ? mine : 1u; nx = cnt > 0u ? cnt : 1u;
}
__device__ __forceinline__ void xcd_barrier(const XcdBarrier& b) {
    asm volatile("s_waitcnt vmcnt(0)" ::: "memory");
    __syncthreads();
    if (threadIdx.x == 0) {
        unsigned* bar = b.bar;
        __builtin_amdgcn_s_waitcnt(0);
        unsigned nloc = b.st[0], nx = b.st[1];
        if (nloc == 0u) { xcd_barrier_complete(bar, b.x, nloc, nx); b.st[0] = nloc; b.st[1] = nx; }
        const unsigned old = xb_add(&bar[XB_XSUB(b.x)], 1u);
        const unsigned gen = old / nloc;
        if (old + 1u == (gen + 1u) * nloc) {
            __builtin_amdgcn_fence(__ATOMIC_RELEASE, "agent");
            asm volatile("s_waitcnt vmcnt(0)" ::: "memory");
            const unsigned og = xb_add(&bar[XB_TOP], 1u);
            const unsigned tg = og / nx;
            if (og + 1u == (tg + 1u) * nx) xb_add(&bar[XB_TOPGEN], 1u);
            else XB_SPIN(xb_ld(&bar[XB_TOPGEN]) == tg, bar);
            __builtin_amdgcn_fence(__ATOMIC_ACQUIRE, "agent");
            xb_add(&bar[XB_XGEN(b.x)], 1u);
            asm volatile("s_waitcnt vmcnt(0)" ::: "memory");
        } else {
            XB_SPIN(xb_ld(&bar[XB_XGEN(b.x)]) == gen, bar);
            __builtin_amdgcn_fence(__ATOMIC_ACQUIRE, "agent");
            asm volatile("s_waitcnt vmcnt(0)" ::: "memory");
        }
    }
    __syncthreads();
}

namespace pg8 {
constexpr int BM = 256, BK = 64, HALF = 128, HTB = HALF * BK * 2, NXCD = 8, WGM = 8, KD = 1024, NT = KD / BK;
__host__ __device__ __forceinline__ int lds_byte(int r, int c) { const int st = (r >> 4) * 2 + (c >> 5), rr = r & 15, cc = c & 31, ob = rr * 64 + cc * 2; return st * 1024 + (ob ^ (((ob >> 9) & 1) << 5)); }
__host__ __device__ __forceinline__ void stage_rc(int b, int& R, int& C) { const int st = b / 1024, sb = b % 1024, swz = sb ^ (((sb >> 9) & 1) << 5); R = (st >> 1) * 16 + swz / 64; C = (st & 1) * 32 + (swz % 64) / 2; }
__host__ __device__ __forceinline__ int perm32(int rho) { const int n = rho >> 4, i = rho & 15; return 8 * (i >> 2) + 4 * n + (i & 3); }
__device__ __forceinline__ unsigned cvt_pk_bf16(float lo, float hi) { unsigned r; asm volatile("v_cvt_pk_bf16_f32 %0, %1, %2" : "=v"(r) : "v"(lo), "v"(hi)); return r; }

struct Unit { int pm, pn, e, idx; };

struct StaticOrder {
    int nM, nN, nwg, G, c;
    __device__ void init(int M, int N, int G_, int c_) { nM = M / BM; nN = N / BM; nwg = nM * nN; G = G_; c = c_; }
    __device__ bool next(int i, Unit& u) const {
        const long L = (long)i * G + c; if (L >= nwg) return false;
        int wgid = (int)L; { const int q = nwg / NXCD, r = nwg % NXCD, xcd = wgid % NXCD, off = wgid / NXCD; wgid = (xcd < r ? xcd * (q + 1) : r * (q + 1) + (xcd - r) * q) + off; }
        const int nig = WGM * nN, gid = wgid / nig, fm = gid * WGM, gsz = (nM - fm) < WGM ? (nM - fm) : WGM;
        u.pm = fm + ((wgid % nig) % gsz); u.pn = (wgid % nig) / gsz; u.e = 0; u.idx = i; return true;
    }
};

template <class P>
__device__ __forceinline__ void gemm_phase(LAS unsigned char* lds, const P& S) {
    const int tid = threadIdx.x, wid = __builtin_amdgcn_readfirstlane(tid >> 6), lane = tid & 63, wr = wid >> 2, wc = wid & 3, fr = lane & 15, fq = lane >> 4;
    constexpr int K = KD, nt = NT;
    int Rr[2], Cc[2]; unsigned voffB[2];
#pragma unroll
    for (int i = 0; i < 2; ++i) { int R, C; stage_rc(tid * 16 + i * 8192, R, C); const int Rb = P::PERM ? ((R & ~31) + perm32(R & 31)) : R; Rr[i] = R; Cc[i] = C; voffB[i] = (unsigned)(Rb * K + C) * 2u; }
    constexpr size_t kstep = (size_t)(BK * 2);
    constexpr size_t hstep = (size_t)HALF * K * 2;
    const unsigned ldsw = (unsigned)wid * 1024u;
    const int aoff = lds_byte(wr * 64 + fr, fq * 8), boff = lds_byte(wc * 32 + fr, fq * 8);
#define PG8_SA(b, h) (((b) * 2 + (h)) * HTB)
#define PG8_SB(b, h) ((4 + (b) * 2 + (h)) * HTB)
#define PG8_STAGE(bufoff, gbase, voff) do { _Pragma("unroll") for (int _i = 0; _i < 2; ++_i) \
        __builtin_amdgcn_global_load_lds((const unsigned*)((const char*)(gbase) + (voff)[_i]), (LAS unsigned*)(lds + (bufoff) + ldsw + _i * 8192), 16, 0, 0); } while (0)
#define PG8_LDA(dst, b, h) do { _Pragma("unroll") for (int m = 0; m < 4; ++m) _Pragma("unroll") for (int k = 0; k < 2; ++k) dst[m][k] = *(const LAS bf16x8*)(lds + PG8_SA(b, h) + aoff + m * 2048 + k * 1024); } while (0)
#define PG8_LDB(dst, b, h) do { _Pragma("unroll") for (int n = 0; n < 2; ++n) _Pragma("unroll") for (int k = 0; k < 2; ++k) dst[n][k] = *(const LAS bf16x8*)(lds + PG8_SB(b, h) + boff + n * 2048 + k * 1024); } while (0)
#define PG8_MMA(ai, bj, At, Bt) do { __builtin_amdgcn_s_setprio(1); _Pragma("unroll") for (int m = 0; m < 4; ++m) _Pragma("unroll") for (int n = 0; n < 2; ++n) _Pragma("unroll") for (int k = 0; k < 2; ++k) \
        acc[ai][bj][m][n] = __builtin_amdgcn_mfma_f32_16x16x32_bf16(Bt[n][k], At[m][k], acc[ai][bj][m][n], 0, 0, 0); __builtin_amdgcn_s_setprio(0); } while (0)
#define PG8_WAIT_V(n) asm volatile("s_waitcnt vmcnt(" #n ")" ::: "memory")
#define PG8_WAIT_L(n) asm volatile("s_waitcnt lgkmcnt(" #n ")" ::: "memory")
#define PG8_BAR __builtin_amdgcn_s_barrier()
#define PG8_SCHED __builtin_amdgcn_sched_barrier(0)
    Unit cur, nxt; int ui = 0;
    if (!S.next(0, cur)) return;
    f32x4 acc[2][2][4][2];
#pragma unroll
    for (int a = 0; a < 2; ++a)
#pragma unroll
        for (int b = 0; b < 2; ++b)
#pragma unroll
            for (int m = 0; m < 4; ++m)
#pragma unroll
                for (int n = 0; n < 2; ++n) acc[a][b][m][n] = (f32x4){0.f, 0.f, 0.f, 0.f};
    bf16x8 At[4][2], B0[2][2], B1[2][2];
    unsigned voA[2][2], voN[2][2];
    S.a_off(cur, Rr, Cc, voA);
    const char* cA = S.a_base(cur); const char* cB = S.b_base(cur);
    PG8_STAGE(PG8_SB(0, 0), cB, voffB); PG8_STAGE(PG8_SB(0, 1), cB + hstep, voffB); PG8_STAGE(PG8_SA(0, 0), cA, voA[0]); PG8_STAGE(PG8_SA(0, 1), cA, voA[1]);
    if (wr == 1) PG8_BAR;
    PG8_WAIT_V(2); PG8_BAR;
    PG8_STAGE(PG8_SB(1, 0), cB + kstep, voffB); PG8_STAGE(PG8_SA(1, 0), cA + kstep, voA[0]); PG8_STAGE(PG8_SB(1, 1), cB + hstep + kstep, voffB);
    PG8_WAIT_V(6); PG8_BAR;
    for (;;) {
        const bool has_next = S.next(ui + 1, nxt);
        const char* nA = has_next ? S.a_base(nxt) : cA; const char* nB = has_next ? S.b_base(nxt) : cB;
        if (has_next) S.a_off(nxt, Rr, Cc, voN);
        else { voN[0][0] = voA[0][0]; voN[0][1] = voA[0][1]; voN[1][0] = voA[1][0]; voN[1][1] = voA[1][1]; }
        for (int t = 0; t < nt; t += 2) {
            const bool last = (t == nt - 2);
            const char* a1 = cA + (size_t)(t + 1) * kstep;
            const char* a2 = last ? nA : cA + (size_t)(t + 2) * kstep; const char* b2 = last ? nB : cB + (size_t)(t + 2) * kstep;
            const char* a3 = a2 + kstep; const char* b3 = b2 + kstep;
            unsigned v2[2][2];
            v2[0][0] = last ? voN[0][0] : voA[0][0]; v2[0][1] = last ? voN[0][1] : voA[0][1]; v2[1][0] = last ? voN[1][0] : voA[1][0]; v2[1][1] = last ? voN[1][1] : voA[1][1];
            PG8_LDB(B0, 0, 0); PG8_LDB(B1, 0, 1); PG8_SCHED; PG8_LDA(At, 0, 0); PG8_STAGE(PG8_SA(1, 1), a1, voA[1]);
            PG8_WAIT_V(8); PG8_WAIT_L(0); PG8_BAR; PG8_MMA(0, 0, At, B0); PG8_MMA(0, 1, At, B1); PG8_BAR; PG8_SCHED;
            PG8_LDA(At, 0, 1); PG8_STAGE(PG8_SB(0, 0), b2, voffB); PG8_STAGE(PG8_SB(0, 1), b2 + hstep, voffB); PG8_STAGE(PG8_SA(0, 0), a2, v2[0]);
            PG8_WAIT_V(8); PG8_WAIT_L(0); PG8_BAR; PG8_MMA(1, 0, At, B0); PG8_MMA(1, 1, At, B1); PG8_BAR; PG8_SCHED;
            PG8_LDB(B0, 1, 0); PG8_LDB(B1, 1, 1); PG8_SCHED; PG8_LDA(At, 1, 0); PG8_STAGE(PG8_SA(0, 1), a2, v2[1]);
            PG8_WAIT_V(8); PG8_WAIT_L(0); PG8_BAR; PG8_MMA(0, 0, At, B0); PG8_MMA(0, 1, At, B1); PG8_BAR; PG8_SCHED;
            PG8_LDA(At, 1, 1); PG8_STAGE(PG8_SB(1, 0), b3, voffB); PG8_STAGE(PG8_SB(1, 1), b3 + hstep, voffB); PG8_STAGE(PG8_SA(1, 0), a3, v2[0]);
            PG8_WAIT_V(8); PG8_WAIT_L(0); PG8_BAR; PG8_MMA(1, 0, At, B0); PG8_MMA(1, 1, At, B1); PG8_BAR; PG8_SCHED;
        }
        if (wr == 0) PG8_BAR;
        S.epi(acc, cur, wr, wc, fr, fq);
        if (!has_next) break;
#pragma unroll
        for (int a = 0; a < 2; ++a)
#pragma unroll
            for (int b = 0; b < 2; ++b)
#pragma unroll
                for (int m = 0; m < 4; ++m)
#pragma unroll
                    for (int n = 0; n < 2; ++n) acc[a][b][m][n] = (f32x4){0.f, 0.f, 0.f, 0.f};
        cur = nxt; cA = nA; cB = nB; ++ui;
        voA[0][0] = voN[0][0]; voA[0][1] = voN[0][1]; voA[1][0] = voN[1][0]; voA[1][1] = voN[1][1];
        if (wr == 1) PG8_BAR;
    }
    PG8_WAIT_V(0);
    PG8_BAR;
#undef PG8_SA
#undef PG8_SB
#undef PG8_STAGE
#undef PG8_LDA
#undef PG8_LDB
#undef PG8_MMA
#undef PG8_WAIT_V
#undef PG8_WAIT_L
#undef PG8_BAR
#undef PG8_SCHED
}
}

struct PDense {
    static constexpr bool PERM = true;
    const u16* A; const u16* Bt; u16* out; const u16* H0; int mode; pg8::StaticOrder ord;
    __device__ __forceinline__ bool next(int i, pg8::Unit& u) const { return ord.next(i, u); }
    __device__ __forceinline__ const char* a_base(const pg8::Unit& u) const { return (const char*)A + (size_t)u.pm * 256 * 2048; }
    __device__ __forceinline__ const char* b_base(const pg8::Unit& u) const { return (const char*)Bt + (size_t)u.pn * 256 * 2048; }
    __device__ __forceinline__ void a_off(const pg8::Unit&, const int (&R)[2], const int (&C)[2], unsigned (&v)[2][2]) const {
#pragma unroll
        for (int h = 0; h < 2; ++h)
#pragma unroll
            for (int i = 0; i < 2; ++i) v[h][i] = (unsigned)((h * 128 + R[i]) * 1024 + C[i]) * 2u;
    }
    __device__ __forceinline__ void epi(const f32x4 (&acc)[2][2][4][2], const pg8::Unit& u, int wr, int wc, int fr, int fq) const {
        const int row0 = u.pm * 256 + wr * 64 + fr, col0 = u.pn * 256 + wc * 32 + 8 * fq;
        const int ldc = mode == 0 ? QKVP : DM;
        const float sc = (mode == 0 && (u.pn < 2 || u.pn == 6 || u.pn == 7)) ? QSCALE : 1.0f;
#pragma unroll
        for (int ai = 0; ai < 2; ++ai)
#pragma unroll
            for (int m = 0; m < 4; ++m) {
                const size_t off = (size_t)(row0 + ai * 128 + m * 16) * ldc + col0;
#pragma unroll
                for (int bj = 0; bj < 2; ++bj) {
                    f32x4 v0 = acc[ai][bj][m][0] * sc, v1 = acc[ai][bj][m][1] * sc;
                    if (mode == 1) {
                        const u32x4 h = *(const u32x4*)(H0 + off + bj * 128);
                        v0[0] += DN_ALPHA * __uint_as_float(h.x << 16); v0[1] += DN_ALPHA * __uint_as_float(h.x & 0xffff0000u); v0[2] += DN_ALPHA * __uint_as_float(h.y << 16); v0[3] += DN_ALPHA * __uint_as_float(h.y & 0xffff0000u);
                        v1[0] += DN_ALPHA * __uint_as_float(h.z << 16); v1[1] += DN_ALPHA * __uint_as_float(h.z & 0xffff0000u); v1[2] += DN_ALPHA * __uint_as_float(h.w << 16); v1[3] += DN_ALPHA * __uint_as_float(h.w & 0xffff0000u);
                    }
                    u32x4 w; w.x = pg8::cvt_pk_bf16(v0[0], v0[1]); w.y = pg8::cvt_pk_bf16(v0[2], v0[3]); w.z = pg8::cvt_pk_bf16(v1[0], v1[1]); w.w = pg8::cvt_pk_bf16(v1[2], v1[3]);
                    *(u32x4*)(out + off + bj * 128) = w;
                }
            }
    }
};

struct MoeTab { LAS int* tb; LAS int* cn; LAS int* rowoff; };
__device__ __forceinline__ MoeTab moe_tab(LAS unsigned char* lds) { MoeTab t; t.rowoff = (LAS int*)(lds + TAB_OFF); t.tb = (LAS int*)(lds + TAB_OFF + 20480); t.cn = t.tb + 40; return t; }
__device__ __forceinline__ void moe_tables(const MoeTab& T, const int* cnt) {
    if (threadIdx.x == 0) { int s = 0; for (int e = 0; e < NEXP; ++e) { const int c = __hip_atomic_load(cnt + e, RLX_AGENT); T.cn[e] = c; T.tb[e] = s; s += (c + 255) >> 8; } T.tb[NEXP] = s; }
    __syncthreads();
}
__device__ __forceinline__ int moe_find_e(const MoeTab& T, int RT) { int e = 0; while (e < NEXP - 1 && RT >= T.tb[e + 1]) ++e; return e; }

template <int UP>
struct PMoe {
    static constexpr bool PERM = true;
    static constexpr int NPN = UP ? 8 : 4, RPG = UP ? 4 : 8;
    const u16* A; const u16* Bt; u16* out; const int* list; const float* gate; const float* bias; MoeTab T; int c;
    __device__ __forceinline__ bool next(int i, pg8::Unit& u) const {
        const int x = c & 7, s = c >> 3; const int RT = (i * 8 + x) * RPG + (s % RPG);
        if (RT >= T.tb[NEXP]) return false;
        u.pm = RT; u.pn = s / RPG; u.e = moe_find_e(T, RT); u.idx = i; return true;
    }
    __device__ __forceinline__ const char* a_base(const pg8::Unit& u) const { return UP ? (const char*)A : (const char*)A + (size_t)u.pm * 256 * 2048; }
    __device__ __forceinline__ const char* b_base(const pg8::Unit& u) const { return (const char*)Bt + ((size_t)u.e * (UP ? 2048 : 1024) + (size_t)u.pn * 256) * 2048; }
    __device__ __forceinline__ void a_off(const pg8::Unit& u, const int (&R)[2], const int (&C)[2], unsigned (&v)[2][2]) const {
#pragma unroll
        for (int h = 0; h < 2; ++h)
#pragma unroll
            for (int i = 0; i < 2; ++i) v[h][i] = UP ? (unsigned)T.rowoff[u.idx * 256 + h * 128 + R[i]] + (unsigned)C[i] * 2u : (unsigned)((h * 128 + R[i]) * 1024 + C[i]) * 2u;
    }
    __device__ __forceinline__ void prepare() const {
        if (UP) {
            pg8::Unit u;
            for (int i = 0; next(i, u); ++i) {
                if (threadIdx.x < 256) { const int r = (u.pm - T.tb[u.e]) * 256 + (int)threadIdx.x; const int ent = list[(size_t)u.e * NTOK + (r < T.cn[u.e] ? r : 0)]; T.rowoff[i * 256 + threadIdx.x] = (ent >> 2) * 2048; }
            }
        }
        __syncthreads();
    }
    __device__ __forceinline__ void epi(const f32x4 (&acc)[2][2][4][2], const pg8::Unit& u, int wr, int wc, int fr, int fq) const {
        const int rl0 = wr * 64 + fr, col0 = u.pn * 256 + wc * 32 + 8 * fq;
        if (UP) {
            const float* bp = bias + (size_t)u.e * 2048 + col0;
            f32x4 bv[2][2];
#pragma unroll
            for (int bj = 0; bj < 2; ++bj) { bv[bj][0] = *(const f32x4*)(bp + bj * 128); bv[bj][1] = *(const f32x4*)(bp + bj * 128 + 4); }
#pragma unroll
            for (int ai = 0; ai < 2; ++ai)
#pragma unroll
                for (int m = 0; m < 4; ++m) {
                    u16* rowp = out + (size_t)(u.pm * 256 + rl0 + ai * 128 + m * 16) * 1024 + (col0 >> 1);
#pragma unroll
                    for (int bj = 0; bj < 2; ++bj) {
                        const f32x4 v0 = acc[ai][bj][m][0] + bv[bj][0], v1 = acc[ai][bj][m][1] + bv[bj][1];
                        float a[4];
#pragma unroll
                        for (int p = 0; p < 4; ++p) {
                            const float glu = p < 2 ? v0[2 * p] : v1[2 * p - 4], lin = p < 2 ? v0[2 * p + 1] : v1[2 * p - 3];
                            const float xg = fminf(glu, 7.0f), xl = fminf(fmaxf(lin, -7.0f), 7.0f);
                            a[p] = xg * __builtin_amdgcn_rcpf(1.0f + __builtin_amdgcn_exp2f(-1.702f * LOG2E * xg)) * (xl + 1.0f);
                        }
                        u32x2 w; w.x = pg8::cvt_pk_bf16(a[0], a[1]); w.y = pg8::cvt_pk_bf16(a[2], a[3]);
                        *(u32x2*)(rowp + bj * 64) = w;
                    }
                }
        } else {
            const float* bp = bias + (size_t)u.e * 1024 + col0;
            f32x4 bv[2][2];
#pragma unroll
            for (int bj = 0; bj < 2; ++bj) { bv[bj][0] = *(const f32x4*)(bp + bj * 128); bv[bj][1] = *(const f32x4*)(bp + bj * 128 + 4); }
            const int rbase = (u.pm - T.tb[u.e]) * 256, cnt = T.cn[u.e];
#pragma unroll
            for (int ai = 0; ai < 2; ++ai)
#pragma unroll
                for (int m = 0; m < 4; ++m) {
                    const int r = rbase + rl0 + ai * 128 + m * 16;
                    if (r < cnt) {
                        const int ent = list[(size_t)u.e * NTOK + r]; const float gt = gate[ent];
                        u16* rowp = out + (size_t)ent * 1024 + col0;
#pragma unroll
                        for (int bj = 0; bj < 2; ++bj) {
                            const f32x4 v0 = (acc[ai][bj][m][0] + bv[bj][0]) * gt, v1 = (acc[ai][bj][m][1] + bv[bj][1]) * gt;
                            u32x4 w; w.x = pg8::cvt_pk_bf16(v0[0], v0[1]); w.y = pg8::cvt_pk_bf16(v0[2], v0[3]); w.z = pg8::cvt_pk_bf16(v1[0], v1[1]); w.w = pg8::cvt_pk_bf16(v1[2], v1[3]);
                            *(u32x4*)(rowp + bj * 128) = w;
                        }
                    }
                }
        }
    }
};

struct Frame {
    LAS unsigned char* lds; volatile LAS unsigned* MISC; gu32* ctl; int tid, lane, wave, G, bid;
};
__device__ __forceinline__ void p0_transpose_item(const float* W, int K, int N, u16* WT, LAS float* scr, int item, int lane) {
    const int nblk = N / 32, kb = item / nblk, nb = item % nblk, k0 = 64 * kb, n0 = 32 * nb;
    f32x4 v[8];
#pragma unroll
    for (int it = 0; it < 8; ++it) v[it] = *(const f32x4*)(W + (size_t)(k0 + (lane >> 3) + 8 * it) * N + n0 + (lane & 7) * 4);
#pragma unroll
    for (int it = 0; it < 8; ++it) { const int k = (lane >> 3) + 8 * it, n4 = (lane & 7) * 4; scr[(n4 + 0) * 68 + k] = v[it].x; scr[(n4 + 1) * 68 + k] = v[it].y; scr[(n4 + 2) * 68 + k] = v[it].z; scr[(n4 + 3) * 68 + k] = v[it].w; }
    LDS_WAIT(); asm volatile("" ::: "memory");
#pragma unroll
    for (int it = 0; it < 4; ++it) {
        const int n = (lane >> 3) + 8 * it, c = lane & 7; const LAS float* s = scr + n * 68 + 8 * c;
        const f32x4 a = *(const LAS f32x4*)s, b = *(const LAS f32x4*)(s + 4);
        u32x4 o; o.x = pk2(a.x, a.y); o.y = pk2(a.z, a.w); o.z = pk2(b.x, b.y); o.w = pk2(b.z, b.w);
        *(u32x4*)(WT + (size_t)(n0 + n) * K + k0 + 8 * c) = o;
    }
    LDS_WAIT(); asm volatile("" ::: "memory");
}
__device__ __forceinline__ void ln_row_in(const float* xrow, const float* g, const float* b, u16* orow, int lane) {
    const f32x4* xr = (const f32x4*)xrow + lane;
    f32x4 v[4]; float s = 0.f;
#pragma unroll
    for (int j = 0; j < 4; ++j) { v[j] = xr[64 * j]; s += (v[j].x + v[j].y) + (v[j].z + v[j].w); }
    const float mean = wave_sum(s) * (1.f / DM); float s2 = 0.f;
#pragma unroll
    for (int j = 0; j < 4; ++j) { v[j] = v[j] - mean; s2 += (v[j].x * v[j].x + v[j].y * v[j].y) + (v[j].z * v[j].z + v[j].w * v[j].w); }
    const float rstd = 1.f / sqrtf(wave_sum(s2) * (1.f / DM) + LN_EPS);
    u32x2* o8 = (u32x2*)orow + lane;
#pragma unroll
    for (int j = 0; j < 4; ++j) {
        const f32x4 gg = ((const f32x4*)g)[lane + 64 * j], bb = ((const f32x4*)b)[lane + 64 * j];
        u32x2 w; w.x = pk2(v[j].x * rstd * gg.x + bb.x, v[j].y * rstd * gg.y + bb.y); w.y = pk2(v[j].z * rstd * gg.z + bb.z, v[j].w * rstd * gg.w + bb.w);
        o8[64 * j] = w;
    }
}

struct Args { const float* in[21]; float* out; unsigned char* ws; int ph_lo, ph_hi, li, pad; };

__device__ __forceinline__ void p0_prologue(const Frame& F, const Args& a) {
    unsigned char* ws = a.ws;
    u16* WIN = (u16*)(ws + WS_WIN); u16* WOUT = (u16*)(ws + WS_WOUT); u16* W1T = (u16*)(ws + WS_W1); u16* W2T = (u16*)(ws + WS_W2); u16* H0 = (u16*)(ws + WS_H0);
    LAS float* scr = (LAS float*)(F.lds + RING_OFF + F.wave * 8704);
    const int gw = F.bid * NWAVES + F.wave, NGW = F.G * NWAVES;
    constexpr int I_IN = 16 * 96, I_OUT = 16 * 32, I_W1 = 16 * 64, I_W2 = 16 * 32;
    constexpr int NITEMS = I_IN + I_OUT + NEXP * I_W1 + NEXP * I_W2;
    for (int it = gw; it < NITEMS; it += NGW) {
        int r = it;
        if (r < I_IN) { p0_transpose_item(a.in[3], 1024, 3072, WIN, scr, r, F.lane); continue; } r -= I_IN;
        if (r < I_OUT) { p0_transpose_item(a.in[10], 1024, 1024, WOUT, scr, r, F.lane); continue; } r -= I_OUT;
        if (r < NEXP * I_W1) { const int e = r / I_W1; p0_transpose_item(a.in[15] + (size_t)e * 1024 * 2048, 1024, 2048, W1T + (size_t)e * 1024 * 2048, scr, r % I_W1, F.lane); continue; } r -= NEXP * I_W1;
        { const int e = r / I_W2; p0_transpose_item(a.in[17] + (size_t)e * 1024 * 1024, 1024, 1024, W2T + (size_t)e * 1024 * 1024, scr, r % I_W2, F.lane); }
    }
    for (int m = gw; m < NTOK; m += NGW) ln_row_in(a.in[0] + (size_t)m * DM, a.in[1], a.in[2], H0 + (size_t)m * DM, F.lane);
}

__device__ __forceinline__ void p4_router(const Frame& F, const Args& a) {
    unsigned char* ws = a.ws;
    const u16* U = (const u16*)(ws + WS_U); u16* H1 = (u16*)(ws + WS_H1); int* LIST = (int*)(ws + WS_LIST); float* GATE = (float*)(ws + WS_GATE); int* CNT = (int*)(F.ctl + CW_CNT);
    const float* g1 = a.in[11]; const float* b1 = a.in[12]; const float* rw = a.in[13]; const float* rb = a.in[14];
    LAS int* lcnt = (LAS int*)(F.lds + RING_OFF);
    LAS int* lbase = lcnt + 32; LAS int* ent_e = lcnt + 64; LAS int* ent_p = ent_e + 512;
    const int lane = F.lane;
    for (int batch = F.bid; batch < NTOK / 128; batch += F.G) {
        __syncthreads();
        if (F.tid < 32) lcnt[F.tid] = 0;
        __syncthreads();
        for (int j = 0; j < 16; ++j) {
            const int tl = F.wave * 16 + j, t = batch * 128 + tl;
            const u32x2* ur = (const u32x2*)(U + (size_t)t * DM) + lane;
            float v[16]; float s = 0.f;
#pragma unroll
            for (int q = 0; q < 4; ++q) { const u32x2 w = ur[64 * q]; v[4 * q] = __uint_as_float(w.x << 16); v[4 * q + 1] = __uint_as_float(w.x & 0xffff0000u); v[4 * q + 2] = __uint_as_float(w.y << 16); v[4 * q + 3] = __uint_as_float(w.y & 0xffff0000u);
                s += (v[4 * q] + v[4 * q + 1]) + (v[4 * q + 2] + v[4 * q + 3]); }
            const float mean = wave_sum(s) * (1.f / DM); float s2 = 0.f;
#pragma unroll
            for (int i = 0; i < 16; ++i) { v[i] -= mean; s2 += v[i] * v[i]; }
            const float rstd = 1.f / sqrtf(wave_sum(s2) * (1.f / DM) + LN_EPS);
            u32x2* o8 = (u32x2*)(H1 + (size_t)t * DM) + lane;
#pragma unroll
            for (int q = 0; q < 4; ++q) {
                const f32x4 gg = ((const f32x4*)g1)[lane + 64 * q], bb = ((const f32x4*)b1)[lane + 64 * q];
                v[4 * q] = v[4 * q] * rstd * gg.x + bb.x; v[4 * q + 1] = v[4 * q + 1] * rstd * gg.y + bb.y; v[4 * q + 2] = v[4 * q + 2] * rstd * gg.z + bb.z; v[4 * q + 3] = v[4 * q + 3] * rstd * gg.w + bb.w;
                u32x2 w; w.x = pk2(v[4 * q], v[4 * q + 1]); w.y = pk2(v[4 * q + 2], v[4 * q + 3]); o8[64 * q] = w;
            }
            float lg[32];
#pragma unroll
            for (int e = 0; e < 32; ++e) lg[e] = 0.f;
#pragma unroll
            for (int q = 0; q < 4; ++q)
#pragma unroll
                for (int p = 0; p < 4; ++p) {
                    const int col = lane * 4 + 256 * q + p; const f32x4* w = (const f32x4*)(rw + (size_t)col * 32); const float hv = v[4 * q + p];
#pragma unroll
                    for (int k = 0; k < 8; ++k) { const f32x4 wv = w[k]; lg[4 * k] += hv * wv.x; lg[4 * k + 1] += hv * wv.y; lg[4 * k + 2] += hv * wv.z; lg[4 * k + 3] += hv * wv.w; }
                }
#pragma unroll
            for (int e = 0; e < 32; ++e) lg[e] = wave_sum(lg[e]) + rb[e];
            unsigned used = 0u; float tv[4]; int ti[4];
#pragma unroll
            for (int k = 0; k < 4; ++k) {
                float best = -INFINITY; int bi = 0;
#pragma unroll
                for (int e = 0; e < 32; ++e) { const bool ok = !((used >> e) & 1u) && lg[e] > best; best = ok ? lg[e] : best; bi = ok ? e : bi; }
                used |= 1u << bi; tv[k] = best; ti[k] = bi;
            }
            const float e1 = __expf(tv[1] - tv[0]), e2 = __expf(tv[2] - tv[0]), e3 = __expf(tv[3] - tv[0]);
            const float inv = 1.f / (1.f + e1 + e2 + e3);
            if (lane < 4) {
                const int me = lane == 0 ? ti[0] : lane == 1 ? ti[1] : lane == 2 ? ti[2] : ti[3];
                const float mg = (lane == 0 ? 1.f : lane == 1 ? e1 : lane == 2 ? e2 : e3) * inv;
                const int pos = __hip_atomic_fetch_add(lcnt + me, 1, __ATOMIC_RELAXED, __HIP_MEMORY_SCOPE_WORKGROUP);
                ent_e[tl * 4 + lane] = me; ent_p[tl * 4 + lane] = pos; GATE[t * 4 + lane] = mg;
            }
        }
        __syncthreads();
        if (F.tid < 32) lbase[F.tid] = atomicAdd(CNT + F.tid, lcnt[F.tid]);
        __syncthreads();
        { const int e = ent_e[F.tid]; LIST[(size_t)e * NTOK + lbase[e] + ent_p[F.tid]] = (batch * 128 + (F.tid >> 2)) * 4 + (F.tid & 3); }
    }
}

__device__ __forceinline__ void p7_final(const Frame& F, const Args& a) {
    const u16* H1 = (const u16*)(a.ws + WS_H1); const u16* YS = (const u16*)(a.ws + WS_YS); const float* g2 = a.in[19]; const float* b2 = a.in[20];
    const int lane = F.lane, gw = F.bid * NWAVES + F.wave, NGW = F.G * NWAVES;
    for (int t = gw; t < NTOK; t += NGW) {
        float v[16]; float s = 0.f;
#pragma unroll
        for (int j = 0; j < 4; ++j) {
            const u32x2 w = ((const u32x2*)(H1 + (size_t)t * DM) + lane)[64 * j];
            float a0 = DN_ALPHA * __uint_as_float(w.x << 16), a1 = DN_ALPHA * __uint_as_float(w.x & 0xffff0000u), a2 = DN_ALPHA * __uint_as_float(w.y << 16), a3 = DN_ALPHA * __uint_as_float(w.y & 0xffff0000u);
#pragma unroll
            for (int k = 0; k < 4; ++k) {
                const u32x2 y = ((const u32x2*)(YS + ((size_t)t * 4 + k) * DM) + lane)[64 * j];
                a0 += __uint_as_float(y.x << 16); a1 += __uint_as_float(y.x & 0xffff0000u); a2 += __uint_as_float(y.y << 16); a3 += __uint_as_float(y.y & 0xffff0000u);
            }
            v[4 * j] = a0; v[4 * j + 1] = a1; v[4 * j + 2] = a2; v[4 * j + 3] = a3; s += (a0 + a1) + (a2 + a3);
        }
        const float mean = wave_sum(s) * (1.f / DM); float s2 = 0.f;
#pragma unroll
        for (int i = 0; i < 16; ++i) { v[i] -= mean; s2 += v[i] * v[i]; }
        const float rstd = 1.f / sqrtf(wave_sum(s2) * (1.f / DM) + LN_EPS);
        f32x4* o = (f32x4*)(a.out + (size_t)t * DM) + lane;
#pragma unroll
        for (int j = 0; j < 4; ++j) {
            const f32x4 gg = ((const f32x4*)g2)[lane + 64 * j], bb = ((const f32x4*)b2)[lane + 64 * j];
            o[64 * j] = (f32x4){v[4 * j] * rstd * gg.x + bb.x, v[4 * j + 1] * rstd * gg.y + bb.y, v[4 * j + 2] * rstd * gg.z + bb.z, v[4 * j + 3] * rstd * gg.w + bb.w};
        }
    }
}


namespace att {
typedef float f32x16 __attribute__((ext_vector_type(16)));
typedef short s16x4 __attribute__((ext_vector_type(4)));
typedef short v4i16_t __attribute__((ext_vector_type(4)));
constexpr int KV_BUF = 32768, X_OFF = 65536, WSF_OFF = TAB_OFF, TBL_OFF = TAB_OFF + 2048;
constexpr float THR = 6.0f;
__device__ __forceinline__ int crow(int r, int hi) { return (r & 3) + 8 * (r >> 2) + 4 * hi; }
__device__ __forceinline__ unsigned cvtpk(float lo, float hi) { typedef float f2 __attribute__((ext_vector_type(2))); typedef __bf16 b2 __attribute__((ext_vector_type(2))); f2 v = {lo, hi}; b2 b = __builtin_convertvector(v, b2); return __builtin_bit_cast(unsigned, b); }
__device__ __forceinline__ s16x4 vtr(LAS const unsigned char* p) { return __builtin_bit_cast(s16x4, __builtin_amdgcn_ds_read_tr16_b64_v4i16((LAS v4i16_t*)p)); }
__device__ __forceinline__ float swapmax(float m) { auto rr = __builtin_amdgcn_permlane32_swap(__float_as_uint(m), __float_as_uint(m), false, false); return fmaxf(__uint_as_float(rr[0]), __uint_as_float(rr[1])); }
__device__ __forceinline__ float swapsum(float m) { auto rr = __builtin_amdgcn_permlane32_swap(__float_as_uint(m), __float_as_uint(m), false, false); return __uint_as_float(rr[0]) + __uint_as_float(rr[1]); }

template <bool ISA>
__device__ __forceinline__ void attn_unit(const Frame& F, const u16* QKV, u16* O, int b, int hx, int jq, float lam, const float* subg, const float* relb) {
    constexpr int DVB = ISA ? 4 : 2;
    const int lane = F.lane, w = F.wave, sub = w >> 2, rg = w & 3, r32 = lane & 31, hi = lane >> 5;
    const int q0 = jq * 128, cq = 2 * jq + (rg >> 1);
    const int qpos = q0 + rg * 32 + r32;
    const size_t tok0 = (size_t)b * SEQ;
    const int qcol = (ISA ? hx * 128 : 1536 + hx * 128) + sub * 64;
    const int kcol0 = ISA ? 512 + hx * 128 : 2048 + hx * 128, vcol0 = ISA ? 1024 + hx * 128 : 2560 + hx * 128;
    const int ktop = 2 * jq + 1, kbot = ISA ? 0 : (2 * jq - 8 > 0 ? 2 * jq - 8 : 0);
    const int NTs = ktop - kbot + 1;
    LAS unsigned char* lds = F.lds;
    unsigned soff[2];
#pragma unroll
    for (int i = 0; i < 2; ++i) { const unsigned row = 4u * (8u * i + w) + (lane >> 4); const unsigned f = ((row & 3u) << 2) | ((row >> 2) & 3u); soff[i] = row * (QKVP * 2) + (((unsigned)lane & 15u) ^ f) * 16u; }
    const char* kvbase = (const char*)QKV + (tok0 * QKVP + kcol0) * 2;
    const unsigned ldsw = (unsigned)w * 1024u;
#define ATT_ISSUE(kt, buf) do { const char* kb_ = kvbase + (size_t)(kt) * 64 * QKVP * 2; const char* vb_ = kb_ + (vcol0 - kcol0) * 2; \
        _Pragma("unroll") for (int i_ = 0; i_ < 2; ++i_) { \
            __builtin_amdgcn_global_load_lds((const unsigned*)(kb_ + soff[i_]), (LAS unsigned*)(lds + (buf) * KV_BUF + i_ * 8192 + ldsw), 16, 0, 0); \
            __builtin_amdgcn_global_load_lds((const unsigned*)(vb_ + soff[i_]), (LAS unsigned*)(lds + (buf) * KV_BUF + 16384 + i_ * 8192 + ldsw), 16, 0, 0); } } while (0)
    ATT_ISSUE(ktop, 0);
    if (!ISA) {
        LAS float* tbl = (LAS float*)(lds + TBL_OFF);
        for (int i = F.tid; i < 1280; i += NTHR) { const int hd = i / 640, idx = i % 640; int rel = idx - 64; rel = rel < -256 ? -256 : (rel > 256 ? 256 : rel); tbl[i] = relb[(2 * hx + hd) * 513 + rel + 256] * LOG2E; }
    }
    bf16x8 qf[4];
    { const u16* qp = QKV + (tok0 + q0 + rg * 32 + r32) * QKVP + qcol + 8 * hi;
#pragma unroll
      for (int s = 0; s < 4; ++s) qf[s] = *(const bf16x8*)(qp + 16 * s); }
    const unsigned fr_ = ((r32 & 3u) << 2) | ((r32 >> 2) & 3u);
    unsigned kad[4];
#pragma unroll
    for (int s = 0; s < 4; ++s) kad[s] = 256u * r32 + 16u * ((8u * sub + 2u * s + hi) ^ fr_);
    const unsigned qd = (lane & 15) >> 2, pd = lane & 3, blk = (lane >> 4) & 1, xlow = 2 * blk + (pd >> 1);
    unsigned vad[DVB][2];
#pragma unroll
    for (int c = 0; c < DVB; ++c)
#pragma unroll
        for (int t = 0; t < 2; ++t) { const unsigned ci = ISA ? (unsigned)c : (unsigned)(2 * sub + c);
            vad[c][t] = 2048u * t + 256u * (4u * hi + qd) + 64u * (ci ^ qd) + 16u * (xlow ^ ((2u * t + hi) & 3u)) + 8u * (pd & 1u); }
    const float sl2 = ISA ? exp2f(-2.0f * (float)(hx + 1)) * LOG2E : 0.f;
    LAS float* wsf = (LAS float*)(lds + WSF_OFF) + w * 64;
    float mrun = -INFINITY, lrun = 0.f;
    f32x16 o[DVB];
#pragma unroll
    for (int c = 0; c < DVB; ++c)
#pragma unroll
        for (int r = 0; r < 16; ++r) o[c][r] = 0.f;

    for (int i = 0; i < NTs; ++i) {
        const int kt = ktop - i, buf = i & 1;
        asm volatile("s_waitcnt vmcnt(0)" ::: "memory");
        __syncthreads();
        if (i + 1 < NTs) ATT_ISSUE(kt - 1, buf ^ 1);
        const bool active = ISA ? (kt <= cq) : (kt <= cq && kt >= cq - 8);
        if (active) {
            LAS const unsigned char* kbuf = lds + buf * KV_BUF; LAS const unsigned char* vbuf = kbuf + 16384;
            f32x16 p0, p1;
#pragma unroll
            for (int r = 0; r < 16; ++r) { p0[r] = 0.f; p1[r] = 0.f; }
#pragma unroll
            for (int s = 0; s < 4; ++s) {
                const bf16x8 k0 = *(const LAS bf16x8*)(kbuf + kad[s]);
                const bf16x8 k1 = *(const LAS bf16x8*)(kbuf + kad[s] + 8192);
                p0 = __builtin_amdgcn_mfma_f32_32x32x16_bf16(k0, qf[s], p0, 0, 0, 0);
                p1 = __builtin_amdgcn_mfma_f32_32x32x16_bf16(k1, qf[s], p1, 0, 0, 0);
            }
            if (ISA) {
                const float dl = (float)(kt * 64 + 4 * hi - qpos);
#pragma unroll
                for (int r = 0; r < 16; ++r) { const float kc = (float)((r & 3) + 8 * (r >> 2)); p0[r] = fmaf(-sl2, fabsf(dl + kc), p0[r]); p1[r] = fmaf(-sl2, fabsf(dl + kc + 32.0f), p1[r]); }
            } else {
                LAS const float* tb = (LAS const float*)(lds + TBL_OFF) + sub * 640 + (qpos + 64 - kt * 64 - 4 * hi - 63);
#pragma unroll
                for (int r = 0; r < 16; ++r) { const int kc = (r & 3) + 8 * (r >> 2); p0[r] += tb[63 - kc]; p1[r] += tb[63 - 32 - kc]; }
            }
            float mx = fmaxf(p0[0], p1[0]);
#pragma unroll
            for (int r = 1; r < 16; ++r) mx = fmaxf(mx, fmaxf(p0[r], p1[r]));
            const float mt = swapmax(mx);
            if (__any(mt > mrun + THR)) {
                const float mnew = fmaxf(mrun, mt), alpha = __builtin_amdgcn_exp2f(mrun - mnew);
                lrun *= alpha; mrun = mnew;
                if (hi == 0) wsf[r32] = alpha;
#pragma unroll
                for (int r = 0; r < 16; ++r) { const float a_ = wsf[crow(r, hi)];
#pragma unroll
                    for (int c = 0; c < DVB; ++c) o[c][r] *= a_; }
            }
            float ps = 0.f;
#pragma unroll
            for (int r = 0; r < 16; ++r) { p0[r] = __builtin_amdgcn_exp2f(p0[r] - mrun); p1[r] = __builtin_amdgcn_exp2f(p1[r] - mrun); ps += p0[r] + p1[r]; }
            lrun += ps;
            u32x4 pw[4];
#pragma unroll
            for (int q = 0; q < 4; ++q) { pw[0][q] = cvtpk(p0[2 * q], p0[2 * q + 1]); pw[1][q] = cvtpk(p0[8 + 2 * q], p0[8 + 2 * q + 1]); pw[2][q] = cvtpk(p1[2 * q], p1[2 * q + 1]); pw[3][q] = cvtpk(p1[8 + 2 * q], p1[8 + 2 * q + 1]); }
#pragma unroll
            for (int c = 0; c < DVB; ++c)
#pragma unroll
                for (int ks = 0; ks < 4; ++ks) {
                    const s16x4 lo = vtr(vbuf + vad[c][0] + 4096 * ks), h4 = vtr(vbuf + vad[c][1] + 4096 * ks);
                    const bf16x8 vf = (bf16x8){lo[0], lo[1], lo[2], lo[3], h4[0], h4[1], h4[2], h4[3]};
                    o[c] = __builtin_amdgcn_mfma_f32_32x32x16_bf16(__builtin_bit_cast(bf16x8, pw[ks]), vf, o[c], 0, 0, 0);
                }
        }
    }
    { const float lt = swapsum(lrun); const float inv = 1.0f / lt;
      if (hi == 0) wsf[r32] = inv;
#pragma unroll
      for (int r = 0; r < 16; ++r) { const float a_ = wsf[crow(r, hi)];
#pragma unroll
          for (int c = 0; c < DVB; ++c) o[c][r] *= a_; } }
    __syncthreads();
    if (ISA) {
        LAS float* X = (LAS float*)(lds + X_OFF) + rg * 4096;
        if (sub == 1) {
#pragma unroll
            for (int c = 0; c < 4; ++c)
#pragma unroll
                for (int r = 0; r < 16; ++r) X[(c * 16 + r) * 64 + lane] = o[c][r];
        }
        __syncthreads();
        if (sub == 0) {
            float ss[16];
#pragma unroll
            for (int r = 0; r < 16; ++r) ss[r] = 0.f;
#pragma unroll
            for (int c = 0; c < 4; ++c)
#pragma unroll
                for (int r = 0; r < 16; ++r) { const float y = o[c][r] - lam * X[(c * 16 + r) * 64 + lane]; o[c][r] = y; ss[r] += y * y; }
#pragma unroll
            for (int r = 0; r < 16; ++r) {
                float v = ss[r];
                v += __shfl_xor(v, 1); v += __shfl_xor(v, 2); v += __shfl_xor(v, 4); v += __shfl_xor(v, 8); v += __shfl_xor(v, 16);
                ss[r] = 0.8f / sqrtf(v * (1.0f / 128.0f) + 1e-5f);
            }
            float gg[4];
#pragma unroll
            for (int c = 0; c < 4; ++c) gg[c] = subg[32 * c + r32];
            LAS u16* stg = (LAS u16*)(lds + X_OFF + rg * 16384);
            asm volatile("s_waitcnt lgkmcnt(0)" ::: "memory");
#pragma unroll
            for (int c = 0; c < 4; ++c)
#pragma unroll
                for (int r = 0; r < 16; ++r) stg[crow(r, hi) * 128 + 32 * c + r32] = f2bf(o[c][r] * ss[r] * gg[c]);
            asm volatile("s_waitcnt lgkmcnt(0)" ::: "memory");
            u16* og = O + (tok0 + q0 + rg * 32) * DM + hx * 128;
#pragma unroll
            for (int i = 0; i < 8; ++i) { const int row = 4 * i + (lane >> 4), ch = lane & 15; const u32x4 v = *(const LAS u32x4*)((LAS const unsigned char*)stg + row * 256 + ch * 16); *(u32x4*)(og + (size_t)row * DM + ch * 8) = v; }
        }
    } else {
        LAS u16* stg = (LAS u16*)(lds + X_OFF + w * 4096);
#pragma unroll
        for (int c = 0; c < 2; ++c)
#pragma unroll
            for (int r = 0; r < 16; ++r) stg[crow(r, hi) * 64 + 32 * c + r32] = f2bf(o[c][r]);
        asm volatile("s_waitcnt lgkmcnt(0)" ::: "memory");
        u16* og = O + (tok0 + q0 + rg * 32) * DM + 512 + (2 * hx + sub) * 64;
#pragma unroll
        for (int i = 0; i < 4; ++i) { const int row = 8 * i + (lane >> 3), ch = lane & 7; const u32x4 v = *(const LAS u32x4*)((LAS const unsigned char*)stg + row * 128 + ch * 16); *(u32x4*)(og + (size_t)row * DM + ch * 8) = v; }
    }
    __syncthreads();
#undef ATT_ISSUE
}

__device__ __forceinline__ void p2_attention(const Frame& F, const Args& a) {
    const u16* QKV = (const u16*)(a.ws + WS_QKV); u16* O = (u16*)(a.ws + WS_O);
    float d1 = 0.f, d2 = 0.f;
    for (int i = 0; i < 64; ++i) { d1 += a.in[4][i] * a.in[5][i]; d2 += a.in[6][i] * a.in[7][i]; }
    const float lam = expf(d1) - expf(d2) + 0.2f;
    const int vcu = (F.G % 8 == 0) ? (F.bid % 8) * (F.G / 8) + F.bid / 8 : F.bid;
    for (int g = vcu; g < 256; g += F.G) {
        const int grp = g >> 3, s = g & 7, b = grp >> 2, hx = grp & 3;
        for (int i = 0; i < 4; ++i) { const int jq = i == 0 ? 31 - s : i == 1 ? 16 + s : i == 2 ? 15 - s : s; attn_unit<true>(F, QKV, O, b, hx, jq, lam, a.in[8], a.in[9]); }
        for (int i = 0; i < 4; ++i) { const int jq = i == 0 ? 31 - s : i == 1 ? 16 + s : i == 2 ? 15 - s : s; attn_unit<false>(F, QKV, O, b, hx, jq, lam, a.in[8], a.in[9]); }
    }
}
}
__global__ void __launch_bounds__(NTHR, 2) mk_fwd(Args args) {
    extern __shared__ __attribute__((aligned(16))) unsigned char lds_raw[];
    Frame F;
    F.lds = (LAS unsigned char*)lds_raw; F.MISC = (volatile LAS unsigned*)(F.lds + MISC_OFF);
    F.tid = threadIdx.x; F.lane = F.tid & 63; F.wave = __builtin_amdgcn_readfirstlane(F.tid >> 6); F.G = gridDim.x; F.bid = blockIdx.x;
    F.ctl = (gu32*)(args.ws + WS_CTL);
    for (int u = F.tid; u < 256; u += NTHR) ((LAS unsigned*)(F.lds + MISC_OFF))[u] = 0u;
    __syncthreads();
    const int lo = args.ph_lo, hi = args.ph_hi;
    const bool multi = (hi - lo) > 1;
    XcdBarrier bar; bar.bar = (unsigned*)(F.ctl + CW_BAR) + args.li * XCD_BAR_WORDS; bar.x = 0; bar.st = nullptr;
    if (multi) bar = xcd_barrier_post((unsigned*)(F.ctl + CW_BAR) + args.li * XCD_BAR_WORDS, F.MISC + 8);
#define IN(k) (lo <= (k) && (k) < hi)
#define SEAM(k) do { if (IN(k) && IN((k) + 1)) xcd_barrier(bar); } while (0)
    unsigned char* ws = args.ws;
    if (IN(0)) { p0_prologue(F, args); SEAM(0); }
    if (IN(1)) {
        PDense S; S.A = (const u16*)(ws + WS_H0); S.Bt = (const u16*)(ws + WS_WIN); S.out = (u16*)(ws + WS_QKV); S.H0 = nullptr; S.mode = 0; S.ord.init(NTOK, QKVP, F.G, F.bid);
        pg8::gemm_phase(F.lds + RING_OFF, S); SEAM(1);
    }
    if (IN(2)) { att::p2_attention(F, args); SEAM(2); }
    if (IN(3)) {
        PDense S; S.A = (const u16*)(ws + WS_O); S.Bt = (const u16*)(ws + WS_WOUT); S.out = (u16*)(ws + WS_U); S.H0 = (const u16*)(ws + WS_H0); S.mode = 1; S.ord.init(NTOK, DM, F.G, F.bid);
        pg8::gemm_phase(F.lds + RING_OFF, S); SEAM(3);
    }
    if (IN(4)) { p4_router(F, args); SEAM(4); }
    if (IN(5)) {
        const MoeTab T = moe_tab(F.lds); moe_tables(T, (const int*)(F.ctl + CW_CNT));
        PMoe<1> S; S.A = (const u16*)(ws + WS_H1); S.Bt = (const u16*)(ws + WS_W1); S.out = (u16*)(ws + WS_ACT); S.list = (const int*)(ws + WS_LIST); S.gate = nullptr; S.bias = args.in[16]; S.T = T; S.c = F.bid;
        S.prepare();
        pg8::gemm_phase(F.lds + RING_OFF, S); SEAM(5);
    }
    if (IN(6)) {
        const MoeTab T = moe_tab(F.lds); moe_tables(T, (const int*)(F.ctl + CW_CNT));
        PMoe<0> S; S.A = (const u16*)(ws + WS_ACT); S.Bt = (const u16*)(ws + WS_W2); S.out = (u16*)(ws + WS_YS); S.list = (const int*)(ws + WS_LIST); S.gate = (const float*)(ws + WS_GATE); S.bias = args.in[18]; S.T = T; S.c = F.bid;
        S.prepare();
        pg8::gemm_phase(F.lds + RING_OFF, S); SEAM(6);
    }
    if (IN(7)) { p7_final(F, args); }
#undef IN
#undef SEAM
}

extern "C" void kernel_launch(void* const* d_in, const int* in_sizes, int n_in, void* d_out, int out_size, void* d_ws, size_t ws_size, hipStream_t stream) {
    static int grid = 0;
    if (grid == 0) {
        if (n_in != 21 || in_sizes[0] != NTOK * DM || out_size != NTOK * DM || ws_size < WS_END) { fprintf(stderr, "kernel_launch: unexpected shapes / workspace (%d inputs, ws %zu)\n", n_in, ws_size); grid = -1; return; }
        int dev = 0, cus = 0, per_cu = 0;
        if (hipGetDevice(&dev) != hipSuccess || hipDeviceGetAttribute(&cus, hipDeviceAttributeMultiprocessorCount, dev) != hipSuccess) { grid = -1; return; }
        if (hipFuncSetAttribute((const void*)mk_fwd, hipFuncAttributeMaxDynamicSharedMemorySize, LDS_BYTES) != hipSuccess) { fprintf(stderr, "kernel_launch: hipFuncSetAttribute failed\n"); grid = -1; return; }
        if (hipOccupancyMaxActiveBlocksPerMultiprocessor(&per_cu, (const void*)mk_fwd, NTHR, LDS_BYTES) != hipSuccess || per_cu < 1) { fprintf(stderr, "kernel_launch: occupancy query says %d blocks per CU\n", per_cu); (void)hipGetLastError(); grid = -1; return; }
        if (cus < 256) { fprintf(stderr, "kernel_launch: needs 256 CUs, device has %d\n", cus); grid = -1; return; }
        grid = 256;
    }
    if (grid < 0) return;
    const float* lq1 = (const float*)d_in[4]; const float* lk1 = (const float*)d_in[5]; const float* lq2 = (const float*)d_in[6]; const float* lk2 = (const float*)d_in[7];
    const float* subg = (const float*)d_in[8]; const float* relb = (const float*)d_in[9];
    char* ws = (char*)d_ws;
    u16* QKV = (u16*)(ws + WS_QKV); u16* O = (u16*)(ws + WS_O);
    (void)hipMemsetAsync(ws + WS_CTL, 0, CTL_BYTES, stream);
    Args a{};
    for (int i = 0; i < 21; ++i) a.in[i] = (const float*)d_in[i];
    a.out = (float*)d_out; a.ws = (unsigned char*)d_ws;
    int nl = 0;
    auto run = [&](int lo, int hi) { a.ph_lo = lo; a.ph_hi = hi; a.li = nl++; hipLaunchKernelGGL(mk_fwd, dim3(grid), dim3(NTHR), LDS_BYTES, stream, a); };
    run(0, 8);
}
```

```cpp
#define REP_MASK 0
#include <hip/hip_runtime.h>
#include <cstdint>
#include <cstdio>

typedef unsigned short u16;
typedef short bf16x8 __attribute__((ext_vector_type(8)));
typedef float f32x4 __attribute__((ext_vector_type(4)));
typedef unsigned u32x4 __attribute__((ext_vector_type(4)));
typedef unsigned u32x2 __attribute__((ext_vector_type(2)));
#define LAS __attribute__((address_space(3)))

constexpr int NTOK = 32768, DM = 1024, SEQ = 4096, NBATCH = 8;
constexpr int QKVP = 3072;
constexpr int NEXP = 32;
constexpr float LOG2E = 1.4426950408889634f;
constexpr float QSCALE = 0.125f * LOG2E;
constexpr float DN_ALPHA = 1.189207115002721f;
constexpr float LN_EPS = 1e-5f;

constexpr size_t MiB = 1u << 20;
constexpr size_t WS_CTL = 0, CTL_BYTES = 1 * MiB;
constexpr size_t WS_RWT = 1 * MiB;
constexpr size_t WS_WIN = 2 * MiB, WS_WOUT = 8 * MiB, WS_W1 = 16 * MiB, WS_W2 = 144 * MiB;
constexpr size_t WS_H1 = 208 * MiB, WS_LIST = 272 * MiB, WS_GATE = 276 * MiB;
constexpr size_t WS_H0 = 280 * MiB, WS_QKV = 344 * MiB, WS_O = 536 * MiB, WS_U = 344 * MiB, WS_ACT = 280 * MiB;
constexpr size_t WS_YS = 600 * MiB, WS_END = 856 * MiB;

__device__ __forceinline__ float bf2f(u16 v) { return __uint_as_float((unsigned)v << 16); }
__device__ __forceinline__ u16 f2bf(float f) { unsigned u = __float_as_uint(f); return (u16)((u + 0x7fffu + ((u >> 16) & 1u)) >> 16); }
__device__ __forceinline__ unsigned pk2(float lo, float hi) { return (unsigned)f2bf(lo) | ((unsigned)f2bf(hi) << 16); }
__device__ __forceinline__ float wave_sum(float v) {
#pragma unroll
    for (int o = 1; o < 64; o <<= 1) v += __shfl_xor(v, o);
    return v;
}


#define GAS __attribute__((address_space(1)))
typedef GAS unsigned gu32;
#define RLX_AGENT __ATOMIC_RELAXED, __HIP_MEMORY_SCOPE_AGENT
#define LDS_WAIT() asm volatile("s_waitcnt lgkmcnt(0)" ::: "memory")
#define VM_WAIT() asm volatile("s_waitcnt vmcnt(0)" ::: "memory")

constexpr int NWAVES = 8, NTHR = 512;
constexpr int RING_OFF = 0, RING_BYTES = 131072, TAB_OFF = 131072, TAB_BYTES = 24576, MISC_OFF = TAB_OFF + TAB_BYTES, LDS_BYTES = MISC_OFF + 1024;
constexpr int CW_CNT = 0;
constexpr int CW_BAR = 4096;

#define XB_TMO      128
#define XB_XCNT(j)  (256  + 64 * (j))
#define XB_XSUB(j)  (1280 + 64 * (j))
#define XB_XGEN(j)  (2304 + 64 * (j))
#define XB_TOP      3328
#define XB_TOPGEN   3392
#define XCD_BAR_WORDS 3456
#define XB_SPIN_CAP (1u << 20)
__device__ __forceinline__ unsigned xb_ld(unsigned* p)              { return __hip_atomic_load(p, __ATOMIC_RELAXED, __HIP_MEMORY_SCOPE_AGENT); }
__device__ __forceinline__ unsigned xb_add(unsigned* p, unsigned v) { return __hip_atomic_fetch_add(p, v, __ATOMIC_RELAXED, __HIP_MEMORY_SCOPE_AGENT); }
__device__ __forceinline__ unsigned xb_xcc_id() { return (unsigned)__builtin_amdgcn_s_getreg((3 << 11) | 20) & 0xFu; }
#define XB_SPIN(cond, bar) do { unsigned _sp = 0; while (cond) { __builtin_amdgcn_s_sleep(1); \
    if ((++_sp & 255u) == 0u) { if (xb_ld(&(bar)[XB_TMO])) break; if (_sp > XB_SPIN_CAP) { atomicAdd(&(bar)[XB_TMO], 1u); break; } } } } while (0)
struct XcdBarrier { unsigned* bar; unsigned x; volatile LAS unsigned* st; };
__device__ __forceinline__ XcdBarrier xcd_barrier_post(unsigned* bar, volatile LAS unsigned* st) {
    XcdBarrier b; b.bar = bar; b.x = xb_xcc_id(); b.st = st;
    if (threadIdx.x == 0) (void)xb_add(&bar[XB_XCNT(b.x)], 1u);
    return b;
}
__device__ __forceinline__ void xcd_barrier_complete(unsigned* bar, unsigned x, unsigned& nloc, unsigned& nx) {
    const unsigned G = gridDim.x * gridDim.y * gridDim.z;
    unsigned sum, cnt, mine, sp = 0u;
    for (;;) {
        sum = 0u; cnt = 0u; mine = 0u;
#pragma unroll
        for (unsigned j = 0; j < 16; ++j) { const unsigned c = xb_ld(&bar[XB_XCNT(j)]); sum += c; cnt += (c > 0u) ? 1u : 0u; mine = (j == x) ? c : mine; }
        if (sum == G) break;
        __builtin_amdgcn_s_sleep(1);
        if ((++sp & 255u) == 0u) { if (xb_ld(&bar[XB_TMO])) break; if (sp > XB_SPIN_CAP) { atomicAdd(&bar[XB_TMO], 1u); break; } }
    }
    nloc = mine > 0u ? mine : 1u; nx = cnt > 0u ? cnt : 1u;
}
__device__ __forceinline__ void xcd_barrier(const XcdBarrier& b) {
    asm volatile("s_waitcnt vmcnt(0)" ::: "memory");
    __syncthreads();
    if (threadIdx.x == 0) {
        unsigned* bar = b.bar;
        __builtin_amdgcn_s_waitcnt(0);
        unsigned nloc = b.st[0], nx = b.st[1];
        if (nloc == 0u) { xcd_barrier_complete(bar, b.x, nloc, nx); b.st[0] = nloc; b.st[1] = nx; }
        const unsigned old = xb_add(&bar[XB_XSUB(b.x)], 1u);
        const unsigned gen = old / nloc;
        if (old + 1u == (gen + 1u) * nloc) {
            __builtin_amdgcn_fence(__ATOMIC_RELEASE, "agent");
            asm volatile("s_waitcnt vmcnt(0)" ::: "memory");
            const unsigned og = xb_add(&bar[XB_TOP], 1u);
            const unsigned tg = og / nx;
            if (og + 1u == (tg + 1u) * nx) xb_add(&bar[XB_TOPGEN], 1u);
            else XB_SPIN(xb_ld(&bar[XB_TOPGEN]) == tg, bar);
            __builtin_amdgcn_fence(__ATOMIC_ACQUIRE, "agent");
            xb_add(&bar[XB_XGEN(b.x)], 1u);
            asm volatile("s_waitcnt vmcnt(0)" ::: "memory");
        } else {
            XB_SPIN(xb_ld(&bar[XB_XGEN(b.x)]) == gen, bar);
            __builtin_amdgcn_fence(__ATOMIC_ACQUIRE, "agent");
            asm volatile("s_waitcnt vmcnt(0)" ::: "memory");
        }
    }
    __syncthreads();
}

namespace pg8 {
constexpr int BM = 256, BK = 64, HALF = 128, HTB = HALF * BK * 2, NXCD = 8, WGM = 8, KD = 1024, NT = KD / BK;
__host__ __device__ __forceinline__ int lds_byte(int r, int c) { const int st = (r >> 4) * 2 + (c >> 5), rr = r & 15, cc = c & 31, ob = rr * 64 + cc * 2; return st * 1024 + (ob ^ (((ob >> 9) & 1) << 5)); }
__host__ __device__ __forceinline__ void stage_rc(int b, int& R, int& C) { const int st = b / 1024, sb = b % 1024, swz = sb ^ (((sb >> 9) & 1) << 5); R = (st >> 1) * 16 + swz / 64; C = (st & 1) * 32 + (swz % 64) / 2; }
__host__ __device__ __forceinline__ int perm32(int rho) { const int n = rho >> 4, i = rho & 15; return 8 * (i >> 2) + 4 * n + (i & 3); }
__device__ __forceinline__ unsigned cvt_pk_bf16(float lo, float hi) { unsigned r; asm volatile("v_cvt_pk_bf16_f32 %0, %1, %2" : "=v"(r) : "v"(lo), "v"(hi)); return r; }

struct Unit { int pm, pn, e, idx; };

struct StaticOrder {
    int nM, nN, nwg, G, c;
    __device__ void init(int M, int N, int G_, int c_) { nM = M / BM; nN = N / BM; nwg = nM * nN; G = G_; c = c_; }
    __device__ bool next(int i, Unit& u) const {
        const long L = (long)i * G + c; if (L >= nwg) return false;
        int wgid = (int)L; { const int q = nwg / NXCD, r = nwg % NXCD, xcd = wgid % NXCD, off = wgid / NXCD; wgid = (xcd < r ? xcd * (q + 1) : r * (q + 1) + (xcd - r) * q) + off; }
        const int nig = WGM * nN, gid = wgid / nig, fm = gid * WGM, gsz = (nM - fm) < WGM ? (nM - fm) : WGM;
        u.pm = fm + ((wgid % nig) % gsz); u.pn = (wgid % nig) / gsz; u.e = 0; u.idx = i; return true;
    }
};

template <class P>
__device__ __forceinline__ void gemm_phase(LAS unsigned char* lds, const P& S) {
    const int tid = threadIdx.x, wid = __builtin_amdgcn_readfirstlane(tid >> 6), lane = tid & 63, wr = wid >> 2, wc = wid & 3, fr = lane & 15, fq = lane >> 4;
    constexpr int K = KD, nt = NT;
    int Rr[2], Cc[2]; unsigned voffB[2];
#pragma unroll
    for (int i = 0; i < 2; ++i) { int R, C; stage_rc(tid * 16 + i * 8192, R, C); const int Rb = P::PERM ? ((R & ~31) + perm32(R & 31)) : R; Rr[i] = R; Cc[i] = C; voffB[i] = (unsigned)(Rb * K + C) * 2u; }
    constexpr size_t kstep = (size_t)(BK * 2);
    constexpr size_t hstep = (size_t)HALF * K * 2;
    const unsigned ldsw = (unsigned)wid * 1024u;
    const int aoff = lds_byte(wr * 64 + fr, fq * 8), boff = lds_byte(wc * 32 + fr, fq * 8);
#define PG8_SA(b, h) (((b) * 2 + (h)) * HTB)
#define PG8_SB(b, h) ((4 + (b) * 2 + (h)) * HTB)
#define PG8_STAGE(bufoff, gbase, voff) do { _Pragma("unroll") for (int _i = 0; _i < 2; ++_i) \
        __builtin_amdgcn_global_load_lds((const unsigned*)((const char*)(gbase) + (voff)[_i]), (LAS unsigned*)(lds + (bufoff) + ldsw + _i * 8192), 16, 0, 0); } while (0)
#define PG8_LDA(dst, b, h) do { _Pragma("unroll") for (int m = 0; m < 4; ++m) _Pragma("unroll") for (int k = 0; k < 2; ++k) dst[m][k] = *(const LAS bf16x8*)(lds + PG8_SA(b, h) + aoff + m * 2048 + k * 1024); } while (0)
#define PG8_LDB(dst, b, h) do { _Pragma("unroll") for (int n = 0; n < 2; ++n) _Pragma("unroll") for (int k = 0; k < 2; ++k) dst[n][k] = *(const LAS bf16x8*)(lds + PG8_SB(b, h) + boff + n * 2048 + k * 1024); } while (0)
#define PG8_MMA(ai, bj, At, Bt) do { __builtin_amdgcn_s_setprio(1); _Pragma("unroll") for (int m = 0; m < 4; ++m) _Pragma("unroll") for (int n = 0; n < 2; ++n) _Pragma("unroll") for (int k = 0; k < 2; ++k) \
        acc[ai][bj][m][n] = __builtin_amdgcn_mfma_f32_16x16x32_bf16(Bt[n][k], At[m][k], acc[ai][bj][m][n], 0, 0, 0); __builtin_amdgcn_s_setprio(0); } while (0)
#define PG8_WAIT_V(n) asm volatile("s_waitcnt vmcnt(" #n ")" ::: "memory")
#define PG8_WAIT_L(n) asm volatile("s_waitcnt lgkmcnt(" #n ")" ::: "memory")
#define PG8_BAR __builtin_amdgcn_s_barrier()
#define PG8_SCHED __builtin_amdgcn_sched_barrier(0)
    Unit cur, nxt; int ui = 0;
    if (!S.next(0, cur)) return;
    f32x4 acc[2][2][4][2];
#pragma unroll
    for (int a = 0; a < 2; ++a)
#pragma unroll
        for (int b = 0; b < 2; ++b)
#pragma unroll
            for (int m = 0; m < 4; ++m)
#pragma unroll
                for (int n = 0; n < 2; ++n) acc[a][b][m][n] = (f32x4){0.f, 0.f, 0.f, 0.f};
    bf16x8 At[4][2], B0[2][2], B1[2][2];
    unsigned voA[2][2], voN[2][2];
    S.a_off(cur, Rr, Cc, voA);
    const char* cA = S.a_base(cur); const char* cB = S.b_base(cur);
    PG8_STAGE(PG8_SB(0, 0), cB, voffB); PG8_STAGE(PG8_SB(0, 1), cB + hstep, voffB); PG8_STAGE(PG8_SA(0, 0), cA, voA[0]); PG8_STAGE(PG8_SA(0, 1), cA, voA[1]);
    if (wr == 1) PG8_BAR;
    PG8_WAIT_V(2); PG8_BAR;
    PG8_STAGE(PG8_SB(1, 0), cB + kstep, voffB); PG8_STAGE(PG8_SA(1, 0), cA + kstep, voA[0]); PG8_STAGE(PG8_SB(1, 1), cB + hstep + kstep, voffB);
    PG8_WAIT_V(6); PG8_BAR;
    for (;;) {
        const bool has_next = S.next(ui + 1, nxt);
        const char* nA = has_next ? S.a_base(nxt) : cA; const char* nB = has_next ? S.b_base(nxt) : cB;
        if (has_next) S.a_off(nxt, Rr, Cc, voN);
        else { voN[0][0] = voA[0][0]; voN[0][1] = voA[0][1]; voN[1][0] = voA[1][0]; voN[1][1] = voA[1][1]; }
        for (int t = 0; t < nt; t += 2) {
            const bool last = (t == nt - 2);
            const char* a1 = cA + (size_t)(t + 1) * kstep;
            const char* a2 = last ? nA : cA + (size_t)(t + 2) * kstep; const char* b2 = last ? nB : cB + (size_t)(t + 2) * kstep;
            const char* a3 = a2 + kstep; const char* b3 = b2 + kstep;
            unsigned v2[2][2];
            v2[0][0] = last ? voN[0][0] : voA[0][0]; v2[0][1] = last ? voN[0][1] : voA[0][1]; v2[1][0] = last ? voN[1][0] : voA[1][0]; v2[1][1] = last ? voN[1][1] : voA[1][1];
            PG8_LDB(B0, 0, 0); PG8_LDB(B1, 0, 1); PG8_SCHED; PG8_LDA(At, 0, 0); PG8_STAGE(PG8_SA(1, 1), a1, voA[1]);
            PG8_WAIT_V(8); PG8_WAIT_L(0); PG8_BAR; PG8_MMA(0, 0, At, B0); PG8_MMA(0, 1, At, B1); PG8_BAR; PG8_SCHED;
            PG8_LDA(At, 0, 1); PG8_STAGE(PG8_SB(0, 0), b2, voffB); PG8_STAGE(PG8_SB(0, 1), b2 + hstep, voffB); PG8_STAGE(PG8_SA(0, 0), a2, v2[0]);
            PG8_WAIT_V(8); PG8_WAIT_L(0); PG8_BAR; PG8_MMA(1, 0, At, B0); PG8_MMA(1, 1, At, B1); PG8_BAR; PG8_SCHED;
            PG8_LDB(B0, 1, 0); PG8_LDB(B1, 1, 1); PG8_SCHED; PG8_LDA(At, 1, 0); PG8_STAGE(PG8_SA(0, 1), a2, v2[1]);
            PG8_WAIT_V(8); PG8_WAIT_L(0); PG8_BAR; PG8_MMA(0, 0, At, B0); PG8_MMA(0, 1, At, B1); PG8_BAR; PG8_SCHED;
            PG8_LDA(At, 1, 1); PG8_STAGE(PG8_SB(1, 0), b3, voffB); PG8_STAGE(PG8_SB(1, 1), b3 + hstep, voffB); PG8_STAGE(PG8_SA(1, 0), a3, v2[0]);
            PG8_WAIT_V(8); PG8_WAIT_L(0); PG8_BAR; PG8_MMA(1, 0, At, B0); PG8_MMA(1, 1, At, B1); PG8_BAR; PG8_SCHED;
        }
        if (wr == 0) PG8_BAR;
        S.epi(acc, cur, wr, wc, fr, fq);
        if (!has_next) break;
#pragma unroll
        for (int a = 0; a < 2; ++a)
#pragma unroll
            for (int b = 0; b < 2; ++b)
#pragma unroll
                for (int m = 0; m < 4; ++m)
#pragma unroll
                    for (int n = 0; n < 2; ++n) acc[a][b][m][n] = (f32x4){0.f, 0.f, 0.f, 0.f};
        cur = nxt; cA = nA; cB = nB; ++ui;
        voA[0][0] = voN[0][0]; voA[0][1] = voN[0][1]; voA[1][0] = voN[1][0]; voA[1][1] = voN[1][1];
        if (wr == 1) PG8_BAR;
    }
    PG8_WAIT_V(0);
    PG8_BAR;
#undef PG8_SA
#undef PG8_SB
#undef PG8_STAGE
#undef PG8_LDA
#undef PG8_LDB
#undef PG8_MMA
#undef PG8_WAIT_V
#undef PG8_WAIT_L
#undef PG8_BAR
#undef PG8_SCHED
}
}

struct PDense {
    static constexpr bool PERM = true;
    const u16* A; const u16* Bt; u16* out; const u16* H0; int mode; pg8::StaticOrder ord;
    __device__ __forceinline__ bool next(int i, pg8::Unit& u) const { return ord.next(i, u); }
    __device__ __forceinline__ const char* a_base(const pg8::Unit& u) const { return (const char*)A + (size_t)u.pm * 256 * 2048; }
    __device__ __forceinline__ const char* b_base(const pg8::Unit& u) const { return (const char*)Bt + (size_t)u.pn * 256 * 2048; }
    __device__ __forceinline__ void a_off(const pg8::Unit&, const int (&R)[2], const int (&C)[2], unsigned (&v)[2][2]) const {
#pragma unroll
        for (int h = 0; h < 2; ++h)
#pragma unroll
            for (int i = 0; i < 2; ++i) v[h][i] = (unsigned)((h * 128 + R[i]) * 1024 + C[i]) * 2u;
    }
    __device__ __forceinline__ void epi(const f32x4 (&acc)[2][2][4][2], const pg8::Unit& u, int wr, int wc, int fr, int fq) const {
        const int row0 = u.pm * 256 + wr * 64 + fr, col0 = u.pn * 256 + wc * 32 + 8 * fq;
        const int ldc = mode == 0 ? QKVP : DM;
        const float sc = (mode == 0 && (u.pn < 2 || u.pn == 6 || u.pn == 7)) ? QSCALE : 1.0f;
#pragma unroll
        for (int ai = 0; ai < 2; ++ai)
#pragma unroll
            for (int m = 0; m < 4; ++m) {
                const size_t off = (size_t)(row0 + ai * 128 + m * 16) * ldc + col0;
#pragma unroll
                for (int bj = 0; bj < 2; ++bj) {
                    f32x4 v0 = acc[ai][bj][m][0] * sc, v1 = acc[ai][bj][m][1] * sc;
                    if (mode == 1) {
                        const u32x4 h = *(const u32x4*)(H0 + off + bj * 128);
                        v0[0] += DN_ALPHA * __uint_as_float(h.x << 16); v0[1] += DN_ALPHA * __uint_as_float(h.x & 0xffff0000u); v0[2] += DN_ALPHA * __uint_as_float(h.y << 16); v0[3] += DN_ALPHA * __uint_as_float(h.y & 0xffff0000u);
                        v1[0] += DN_ALPHA * __uint_as_float(h.z << 16); v1[1] += DN_ALPHA * __uint_as_float(h.z & 0xffff0000u); v1[2] += DN_ALPHA * __uint_as_float(h.w << 16); v1[3] += DN_ALPHA * __uint_as_float(h.w & 0xffff0000u);
                    }
                    u32x4 w; w.x = pg8::cvt_pk_bf16(v0[0], v0[1]); w.y = pg8::cvt_pk_bf16(v0[2], v0[3]); w.z = pg8::cvt_pk_bf16(v1[0], v1[1]); w.w = pg8::cvt_pk_bf16(v1[2], v1[3]);
                    *(u32x4*)(out + off + bj * 128) = w;
                }
            }
    }
};

struct MoeTab { LAS int* tb; LAS int* cn; LAS int* rowoff; };
__device__ __forceinline__ MoeTab moe_tab(LAS unsigned char* lds) { MoeTab t; t.rowoff = (LAS int*)(lds + TAB_OFF); t.tb = (LAS int*)(lds + TAB_OFF + 20480); t.cn = t.tb + 40; return t; }
__device__ __forceinline__ void moe_tables(const MoeTab& T, const int* cnt) {
    if (threadIdx.x == 0) { int s = 0; for (int e = 0; e < NEXP; ++e) { const int c = __hip_atomic_load(cnt + e, RLX_AGENT); T.cn[e] = c; T.tb[e] = s; s += (c + 255) >> 8; } T.tb[NEXP] = s; }
    __syncthreads();
}
__device__ __forceinline__ int moe_find_e(const MoeTab& T, int RT) { int e = 0; while (e < NEXP - 1 && RT >= T.tb[e + 1]) ++e; return e; }

template <int UP>
struct PMoe {
    static constexpr bool PERM = true;
    static constexpr int NPN = UP ? 8 : 4, RPG = UP ? 4 : 8;
    const u16* A; const u16* Bt; u16* out; const int* list; const float* gate; const float* bias; MoeTab T; int c;
    __device__ __forceinline__ bool next(int i, pg8::Unit& u) const {
        const int x = c & 7, s = c >> 3; const int RT = (i * 8 + x) * RPG + (s % RPG);
        if (RT >= T.tb[NEXP]) return false;
        u.pm = RT; u.pn = s / RPG; u.e = moe_find_e(T, RT); u.idx = i; return true;
    }
    __device__ __forceinline__ const char* a_base(const pg8::Unit& u) const { return UP ? (const char*)A : (const char*)A + (size_t)u.pm * 256 * 2048; }
    __device__ __forceinline__ const char* b_base(const pg8::Unit& u) const { return (const char*)Bt + ((size_t)u.e * (UP ? 2048 : 1024) + (size_t)u.pn * 256) * 2048; }
    __device__ __forceinline__ void a_off(const pg8::Unit& u, const int (&R)[2], const int (&C)[2], unsigned (&v)[2][2]) const {
#pragma unroll
        for (int h = 0; h < 2; ++h)
#pragma unroll
            for (int i = 0; i < 2; ++i) v[h][i] = UP ? (unsigned)T.rowoff[u.idx * 256 + h * 128 + R[i]] + (unsigned)C[i] * 2u : (unsigned)((h * 128 + R[i]) * 1024 + C[i]) * 2u;
    }
    __device__ __forceinline__ void prepare() const {
        if (UP) {
            pg8::Unit u;
            for (int i = 0; next(i, u); ++i) {
                if (threadIdx.x < 256) { const int r = (u.pm - T.tb[u.e]) * 256 + (int)threadIdx.x; const int ent = list[(size_t)u.e * NTOK + (r < T.cn[u.e] ? r : 0)]; T.rowoff[i * 256 + threadIdx.x] = (ent >> 2) * 2048; }
            }
        }
        __syncthreads();
    }
    __device__ __forceinline__ void epi(const f32x4 (&acc)[2][2][4][2], const pg8::Unit& u, int wr, int wc, int fr, int fq) const {
        const int rl0 = wr * 64 + fr, col0 = u.pn * 256 + wc * 32 + 8 * fq;
        if (UP) {
            const float* bp = bias + (size_t)u.e * 2048 + col0;
            f32x4 bv[2][2];
#pragma unroll
            for (int bj = 0; bj < 2; ++bj) { bv[bj][0] = *(const f32x4*)(bp + bj * 128); bv[bj][1] = *(const f32x4*)(bp + bj * 128 + 4); }
#pragma unroll
            for (int ai = 0; ai < 2; ++ai)
#pragma unroll
                for (int m = 0; m < 4; ++m) {
                    u16* rowp = out + (size_t)(u.pm * 256 + rl0 + ai * 128 + m * 16) * 1024 + (col0 >> 1);
#pragma unroll
                    for (int bj = 0; bj < 2; ++bj) {
                        const f32x4 v0 = acc[ai][bj][m][0] + bv[bj][0], v1 = acc[ai][bj][m][1] + bv[bj][1];
                        float a[4];
#pragma unroll
                        for (int p = 0; p < 4; ++p) {
                            const float glu = p < 2 ? v0[2 * p] : v1[2 * p - 4], lin = p < 2 ? v0[2 * p + 1] : v1[2 * p - 3];
                            const float xg = fminf(glu, 7.0f), xl = fminf(fmaxf(lin, -7.0f), 7.0f);
                            a[p] = xg * __builtin_amdgcn_rcpf(1.0f + __builtin_amdgcn_exp2f(-1.702f * LOG2E * xg)) * (xl + 1.0f);
                        }
                        u32x2 w; w.x = pg8::cvt_pk_bf16(a[0], a[1]); w.y = pg8::cvt_pk_bf16(a[2], a[3]);
                        *(u32x2*)(rowp + bj * 64) = w;
                    }
                }
        } else {
            const float* bp = bias + (size_t)u.e * 1024 + col0;
            f32x4 bv[2][2];
#pragma unroll
            for (int bj = 0; bj < 2; ++bj) { bv[bj][0] = *(const f32x4*)(bp + bj * 128); bv[bj][1] = *(const f32x4*)(bp + bj * 128 + 4); }
            const int rbase = (u.pm - T.tb[u.e]) * 256, cnt = T.cn[u.e];
#pragma unroll
            for (int ai = 0; ai < 2; ++ai)
#pragma unroll
                for (int m = 0; m < 4; ++m) {
                    const int r = rbase + rl0 + ai * 128 + m * 16;
                    if (r < cnt) {
                        const int ent = list[(size_t)u.e * NTOK + r]; const float gt = gate[ent];
                        u16* rowp = out + (size_t)ent * 1024 + col0;
#pragma unroll
                        for (int bj = 0; bj < 2; ++bj) {
                            const f32x4 v0 = (acc[ai][bj][m][0] + bv[bj][0]) * gt, v1 = (acc[ai][bj][m][1] + bv[bj][1]) * gt;
                            u32x4 w; w.x = pg8::cvt_pk_bf16(v0[0], v0[1]); w.y = pg8::cvt_pk_bf16(v0[2], v0[3]); w.z = pg8::cvt_pk_bf16(v1[0], v1[1]); w.w = pg8::cvt_pk_bf16(v1[2], v1[3]);
                            *(u32x4*)(rowp + bj * 128) = w;
                        }
                    }
                }
        }
    }
};

struct Frame {
    LAS unsigned char* lds; volatile LAS unsigned* MISC; gu32* ctl; int tid, lane, wave, G, bid;
};
__device__ __forceinline__ void p0_transpose_item(const float* W, int K, int N, u16* WT, LAS float* scr, int item, int lane) {
    const int nblk = N / 32, kb = item / nblk, nb = item % nblk, k0 = 64 * kb, n0 = 32 * nb;
    f32x4 v[8];
#pragma unroll
    for (int it = 0; it < 8; ++it) v[it] = *(const f32x4*)(W + (size_t)(k0 + (lane >> 3) + 8 * it) * N + n0 + (lane & 7) * 4);
#pragma unroll
    for (int it = 0; it < 8; ++it) { const int k = (lane >> 3) + 8 * it, n4 = (lane & 7) * 4; scr[(n4 + 0) * 68 + k] = v[it].x; scr[(n4 + 1) * 68 + k] = v[it].y; scr[(n4 + 2) * 68 + k] = v[it].z; scr[(n4 + 3) * 68 + k] = v[it].w; }
    LDS_WAIT(); asm volatile("" ::: "memory");
#pragma unroll
    for (int it = 0; it < 4; ++it) {
        const int n = (lane >> 3) + 8 * it, c = lane & 7; const LAS float* s = scr + n * 68 + 8 * c;
        const f32x4 a = *(const LAS f32x4*)s, b = *(const LAS f32x4*)(s + 4);
        u32x4 o; o.x = pk2(a.x, a.y); o.y = pk2(a.z, a.w); o.z = pk2(b.x, b.y); o.w = pk2(b.z, b.w);
        *(u32x4*)(WT + (size_t)(n0 + n) * K + k0 + 8 * c) = o;
    }
    LDS_WAIT(); asm volatile("" ::: "memory");
}
__device__ __forceinline__ void ln_row_in(const float* xrow, const float* g, const float* b, u16* orow, int lane) {
    const f32x4* xr = (const f32x4*)xrow + lane;
    f32x4 v[4]; float s = 0.f;
#pragma unroll
    for (int j = 0; j < 4; ++j) { v[j] = xr[64 * j]; s += (v[j].x + v[j].y) + (v[j].z + v[j].w); }
    const float mean = wave_sum(s) * (1.f / DM); float s2 = 0.f;
#pragma unroll
    for (int j = 0; j < 4; ++j) { v[j] = v[j] - mean; s2 += (v[j].x * v[j].x + v[j].y * v[j].y) + (v[j].z * v[j].z + v[j].w * v[j].w); }
    const float rstd = 1.f / sqrtf(wave_sum(s2) * (1.f / DM) + LN_EPS);
    u32x2* o8 = (u32x2*)orow + lane;
#pragma unroll
    for (int j = 0; j < 4; ++j) {
        const f32x4 gg = ((const f32x4*)g)[lane + 64 * j], bb = ((const f32x4*)b)[lane + 64 * j];
        u32x2 w; w.x = pk2(v[j].x * rstd * gg.x + bb.x, v[j].y * rstd * gg.y + bb.y); w.y = pk2(v[j].z * rstd * gg.z + bb.z, v[j].w * rstd * gg.w + bb.w);
        o8[64 * j] = w;
    }
}

struct Args { const float* in[21]; float* out; unsigned char* ws; int ph_lo, ph_hi, li, pad; };

__device__ __forceinline__ void p0_prologue(const Frame& F, const Args& a) {
    unsigned char* ws = a.ws;
    u16* WIN = (u16*)(ws + WS_WIN); u16* WOUT = (u16*)(ws + WS_WOUT); u16* W1T = (u16*)(ws + WS_W1); u16* W2T = (u16*)(ws + WS_W2); u16* H0 = (u16*)(ws + WS_H0);
    LAS float* scr = (LAS float*)(F.lds + RING_OFF + F.wave * 8704);
    const int gw = F.bid * NWAVES + F.wave, NGW = F.G * NWAVES;
    constexpr int I_IN = 16 * 96, I_OUT = 16 * 32, I_W1 = 16 * 64, I_W2 = 16 * 32;
    constexpr int NITEMS = I_IN + I_OUT + NEXP * I_W1 + NEXP * I_W2;
    for (int it = gw; it < NITEMS; it += NGW) {
        int r = it;
        if (r < I_IN) { p0_transpose_item(a.in[3], 1024, 3072, WIN, scr, r, F.lane); continue; } r -= I_IN;
        if (r < I_OUT) { p0_transpose_item(a.in[10], 1024, 1024, WOUT, scr, r, F.lane); continue; } r -= I_OUT;
        if (r < NEXP * I_W1) { const int e = r / I_W1; p0_transpose_item(a.in[15] + (size_t)e * 1024 * 2048, 1024, 2048, W1T + (size_t)e * 1024 * 2048, scr, r % I_W1, F.lane); continue; } r -= NEXP * I_W1;
        { const int e = r / I_W2; p0_transpose_item(a.in[17] + (size_t)e * 1024 * 1024, 1024, 1024, W2T + (size_t)e * 1024 * 1024, scr, r % I_W2, F.lane); }
    }
    { u16* RW = (u16*)(ws + WS_RWT); const float* rw = a.in[13];
      for (int idx = F.bid * NTHR + F.tid; idx < 32768; idx += F.G * NTHR) { const int e = idx >> 10, k = idx & 1023; const float v = rw[k * 32 + e]; const u16 hi = f2bf(v); RW[idx] = hi; RW[32768 + idx] = f2bf(v - bf2f(hi)); } }
    for (int m = gw; m < NTOK; m += NGW) ln_row_in(a.in[0] + (size_t)m * DM, a.in[1], a.in[2], H0 + (size_t)m * DM, F.lane);
}

__device__ __forceinline__ void p4_router(const Frame& F, const Args& a) {
    unsigned char* ws = a.ws;
    const u16* U = (const u16*)(ws + WS_U); u16* H1 = (u16*)(ws + WS_H1); int* LIST = (int*)(ws + WS_LIST); float* GATE = (float*)(ws + WS_GATE); int* CNT = (int*)(F.ctl + CW_CNT);
    const float* g1 = a.in[11]; const float* b1 = a.in[12]; const float* rb = a.in[14];
    const u32x4* RWT = (const u32x4*)(ws + WS_RWT);
    LAS int* lcnt = (LAS int*)(F.lds + TAB_OFF); LAS int* lbase = lcnt + 32; LAS int* ent_e = lcnt + 64; LAS int* ent_p = ent_e + 512;
    const int lane = F.lane, tok = lane & 15, kg = lane >> 4;
    for (int i = F.tid; i < 8192; i += NTHR) { const int img = i >> 12, e = (i >> 7) & 31, c = i & 127; *(LAS u32x4*)(F.lds + RING_OFF + img * 65536 + e * 2048 + 16 * (c ^ (e & 15))) = RWT[i]; }
    for (int batch = F.bid; batch < NTOK / 128; batch += F.G) {
        __syncthreads();
        if (F.tid < 32) lcnt[F.tid] = 0;
        __syncthreads();
        const int tl = F.wave * 16 + tok, t = batch * 128 + tl;
        const u32x4* ur = (const u32x4*)(U + (size_t)t * DM) + kg;
        float s1 = 0.f;
#pragma unroll 8
        for (int s = 0; s < 32; ++s) { const u32x4 w = ur[4 * s];
            s1 += (__uint_as_float(w.x << 16) + __uint_as_float(w.x & 0xffff0000u)) + (__uint_as_float(w.y << 16) + __uint_as_float(w.y & 0xffff0000u))
                + (__uint_as_float(w.z << 16) + __uint_as_float(w.z & 0xffff0000u)) + (__uint_as_float(w.w << 16) + __uint_as_float(w.w & 0xffff0000u)); }
        s1 += __shfl_xor(s1, 16); s1 += __shfl_xor(s1, 32);
        const float mean = s1 * (1.f / DM);
        float s2 = 0.f;
#pragma unroll 8
        for (int s = 0; s < 32; ++s) { const u32x4 w = ur[4 * s];
            const float d0 = __uint_as_float(w.x << 16) - mean, d1 = __uint_as_float(w.x & 0xffff0000u) - mean, d2 = __uint_as_float(w.y << 16) - mean, d3 = __uint_as_float(w.y & 0xffff0000u) - mean;
            const float d4 = __uint_as_float(w.z << 16) - mean, d5 = __uint_as_float(w.z & 0xffff0000u) - mean, d6 = __uint_as_float(w.w << 16) - mean, d7 = __uint_as_float(w.w & 0xffff0000u) - mean;
            s2 += (d0 * d0 + d1 * d1) + (d2 * d2 + d3 * d3) + (d4 * d4 + d5 * d5) + (d6 * d6 + d7 * d7); }
        s2 += __shfl_xor(s2, 16); s2 += __shfl_xor(s2, 32);
        const float rstd = 1.f / sqrtf(s2 * (1.f / DM) + LN_EPS);
        f32x4 acc[2];
        acc[0] = (f32x4){0.f, 0.f, 0.f, 0.f}; acc[1] = (f32x4){0.f, 0.f, 0.f, 0.f};
        u32x4* hr = (u32x4*)(H1 + (size_t)t * DM) + kg;
        LAS const unsigned char* wimg = F.lds + RING_OFF + tok * 2048;
#pragma unroll 2
        for (int s = 0; s < 32; ++s) {
            const u32x4 w = ur[4 * s];
            const f32x4 ga = *(const f32x4*)(g1 + 32 * s + 8 * kg), gb = *(const f32x4*)(g1 + 32 * s + 8 * kg + 4), ba = *(const f32x4*)(b1 + 32 * s + 8 * kg), bb = *(const f32x4*)(b1 + 32 * s + 8 * kg + 4);
            float h[8];
            h[0] = (__uint_as_float(w.x << 16) - mean) * rstd * ga.x + ba.x; h[1] = (__uint_as_float(w.x & 0xffff0000u) - mean) * rstd * ga.y + ba.y;
            h[2] = (__uint_as_float(w.y << 16) - mean) * rstd * ga.z + ba.z; h[3] = (__uint_as_float(w.y & 0xffff0000u) - mean) * rstd * ga.w + ba.w;
            h[4] = (__uint_as_float(w.z << 16) - mean) * rstd * gb.x + bb.x; h[5] = (__uint_as_float(w.z & 0xffff0000u) - mean) * rstd * gb.y + bb.y;
            h[6] = (__uint_as_float(w.w << 16) - mean) * rstd * gb.z + bb.z; h[7] = (__uint_as_float(w.w & 0xffff0000u) - mean) * rstd * gb.w + bb.w;
            u32x4 hh, hl;
            hh.x = pk2(h[0], h[1]); hh.y = pk2(h[2], h[3]); hh.z = pk2(h[4], h[5]); hh.w = pk2(h[6], h[7]);
            hr[4 * s] = hh;
            hl.x = pk2(h[0] - __uint_as_float(hh.x << 16), h[1] - __uint_as_float(hh.x & 0xffff0000u)); hl.y = pk2(h[2] - __uint_as_float(hh.y << 16), h[3] - __uint_as_float(hh.y & 0xffff0000u));
            hl.z = pk2(h[4] - __uint_as_float(hh.z << 16), h[5] - __uint_as_float(hh.z & 0xffff0000u)); hl.w = pk2(h[6] - __uint_as_float(hh.w << 16), h[7] - __uint_as_float(hh.w & 0xffff0000u));
            const bf16x8 bh = __builtin_bit_cast(bf16x8, hh), bl = __builtin_bit_cast(bf16x8, hl);
            const unsigned co = 16u * ((unsigned)(4 * s + kg) ^ (unsigned)tok);
#pragma unroll
            for (int eh = 0; eh < 2; ++eh) {
                const bf16x8 wh = *(const LAS bf16x8*)(wimg + eh * 32768 + co), wl = *(const LAS bf16x8*)(wimg + 65536 + eh * 32768 + co);
                acc[eh] = __builtin_amdgcn_mfma_f32_16x16x32_bf16(wh, bh, acc[eh], 0, 0, 0);
                acc[eh] = __builtin_amdgcn_mfma_f32_16x16x32_bf16(wl, bh, acc[eh], 0, 0, 0);
                acc[eh] = __builtin_amdgcn_mfma_f32_16x16x32_bf16(wh, bl, acc[eh], 0, 0, 0);
            }
        }
        float lg[8];
#pragma unroll
        for (int eh = 0; eh < 2; ++eh)
#pragma unroll
            for (int r = 0; r < 4; ++r) lg[eh * 4 + r] = acc[eh][r] + rb[16 * eh + 4 * kg + r];
        unsigned used = 0u; float tv[4]; int ti[4];
#pragma unroll
        for (int k = 0; k < 4; ++k) {
            float best = -INFINITY; int bi = 1 << 20;
#pragma unroll
            for (int j = 0; j < 8; ++j) { const int e = 16 * (j >> 2) + 4 * kg + (j & 3); const bool ok = !((used >> j) & 1u) && (lg[j] > best || (lg[j] == best && e < bi)); best = ok ? lg[j] : best; bi = ok ? e : bi; }
#pragma unroll
            for (int off = 16; off <= 32; off <<= 1) { const float ov = __shfl_xor(best, off); const int oi = __shfl_xor(bi, off); const bool tk = ov > best || (ov == best && oi < bi); best = tk ? ov : best; bi = tk ? oi : bi; }
            tv[k] = best; ti[k] = bi;
#pragma unroll
            for (int j = 0; j < 8; ++j) { const int e = 16 * (j >> 2) + 4 * kg + (j & 3); if (e == bi) used |= 1u << j; }
        }
        const float e1 = __expf(tv[1] - tv[0]), e2 = __expf(tv[2] - tv[0]), e3 = __expf(tv[3] - tv[0]);
        const float inv = 1.f / (1.f + e1 + e2 + e3);
        {
            const int me = kg == 0 ? ti[0] : kg == 1 ? ti[1] : kg == 2 ? ti[2] : ti[3];
            const float mg = (kg == 0 ? 1.f : kg == 1 ? e1 : kg == 2 ? e2 : e3) * inv;
            const int pos = __hip_atomic_fetch_add(lcnt + me, 1, __ATOMIC_RELAXED, __HIP_MEMORY_SCOPE_WORKGROUP);
            ent_e[tl * 4 + kg] = me; ent_p[tl * 4 + kg] = pos; GATE[t * 4 + kg] = mg;
        }
        __syncthreads();
        if (F.tid < 32) lbase[F.tid] = atomicAdd(CNT + F.tid, lcnt[F.tid]);
        __syncthreads();
        { const int e = ent_e[F.tid]; LIST[(size_t)e * NTOK + lbase[e] + ent_p[F.tid]] = (batch * 128 + (F.tid >> 2)) * 4 + (F.tid & 3); }
    }
}

__device__ __forceinline__ void p7_final(const Frame& F, const Args& a) {
    const u16* H1 = (const u16*)(a.ws + WS_H1); const u16* YS = (const u16*)(a.ws + WS_YS); const float* g2 = a.in[19]; const float* b2 = a.in[20];
    const int lane = F.lane, gw = F.bid * NWAVES + F.wave, NGW = F.G * NWAVES;
    for (int t = gw; t < NTOK; t += NGW) {
        float v[16]; float s = 0.f;
#pragma unroll
        for (int j = 0; j < 4; ++j) {
            const u32x2 w = ((const u32x2*)(H1 + (size_t)t * DM) + lane)[64 * j];
            float a0 = DN_ALPHA * __uint_as_float(w.x << 16), a1 = DN_ALPHA * __uint_as_float(w.x & 0xffff0000u), a2 = DN_ALPHA * __uint_as_float(w.y << 16), a3 = DN_ALPHA * __uint_as_float(w.y & 0xffff0000u);
#pragma unroll
            for (int k = 0; k < 4; ++k) {
                const u32x2 y = ((const u32x2*)(YS + ((size_t)t * 4 + k) * DM) + lane)[64 * j];
                a0 += __uint_as_float(y.x << 16); a1 += __uint_as_float(y.x & 0xffff0000u); a2 += __uint_as_float(y.y << 16); a3 += __uint_as_float(y.y & 0xffff0000u);
            }
            v[4 * j] = a0; v[4 * j + 1] = a1; v[4 * j + 2] = a2; v[4 * j + 3] = a3; s += (a0 + a1) + (a2 + a3);
        }
        const float mean = wave_sum(s) * (1.f / DM); float s2 = 0.f;
#pragma unroll
        for (int i = 0; i < 16; ++i) { v[i] -= mean; s2 += v[i] * v[i]; }
        const float rstd = 1.f / sqrtf(wave_sum(s2) * (1.f / DM) + LN_EPS);
        f32x4* o = (f32x4*)(a.out + (size_t)t * DM) + lane;
#pragma unroll
        for (int j = 0; j < 4; ++j) {
            const f32x4 gg = ((const f32x4*)g2)[lane + 64 * j], bb = ((const f32x4*)b2)[lane + 64 * j];
            o[64 * j] = (f32x4){v[4 * j] * rstd * gg.x + bb.x, v[4 * j + 1] * rstd * gg.y + bb.y, v[4 * j + 2] * rstd * gg.z + bb.z, v[4 * j + 3] * rstd * gg.w + bb.w};
        }
    }
}


namespace att {
typedef float f32x16 __attribute__((ext_vector_type(16)));
typedef short s16x4 __attribute__((ext_vector_type(4)));
typedef short v4i16_t __attribute__((ext_vector_type(4)));
constexpr int KV_BUF = 32768, X_OFF = 65536, WSF_OFF = TAB_OFF, TBL_OFF = TAB_OFF + 2048;
constexpr float THR = 6.0f;
__device__ __forceinline__ int crow(int r, int hi) { return (r & 3) + 8 * (r >> 2) + 4 * hi; }
__device__ __forceinline__ unsigned cvtpk(float lo, float hi) { typedef float f2 __attribute__((ext_vector_type(2))); typedef __bf16 b2 __attribute__((ext_vector_type(2))); f2 v = {lo, hi}; b2 b = __builtin_convertvector(v, b2); return __builtin_bit_cast(unsigned, b); }
__device__ __forceinline__ s16x4 vtr(LAS const unsigned char* p) { return __builtin_bit_cast(s16x4, __builtin_amdgcn_ds_read_tr16_b64_v4i16((LAS v4i16_t*)p)); }
__device__ __forceinline__ float swapmax(float m) { auto rr = __builtin_amdgcn_permlane32_swap(__float_as_uint(m), __float_as_uint(m), false, false); return fmaxf(__uint_as_float(rr[0]), __uint_as_float(rr[1])); }
__device__ __forceinline__ float swapsum(float m) { auto rr = __builtin_amdgcn_permlane32_swap(__float_as_uint(m), __float_as_uint(m), false, false); return __uint_as_float(rr[0]) + __uint_as_float(rr[1]); }

template <bool ISA>
__device__ __forceinline__ void attn_unit(const Frame& F, const u16* QKV, u16* O, int b, int hx, int jq, float lam, const float* subg, const float* relb) {
    constexpr int DVB = ISA ? 4 : 2;
    const int lane = F.lane, w = F.wave, sub = w >> 2, rg = w & 3, r32 = lane & 31, hi = lane >> 5;
    const int q0 = jq * 128, cq = 2 * jq + (rg >> 1);
    const int qpos = q0 + rg * 32 + r32;
    const size_t tok0 = (size_t)b * SEQ;
    const int qcol = (ISA ? hx * 128 : 1536 + hx * 128) + sub * 64;
    const int kcol0 = ISA ? 512 + hx * 128 : 2048 + hx * 128, vcol0 = ISA ? 1024 + hx * 128 : 2560 + hx * 128;
    const int ktop = 2 * jq + 1, kbot = ISA ? 0 : (2 * jq - 8 > 0 ? 2 * jq - 8 : 0);
    const int NTs = ktop - kbot + 1;
    LAS unsigned char* lds = F.lds;
    unsigned soff[2];
#pragma unroll
    for (int i = 0; i < 2; ++i) { const unsigned row = 4u * (8u * i + w) + (lane >> 4); const unsigned f = ((row & 3u) << 2) | ((row >> 2) & 3u); soff[i] = row * (QKVP * 2) + (((unsigned)lane & 15u) ^ f) * 16u; }
    const char* kvbase = (const char*)QKV + (tok0 * QKVP + kcol0) * 2;
    const unsigned ldsw = (unsigned)w * 1024u;
#define ATT_ISSUE(kt, buf) do { const char* kb_ = kvbase + (size_t)(kt) * 64 * QKVP * 2; const char* vb_ = kb_ + (vcol0 - kcol0) * 2; \
        _Pragma("unroll") for (int i_ = 0; i_ < 2; ++i_) { \
            __builtin_amdgcn_global_load_lds((const unsigned*)(kb_ + soff[i_]), (LAS unsigned*)(lds + (buf) * KV_BUF + i_ * 8192 + ldsw), 16, 0, 0); \
            __builtin_amdgcn_global_load_lds((const unsigned*)(vb_ + soff[i_]), (LAS unsigned*)(lds + (buf) * KV_BUF + 16384 + i_ * 8192 + ldsw), 16, 0, 0); } } while (0)
    ATT_ISSUE(ktop, 0);
    if (!ISA) {
        LAS float* tbl = (LAS float*)(lds + TBL_OFF);
        for (int i = F.tid; i < 1280; i += NTHR) { const int hd = i / 640, idx = i % 640; int rel = idx - 64; rel = rel < -256 ? -256 : (rel > 256 ? 256 : rel); tbl[i] = relb[(2 * hx + hd) * 513 + rel + 256] * LOG2E; }
    }
    bf16x8 qf[4];
    { const u16* qp = QKV + (tok0 + q0 + rg * 32 + r32) * QKVP + qcol + 8 * hi;
#pragma unroll
      for (int s = 0; s < 4; ++s) qf[s] = *(const bf16x8*)(qp + 16 * s); }
    const unsigned fr_ = ((r32 & 3u) << 2) | ((r32 >> 2) & 3u);
    unsigned kad[4];
#pragma unroll
    for (int s = 0; s < 4; ++s) kad[s] = 256u * r32 + 16u * ((8u * sub + 2u * s + hi) ^ fr_);
    const unsigned qd = (lane & 15) >> 2, pd = lane & 3, blk = (lane >> 4) & 1, xlow = 2 * blk + (pd >> 1);
    unsigned vad[DVB][2];
#pragma unroll
    for (int c = 0; c < DVB; ++c)
#pragma unroll
        for (int t = 0; t < 2; ++t) { const unsigned ci = ISA ? (unsigned)c : (unsigned)(2 * sub + c);
            vad[c][t] = 2048u * t + 256u * (4u * hi + qd) + 64u * (ci ^ qd) + 16u * (xlow ^ ((2u * t + hi) & 3u)) + 8u * (pd & 1u); }
    const float sl2 = ISA ? exp2f(-2.0f * (float)(hx + 1)) * LOG2E : 0.f;
    LAS float* wsf = (LAS float*)(lds + WSF_OFF) + w * 64;
    float mrun = -INFINITY, lrun = 0.f;
    f32x16 o[DVB];
#pragma unroll
    for (int c = 0; c < DVB; ++c)
#pragma unroll
        for (int r = 0; r < 16; ++r) o[c][r] = 0.f;

    for (int i = 0; i < NTs; ++i) {
        const int kt = ktop - i, buf = i & 1;
        asm volatile("s_waitcnt vmcnt(0)" ::: "memory");
        __syncthreads();
        if (i + 1 < NTs) ATT_ISSUE(kt - 1, buf ^ 1);
        const bool active = ISA ? (kt <= cq) : (kt <= cq && kt >= cq - 8);
        if (active) {
            LAS const unsigned char* kbuf = lds + buf * KV_BUF; LAS const unsigned char* vbuf = kbuf + 16384;
            f32x16 p0, p1;
#pragma unroll
            for (int r = 0; r < 16; ++r) { p0[r] = 0.f; p1[r] = 0.f; }
#pragma unroll
            for (int s = 0; s < 4; ++s) {
                const bf16x8 k0 = *(const LAS bf16x8*)(kbuf + kad[s]);
                const bf16x8 k1 = *(const LAS bf16x8*)(kbuf + kad[s] + 8192);
                p0 = __builtin_amdgcn_mfma_f32_32x32x16_bf16(k0, qf[s], p0, 0, 0, 0);
                p1 = __builtin_amdgcn_mfma_f32_32x32x16_bf16(k1, qf[s], p1, 0, 0, 0);
            }
            if (ISA) {
                const float dl = (float)(kt * 64 + 4 * hi - qpos);
#pragma unroll
                for (int r = 0; r < 16; ++r) { const float kc = (float)((r & 3) + 8 * (r >> 2)); p0[r] = fmaf(-sl2, fabsf(dl + kc), p0[r]); p1[r] = fmaf(-sl2, fabsf(dl + kc + 32.0f), p1[r]); }
            } else {
                LAS const float* tb = (LAS const float*)(lds + TBL_OFF) + sub * 640 + (qpos + 64 - kt * 64 - 4 * hi - 63);
#pragma unroll
                for (int r = 0; r < 16; ++r) { const int kc = (r & 3) + 8 * (r >> 2); p0[r] += tb[63 - kc]; p1[r] += tb[63 - 32 - kc]; }
            }
            float mx = fmaxf(p0[0], p1[0]);
#pragma unroll
            for (int r = 1; r < 16; ++r) mx = fmaxf(mx, fmaxf(p0[r], p1[r]));
            const float mt = swapmax(mx);
            if (__any(mt > mrun + THR)) {
                const float mnew = fmaxf(mrun, mt), alpha = __builtin_amdgcn_exp2f(mrun - mnew);
                lrun *= alpha; mrun = mnew;
                if (hi == 0) wsf[r32] = alpha;
#pragma unroll
                for (int r = 0; r < 16; ++r) { const float a_ = wsf[crow(r, hi)];
#pragma unroll
                    for (int c = 0; c < DVB; ++c) o[c][r] *= a_; }
            }
            float ps = 0.f;
#pragma unroll
            for (int r = 0; r < 16; ++r) { p0[r] = __builtin_amdgcn_exp2f(p0[r] - mrun); p1[r] = __builtin_amdgcn_exp2f(p1[r] - mrun); ps += p0[r] + p1[r]; }
            lrun += ps;
            u32x4 pw[4];
#pragma unroll
            for (int q = 0; q < 4; ++q) { pw[0][q] = cvtpk(p0[2 * q], p0[2 * q + 1]); pw[1][q] = cvtpk(p0[8 + 2 * q], p0[8 + 2 * q + 1]); pw[2][q] = cvtpk(p1[2 * q], p1[2 * q + 1]); pw[3][q] = cvtpk(p1[8 + 2 * q], p1[8 + 2 * q + 1]); }
#pragma unroll
            for (int c = 0; c < DVB; ++c)
#pragma unroll
                for (int ks = 0; ks < 4; ++ks) {
                    const s16x4 lo = vtr(vbuf + vad[c][0] + 4096 * ks), h4 = vtr(vbuf + vad[c][1] + 4096 * ks);
                    const bf16x8 vf = (bf16x8){lo[0], lo[1], lo[2], lo[3], h4[0], h4[1], h4[2], h4[3]};
                    o[c] = __builtin_amdgcn_mfma_f32_32x32x16_bf16(__builtin_bit_cast(bf16x8, pw[ks]), vf, o[c], 0, 0, 0);
                }
        }
    }
    { const float lt = swapsum(lrun); const float inv = 1.0f / lt;
      if (hi == 0) wsf[r32] = inv;
#pragma unroll
      for (int r = 0; r < 16; ++r) { const float a_ = wsf[crow(r, hi)];
#pragma unroll
          for (int c = 0; c < DVB; ++c) o[c][r] *= a_; } }
    __syncthreads();
    if (ISA) {
        LAS float* X = (LAS float*)(lds + X_OFF) + rg * 4096;
        if (sub == 1) {
#pragma unroll
            for (int c = 0; c < 4; ++c)
#pragma unroll
                for (int r = 0; r < 16; ++r) X[(c * 16 + r) * 64 + lane] = o[c][r];
        }
        __syncthreads();
        if (sub == 0) {
            float ss[16];
#pragma unroll
            for (int r = 0; r < 16; ++r) ss[r] = 0.f;
#pragma unroll
            for (int c = 0; c < 4; ++c)
#pragma unroll
                for (int r = 0; r < 16; ++r) { const float y = o[c][r] - lam * X[(c * 16 + r) * 64 + lane]; o[c][r] = y; ss[r] += y * y; }
#pragma unroll
            for (int r = 0; r < 16; ++r) {
                float v = ss[r];
                v += __shfl_xor(v, 1); v += __shfl_xor(v, 2); v += __shfl_xor(v, 4); v += __shfl_xor(v, 8); v += __shfl_xor(v, 16);
                ss[r] = 0.8f / sqrtf(v * (1.0f / 128.0f) + 1e-5f);
            }
            float gg[4];
#pragma unroll
            for (int c = 0; c < 4; ++c) gg[c] = subg[32 * c + r32];
            LAS u16* stg = (LAS u16*)(lds + X_OFF + rg * 16384);
            asm volatile("s_waitcnt lgkmcnt(0)" ::: "memory");
#pragma unroll
            for (int c = 0; c < 4; ++c)
#pragma unroll
                for (int r = 0; r < 16; ++r) stg[crow(r, hi) * 128 + 32 * c + r32] = f2bf(o[c][r] * ss[r] * gg[c]);
            asm volatile("s_waitcnt lgkmcnt(0)" ::: "memory");
            u16* og = O + (tok0 + q0 + rg * 32) * DM + hx * 128;
#pragma unroll
            for (int i = 0; i < 8; ++i) { const int row = 4 * i + (lane >> 4), ch = lane & 15; const u32x4 v = *(const LAS u32x4*)((LAS const unsigned char*)stg + row * 256 + ch * 16); *(u32x4*)(og + (size_t)row * DM + ch * 8) = v; }
        }
    } else {
        LAS u16* stg = (LAS u16*)(lds + X_OFF + w * 4096);
#pragma unroll
        for (int c = 0; c < 2; ++c)
#pragma unroll
            for (int r = 0; r < 16; ++r) stg[crow(r, hi) * 64 + 32 * c + r32] = f2bf(o[c][r]);
        asm volatile("s_waitcnt lgkmcnt(0)" ::: "memory");
        u16* og = O + (tok0 + q0 + rg * 32) * DM + 512 + (2 * hx + sub) * 64;
#pragma unroll
        for (int i = 0; i < 4; ++i) { const int row = 8 * i + (lane >> 3), ch = lane & 7; const u32x4 v = *(const LAS u32x4*)((LAS const unsigned char*)stg + row * 128 + ch * 16); *(u32x4*)(og + (size_t)row * DM + ch * 8) = v; }
    }
    __syncthreads();
#undef ATT_ISSUE
}

__device__ __forceinline__ void p2_attention(const Frame& F, const Args& a) {
    const u16* QKV = (const u16*)(a.ws + WS_QKV); u16* O = (u16*)(a.ws + WS_O);
    float d1 = 0.f, d2 = 0.f;
    for (int i = 0; i < 64; ++i) { d1 += a.in[4][i] * a.in[5][i]; d2 += a.in[6][i] * a.in[7][i]; }
    const float lam = expf(d1) - expf(d2) + 0.2f;
    const int vcu = (F.G % 8 == 0) ? (F.bid % 8) * (F.G / 8) + F.bid / 8 : F.bid;
    for (int g = vcu; g < 256; g += F.G) {
        const int grp = g >> 3, s = g & 7, b = grp >> 2, hx = grp & 3;
        for (int i = 0; i < 4; ++i) { const int jq = i == 0 ? 31 - s : i == 1 ? 16 + s : i == 2 ? 15 - s : s; attn_unit<true>(F, QKV, O, b, hx, jq, lam, a.in[8], a.in[9]); }
        for (int i = 0; i < 4; ++i) { const int jq = i == 0 ? 31 - s : i == 1 ? 16 + s : i == 2 ? 15 - s : s; attn_unit<false>(F, QKV, O, b, hx, jq, lam, a.in[8], a.in[9]); }
    }
}
}
#ifndef REP_MASK
#define REP_MASK 0
#endif
__global__ void __launch_bounds__(NTHR, 2) mk_fwd(Args args) {
    extern __shared__ __attribute__((aligned(16))) unsigned char lds_raw[];
    Frame F;
    F.lds = (LAS unsigned char*)lds_raw; F.MISC = (volatile LAS unsigned*)(F.lds + MISC_OFF);
    F.tid = threadIdx.x; F.lane = F.tid & 63; F.wave = __builtin_amdgcn_readfirstlane(F.tid >> 6); F.G = gridDim.x; F.bid = blockIdx.x;
    F.ctl = (gu32*)(args.ws + WS_CTL);
    for (int u = F.tid; u < 256; u += NTHR) ((LAS unsigned*)(F.lds + MISC_OFF))[u] = 0u;
    __syncthreads();
    const int lo = args.ph_lo, hi = args.ph_hi;
    const bool multi = (hi - lo) > 1;
    XcdBarrier bar; bar.bar = (unsigned*)(F.ctl + CW_BAR) + args.li * XCD_BAR_WORDS; bar.x = 0; bar.st = nullptr;
    if (multi) bar = xcd_barrier_post((unsigned*)(F.ctl + CW_BAR) + args.li * XCD_BAR_WORDS, F.MISC + 8);
#define IN(k) (lo <= (k) && (k) < hi)
#define SEAM(k) do { if (IN(k) && IN((k) + 1)) xcd_barrier(bar); } while (0)
    unsigned char* ws = args.ws;
    if (IN(0)) { p0_prologue(F, args); if (REP_MASK & 1) p0_prologue(F, args); SEAM(0); }
    if (IN(1)) {
        PDense S; S.A = (const u16*)(ws + WS_H0); S.Bt = (const u16*)(ws + WS_WIN); S.out = (u16*)(ws + WS_QKV); S.H0 = nullptr; S.mode = 0; S.ord.init(NTOK, QKVP, F.G, F.bid);
        pg8::gemm_phase(F.lds + RING_OFF, S); if (REP_MASK & 2) pg8::gemm_phase(F.lds + RING_OFF, S); SEAM(1);
    }
    if (IN(2)) { att::p2_attention(F, args); if (REP_MASK & 4) att::p2_attention(F, args); SEAM(2); }
    if (IN(3)) {
        PDense S; S.A = (const u16*)(ws + WS_O); S.Bt = (const u16*)(ws + WS_WOUT); S.out = (u16*)(ws + WS_U); S.H0 = (const u16*)(ws + WS_H0); S.mode = 1; S.ord.init(NTOK, DM, F.G, F.bid);
        pg8::gemm_phase(F.lds + RING_OFF, S); if (REP_MASK & 8) pg8::gemm_phase(F.lds + RING_OFF, S); SEAM(3);
    }
    if (IN(4)) { p4_router(F, args); SEAM(4); }
    if (IN(5)) {
        const MoeTab T = moe_tab(F.lds); moe_tables(T, (const int*)(F.ctl + CW_CNT));
        PMoe<1> S; S.A = (const u16*)(ws + WS_H1); S.Bt = (const u16*)(ws + WS_W1); S.out = (u16*)(ws + WS_ACT); S.list = (const int*)(ws + WS_LIST); S.gate = nullptr; S.bias = args.in[16]; S.T = T; S.c = F.bid;
        S.prepare();
        pg8::gemm_phase(F.lds + RING_OFF, S); if (REP_MASK & 32) pg8::gemm_phase(F.lds + RING_OFF, S); SEAM(5);
    }
    if (IN(6)) {
        const MoeTab T = moe_tab(F.lds); moe_tables(T, (const int*)(F.ctl + CW_CNT));
        PMoe<0> S; S.A = (const u16*)(ws + WS_ACT); S.Bt = (const u16*)(ws + WS_W2); S.out = (u16*)(ws + WS_YS); S.list = (const int*)(ws + WS_LIST); S.gate = (const float*)(ws + WS_GATE); S.bias = args.in[18]; S.T = T; S.c = F.bid;
        S.prepare();
        pg8::gemm_phase(F.lds + RING_OFF, S); if (REP_MASK & 64) pg8::gemm_phase(F.lds + RING_OFF, S); SEAM(6);
    }
    if (IN(7)) { p7_final(F, args); if (REP_MASK & 128) p7_final(F, args); }
#undef IN
#undef SEAM
}

extern "C" void kernel_launch(void* const* d_in, const int* in_sizes, int n_in, void* d_out, int out_size, void* d_ws, size_t ws_size, hipStream_t stream) {
    static int grid = 0;
    if (grid == 0) {
        if (n_in != 21 || in_sizes[0] != NTOK * DM || out_size != NTOK * DM || ws_size < WS_END) { fprintf(stderr, "kernel_launch: unexpected shapes / workspace (%d inputs, ws %zu)\n", n_in, ws_size); grid = -1; return; }
        int dev = 0, cus = 0, per_cu = 0;
        if (hipGetDevice(&dev) != hipSuccess || hipDeviceGetAttribute(&cus, hipDeviceAttributeMultiprocessorCount, dev) != hipSuccess) { grid = -1; return; }
        if (hipFuncSetAttribute((const void*)mk_fwd, hipFuncAttributeMaxDynamicSharedMemorySize, LDS_BYTES) != hipSuccess) { fprintf(stderr, "kernel_launch: hipFuncSetAttribute failed\n"); grid = -1; return; }
        if (hipOccupancyMaxActiveBlocksPerMultiprocessor(&per_cu, (const void*)mk_fwd, NTHR, LDS_BYTES) != hipSuccess || per_cu < 1) { fprintf(stderr, "kernel_launch: occupancy query says %d blocks per CU\n", per_cu); (void)hipGetLastError(); grid = -1; return; }
        if (cus < 256) { fprintf(stderr, "kernel_launch: needs 256 CUs, device has %d\n", cus); grid = -1; return; }
        grid = 256;
    }
    if (grid < 0) return;
    const float* lq1 = (const float*)d_in[4]; const float* lk1 = (const float*)d_in[5]; const float* lq2 = (const float*)d_in[6]; const float* lk2 = (const float*)d_in[7];
    const float* subg = (const float*)d_in[8]; const float* relb = (const float*)d_in[9];
    char* ws = (char*)d_ws;
    u16* QKV = (u16*)(ws + WS_QKV); u16* O = (u16*)(ws + WS_O);
    (void)hipMemsetAsync(ws + WS_CTL, 0, CTL_BYTES, stream);
    Args a{};
    for (int i = 0; i < 21; ++i) a.in[i] = (const float*)d_in[i];
    a.out = (float*)d_out; a.ws = (unsigned char*)d_ws;
    int nl = 0;
    auto run = [&](int lo, int hi) { a.ph_lo = lo; a.ph_hi = hi; a.li = nl++; hipLaunchKernelGGL(mk_fwd, dim3(grid), dim3(NTHR), LDS_BYTES, stream, a); };
    run(0, 8);
}
```

```cpp
#define REP_MASK 0
#include <hip/hip_runtime.h>
#include <cstdint>
#include <cstdio>

typedef unsigned short u16;
typedef short bf16x8 __attribute__((ext_vector_type(8)));
typedef float f32x4 __attribute__((ext_vector_type(4)));
typedef unsigned u32x4 __attribute__((ext_vector_type(4)));
typedef unsigned u32x2 __attribute__((ext_vector_type(2)));
#define LAS __attribute__((address_space(3)))

constexpr int NTOK = 32768, DM = 1024, SEQ = 4096, NBATCH = 8;
constexpr int QKVP = 3072;
constexpr int NEXP = 32;
constexpr float LOG2E = 1.4426950408889634f;
constexpr float QSCALE = 0.125f * LOG2E;
constexpr float DN_ALPHA = 1.189207115002721f;
constexpr float LN_EPS = 1e-5f;

constexpr size_t MiB = 1u << 20;
constexpr size_t WS_CTL = 0, CTL_BYTES = 1 * MiB;
constexpr size_t WS_RWT = 1 * MiB;
constexpr size_t WS_H1Q = 80 * MiB;
constexpr size_t WS_WIN = 2 * MiB, WS_WOUT = 8 * MiB, WS_W1 = 16 * MiB, WS_W2 = 144 * MiB;
constexpr size_t WS_H1 = 208 * MiB, WS_LIST = 272 * MiB, WS_GATE = 276 * MiB;
constexpr size_t WS_H0 = 280 * MiB, WS_QKV = 344 * MiB, WS_O = 536 * MiB, WS_U = 344 * MiB, WS_ACT = 280 * MiB;
constexpr size_t WS_YS = 600 * MiB, WS_END = 856 * MiB;

__device__ __forceinline__ float bf2f(u16 v) { return __uint_as_float((unsigned)v << 16); }
__device__ __forceinline__ u16 f2bf(float f) { unsigned u = __float_as_uint(f); return (u16)((u + 0x7fffu + ((u >> 16) & 1u)) >> 16); }
__device__ __forceinline__ unsigned pk2(float lo, float hi) { return (unsigned)f2bf(lo) | ((unsigned)f2bf(hi) << 16); }
__device__ __forceinline__ float wave_sum(float v) {
#pragma unroll
    for (int o = 1; o < 64; o <<= 1) v += __shfl_xor(v, o);
    return v;
}


#define GAS __attribute__((address_space(1)))
typedef GAS unsigned gu32;
#define RLX_AGENT __ATOMIC_RELAXED, __HIP_MEMORY_SCOPE_AGENT
#define LDS_WAIT() asm volatile("s_waitcnt lgkmcnt(0)" ::: "memory")
#define VM_WAIT() asm volatile("s_waitcnt vmcnt(0)" ::: "memory")

constexpr int NWAVES = 8, NTHR = 512;
constexpr int RING_OFF = 0, RING_BYTES = 131072, TAB_OFF = 131072, TAB_BYTES = 24576, MISC_OFF = TAB_OFF + TAB_BYTES, LDS_BYTES = MISC_OFF + 1024;
constexpr int CW_CNT = 0;
constexpr int CW_BAR = 4096;

#define XB_TMO      128
#define XB_XCNT(j)  (256  + 64 * (j))
#define XB_XSUB(j)  (1280 + 64 * (j))
#define XB_XGEN(j)  (2304 + 64 * (j))
#define XB_TOP      3328
#define XB_TOPGEN   3392
#define XCD_BAR_WORDS 3456
#define XB_SPIN_CAP (1u << 20)
__device__ __forceinline__ unsigned xb_ld(unsigned* p)              { return __hip_atomic_load(p, __ATOMIC_RELAXED, __HIP_MEMORY_SCOPE_AGENT); }
__device__ __forceinline__ unsigned xb_add(unsigned* p, unsigned v) { return __hip_atomic_fetch_add(p, v, __ATOMIC_RELAXED, __HIP_MEMORY_SCOPE_AGENT); }
__device__ __forceinline__ unsigned xb_xcc_id() { return (unsigned)__builtin_amdgcn_s_getreg((3 << 11) | 20) & 0xFu; }
#define XB_SPIN(cond, bar) do { unsigned _sp = 0; while (cond) { __builtin_amdgcn_s_sleep(1); \
    if ((++_sp & 255u) == 0u) { if (xb_ld(&(bar)[XB_TMO])) break; if (_sp > XB_SPIN_CAP) { atomicAdd(&(bar)[XB_TMO], 1u); break; } } } } while (0)
struct XcdBarrier { unsigned* bar; unsigned x; volatile LAS unsigned* st; };
__device__ __forceinline__ XcdBarrier xcd_barrier_post(unsigned* bar, volatile LAS unsigned* st) {
    XcdBarrier b; b.bar = bar; b.x = xb_xcc_id(); b.st = st;
    if (threadIdx.x == 0) (void)xb_add(&bar[XB_XCNT(b.x)], 1u);
    return b;
}
__device__ __forceinline__ void xcd_barrier_complete(unsigned* bar, unsigned x, unsigned& nloc, unsigned& nx) {
    const unsigned G = gridDim.x * gridDim.y * gridDim.z;
    unsigned sum, cnt, mine, sp = 0u;
    for (;;) {
        sum = 0u; cnt = 0u; mine = 0u;
#pragma unroll
        for (unsigned j = 0; j < 16; ++j) { const unsigned c = xb_ld(&bar[XB_XCNT(j)]); sum += c; cnt += (c > 0u) ? 1u : 0u; mine = (j == x) ? c : mine; }
        if (sum == G) break;
        __builtin_amdgcn_s_sleep(1);
        if ((++sp & 255u) == 0u) { if (xb_ld(&bar[XB_TMO])) break; if (sp > XB_SPIN_CAP) { atomicAdd(&bar[XB_TMO], 1u); break; } }
    }
    nloc = mine > 0u ? mine : 1u; nx = cnt > 0u ? cnt : 1u;
}
__device__ __forceinline__ void xcd_barrier(const XcdBarrier& b) {
    asm volatile("s_waitcnt vmcnt(0)" ::: "memory");
    __syncthreads();
    if (threadIdx.x == 0) {
        unsigned* bar = b.bar;
        __builtin_amdgcn_s_waitcnt(0);
        unsigned nloc = b.st[0], nx = b.st[1];
        if (nloc == 0u) { xcd_barrier_complete(bar, b.x, nloc, nx); b.st[0] = nloc; b.st[1] = nx; }
        const unsigned old = xb_add(&bar[XB_XSUB(b.x)], 1u);
        const unsigned gen = old / nloc;
        if (old + 1u == (gen + 1u) * nloc) {
            __builtin_amdgcn_fence(__ATOMIC_RELEASE, "agent");
            asm volatile("s_waitcnt vmcnt(0)" ::: "memory");
            const unsigned og = xb_add(&bar[XB_TOP], 1u);
            const unsigned tg = og / nx;
            if (og + 1u == (tg + 1u) * nx) xb_add(&bar[XB_TOPGEN], 1u);
            else XB_SPIN(xb_ld(&bar[XB_TOPGEN]) == tg, bar);
            __builtin_amdgcn_fence(__ATOMIC_ACQUIRE, "agent");
            xb_add(&bar[XB_XGEN(b.x)], 1u);
            asm volatile("s_waitcnt vmcnt(0)" ::: "memory");
        } else {
            XB_SPIN(xb_ld(&bar[XB_XGEN(b.x)]) == gen, bar);
            __builtin_amdgcn_fence(__ATOMIC_ACQUIRE, "agent");
            asm volatile("s_waitcnt vmcnt(0)" ::: "memory");
        }
    }
    __syncthreads();
}

namespace pg8 {
constexpr int BM = 256, BK = 64, HALF = 128, HTB = HALF * BK * 2, NXCD = 8, WGM = 8, KD = 1024, NT = KD / BK;
__host__ __device__ __forceinline__ int lds_byte(int r, int c) { const int st = (r >> 4) * 2 + (c >> 5), rr = r & 15, cc = c & 31, ob = rr * 64 + cc * 2; return st * 1024 + (ob ^ (((ob >> 9) & 1) << 5)); }
__host__ __device__ __forceinline__ void stage_rc(int b, int& R, int& C) { const int st = b / 1024, sb = b % 1024, swz = sb ^ (((sb >> 9) & 1) << 5); R = (st >> 1) * 16 + swz / 64; C = (st & 1) * 32 + (swz % 64) / 2; }
__host__ __device__ __forceinline__ int perm32(int rho) { const int n = rho >> 4, i = rho & 15; return 8 * (i >> 2) + 4 * n + (i & 3); }
__device__ __forceinline__ unsigned cvt_pk_bf16(float lo, float hi) { unsigned r; asm volatile("v_cvt_pk_bf16_f32 %0, %1, %2" : "=v"(r) : "v"(lo), "v"(hi)); return r; }

typedef int v8i32 __attribute__((ext_vector_type(8)));
struct Unit { int pm, pn, e, idx; };

struct StaticOrder {
    int nM, nN, nwg, G, c;
    __device__ void init(int M, int N, int G_, int c_) { nM = M / BM; nN = N / BM; nwg = nM * nN; G = G_; c = c_; }
    __device__ bool next(int i, Unit& u) const {
        const long L = (long)i * G + c; if (L >= nwg) return false;
        int wgid = (int)L; { const int q = nwg / NXCD, r = nwg % NXCD, xcd = wgid % NXCD, off = wgid / NXCD; wgid = (xcd < r ? xcd * (q + 1) : r * (q + 1) + (xcd - r) * q) + off; }
        const int nig = WGM * nN, gid = wgid / nig, fm = gid * WGM, gsz = (nM - fm) < WGM ? (nM - fm) : WGM;
        u.pm = fm + ((wgid % nig) % gsz); u.pn = (wgid % nig) / gsz; u.e = 0; u.idx = i; return true;
    }
};

template <class P>
__device__ __forceinline__ void gemm_phase(LAS unsigned char* lds, const P& S) {
    const int tid = threadIdx.x, wid = __builtin_amdgcn_readfirstlane(tid >> 6), lane = tid & 63, wr = wid >> 2, wc = wid & 3, fr = lane & 15, fq = lane >> 4;
    constexpr int KB = P::FP8 ? 1024 : 2048, nt = KB / 128;
    int Rr[2], Cc[2]; unsigned voffB[2];
#pragma unroll
    for (int i = 0; i < 2; ++i) { int R, C; stage_rc(tid * 16 + i * 8192, R, C); const int Rb = P::PERM ? ((R & ~31) + perm32(R & 31)) : R; Rr[i] = R; Cc[i] = C; voffB[i] = (unsigned)(Rb * KB + C * 2); }
    constexpr unsigned kstep = (unsigned)(BK * 2);
    constexpr unsigned hstep = (unsigned)HALF * KB;
    const __amdgpu_buffer_rsrc_t rA = __builtin_amdgcn_make_buffer_rsrc((void*)S.a_ptr(), 0, 0x7fffffff, 0x00020000), rB = __builtin_amdgcn_make_buffer_rsrc((void*)S.b_ptr(), 0, 0x7fffffff, 0x00020000);
    const unsigned ldsw = (unsigned)wid * 1024u;
    const int aoff = lds_byte(wr * 64 + fr, fq * 8), boff = lds_byte(wc * 32 + fr, fq * 8);
#define PG8_SA(b, h) (((b) * 2 + (h)) * HTB)
#define PG8_SB(b, h) ((4 + (b) * 2 + (h)) * HTB)
#define PG8_STAGE(bufoff, rs, sbase, voff) do { _Pragma("unroll") for (int _i = 0; _i < 2; ++_i) \
        __builtin_amdgcn_raw_ptr_buffer_load_lds(rs, (LAS unsigned*)(lds + (bufoff) + ldsw + _i * 8192), 16, (int)(voff)[_i], (int)(sbase), 0, 0); } while (0)
#define PG8_STAGE_A(bufoff, sbase, un, h) do { _Pragma("unroll") for (int _i = 0; _i < 2; ++_i) \
        __builtin_amdgcn_raw_ptr_buffer_load_lds(rA, (LAS unsigned*)(lds + (bufoff) + ldsw + _i * 8192), 16, (int)S.a_off1(un, h, Rr[_i], Cc[_i]), (int)(sbase), 0, 0); } while (0)
#define PG8_LDA(dst, b, h) do { _Pragma("unroll") for (int m = 0; m < 4; ++m) _Pragma("unroll") for (int k = 0; k < 2; ++k) dst[m][k] = *(const LAS bf16x8*)(lds + PG8_SA(b, h) + aoff + m * 2048 + k * 1024); } while (0)
#define PG8_LDB(dst, b, h) do { _Pragma("unroll") for (int n = 0; n < 2; ++n) _Pragma("unroll") for (int k = 0; k < 2; ++k) dst[n][k] = *(const LAS bf16x8*)(lds + PG8_SB(b, h) + boff + n * 2048 + k * 1024); } while (0)
#define PG8_CAT(x) __builtin_bit_cast(v8i32, __builtin_shufflevector((x)[0], (x)[1], 0, 1, 2, 3, 4, 5, 6, 7, 8, 9, 10, 11, 12, 13, 14, 15))
#define PG8_MMA(ai, bj, At, Bt) do { __builtin_amdgcn_sched_barrier(0); __builtin_amdgcn_s_setprio(1); \
        if constexpr (P::FP8) { _Pragma("unroll") for (int m = 0; m < 4; ++m) _Pragma("unroll") for (int n = 0; n < 2; ++n) \
            acc[ai][bj][m][n] = __builtin_amdgcn_mfma_scale_f32_16x16x128_f8f6f4(PG8_CAT(Bt[n]), PG8_CAT(At[m]), acc[ai][bj][m][n], 0, 0, 0, P::SCALE_B, 0, P::SCALE_A); } \
        else { _Pragma("unroll") for (int m = 0; m < 4; ++m) _Pragma("unroll") for (int n = 0; n < 2; ++n) _Pragma("unroll") for (int k = 0; k < 2; ++k) \
            acc[ai][bj][m][n] = __builtin_amdgcn_mfma_f32_16x16x32_bf16(Bt[n][k], At[m][k], acc[ai][bj][m][n], 0, 0, 0); } \
        __builtin_amdgcn_s_setprio(0); __builtin_amdgcn_sched_barrier(0); } while (0)
#define PG8_WAIT_V(n) asm volatile("s_waitcnt vmcnt(" #n ")" ::: "memory")
#define PG8_WAIT_L(n) asm volatile("s_waitcnt lgkmcnt(" #n ")" ::: "memory")
#define PG8_BAR __builtin_amdgcn_s_barrier()
#define PG8_SCHED __builtin_amdgcn_sched_barrier(0)
    Unit cur, nxt; int ui = 0;
    if (!S.next(0, cur)) return;
    f32x4 acc[2][2][4][2];
#pragma unroll
    for (int a = 0; a < 2; ++a)
#pragma unroll
        for (int b = 0; b < 2; ++b)
#pragma unroll
            for (int m = 0; m < 4; ++m)
#pragma unroll
                for (int n = 0; n < 2; ++n) acc[a][b][m][n] = (f32x4){0.f, 0.f, 0.f, 0.f};
    bf16x8 At[4][2], B0[2][2], B1[2][2];
    unsigned cA = S.a_base(cur), cB = S.b_base(cur);
    PG8_STAGE(PG8_SB(0, 0), rB, cB, voffB); PG8_STAGE(PG8_SB(0, 1), rB, cB + hstep, voffB); PG8_STAGE_A(PG8_SA(0, 0), cA, cur, 0); PG8_STAGE_A(PG8_SA(0, 1), cA, cur, 1);
    if (wr == 1) PG8_BAR;
    PG8_WAIT_V(2); PG8_BAR;
    PG8_STAGE(PG8_SB(1, 0), rB, cB + kstep, voffB); PG8_STAGE_A(PG8_SA(1, 0), cA + kstep, cur, 0); PG8_STAGE(PG8_SB(1, 1), rB, cB + hstep + kstep, voffB);
    PG8_WAIT_V(6); PG8_BAR;
    for (;;) {
        const bool has_next = S.next(ui + 1, nxt);
        const unsigned nA = has_next ? S.a_base(nxt) : cA, nB = has_next ? S.b_base(nxt) : cB;
#pragma unroll 1
        for (int t = 0; t < nt; t += 2) {
            const bool last = (t == nt - 2);
            const unsigned a1 = cA + (unsigned)(t + 1) * kstep;
            const unsigned a2 = last ? nA : cA + (unsigned)(t + 2) * kstep, b2 = last ? nB : cB + (unsigned)(t + 2) * kstep;
            const unsigned a3 = a2 + kstep, b3 = b2 + kstep;
            Unit un2; { const bool nx_ = last && has_next; un2.pm = nx_ ? nxt.pm : cur.pm; un2.pn = nx_ ? nxt.pn : cur.pn; un2.e = nx_ ? nxt.e : cur.e; un2.idx = nx_ ? nxt.idx : cur.idx; }
            PG8_LDB(B0, 0, 0); PG8_LDB(B1, 0, 1); PG8_SCHED; PG8_LDA(At, 0, 0); PG8_STAGE_A(PG8_SA(1, 1), a1, cur, 1);
            PG8_WAIT_V(8); PG8_WAIT_L(0); PG8_BAR; PG8_MMA(0, 0, At, B0); PG8_MMA(0, 1, At, B1); PG8_BAR; PG8_SCHED;
            PG8_LDA(At, 0, 1); PG8_STAGE(PG8_SB(0, 0), rB, b2, voffB); PG8_STAGE(PG8_SB(0, 1), rB, b2 + hstep, voffB); PG8_STAGE_A(PG8_SA(0, 0), a2, un2, 0);
            PG8_WAIT_V(8); PG8_WAIT_L(0); PG8_BAR; PG8_MMA(1, 0, At, B0); PG8_MMA(1, 1, At, B1); PG8_BAR; PG8_SCHED;
            PG8_LDB(B0, 1, 0); PG8_LDB(B1, 1, 1); PG8_SCHED; PG8_LDA(At, 1, 0); PG8_STAGE_A(PG8_SA(0, 1), a2, un2, 1);
            PG8_WAIT_V(8); PG8_WAIT_L(0); PG8_BAR; PG8_MMA(0, 0, At, B0); PG8_MMA(0, 1, At, B1); PG8_BAR; PG8_SCHED;
            PG8_LDA(At, 1, 1); PG8_STAGE(PG8_SB(1, 0), rB, b3, voffB); PG8_STAGE(PG8_SB(1, 1), rB, b3 + hstep, voffB); PG8_STAGE_A(PG8_SA(1, 0), a3, un2, 0);
            PG8_WAIT_V(8); PG8_WAIT_L(0); PG8_BAR; PG8_MMA(1, 0, At, B0); PG8_MMA(1, 1, At, B1); PG8_BAR; PG8_SCHED;
        }
        if (wr == 0) PG8_BAR;
        { int fr_e = fr, fq_e = fq; asm volatile("" : "+v"(fr_e), "+v"(fq_e)); S.epi(acc, cur, wr, wc, fr_e, fq_e); }
        if (!has_next) break;
#pragma unroll
        for (int a = 0; a < 2; ++a)
#pragma unroll
            for (int b = 0; b < 2; ++b)
#pragma unroll
                for (int m = 0; m < 4; ++m)
#pragma unroll
                    for (int n = 0; n < 2; ++n) acc[a][b][m][n] = (f32x4){0.f, 0.f, 0.f, 0.f};
        cur = nxt; cA = nA; cB = nB; ++ui;
        if (wr == 1) PG8_BAR;
    }
    PG8_WAIT_V(0);
    PG8_BAR;
#undef PG8_SA
#undef PG8_SB
#undef PG8_STAGE
#undef PG8_STAGE_A
#undef PG8_LDA
#undef PG8_LDB
#undef PG8_MMA
#undef PG8_CAT
#undef PG8_WAIT_V
#undef PG8_WAIT_L
#undef PG8_BAR
#undef PG8_SCHED
}
}

struct PDense {
    static constexpr bool PERM = true, FP8 = false; static constexpr int SCALE_A = 0, SCALE_B = 0;
    const u16* A; const u16* Bt; u16* out; const u16* H0; int mode; pg8::StaticOrder ord;
    __device__ __forceinline__ bool next(int i, pg8::Unit& u) const { return ord.next(i, u); }
    __device__ __forceinline__ const void* a_ptr() const { return A; }
    __device__ __forceinline__ const void* b_ptr() const { return Bt; }
    __device__ __forceinline__ unsigned a_base(const pg8::Unit& u) const { return (unsigned)u.pm * 256u * 2048u; }
    __device__ __forceinline__ unsigned b_base(const pg8::Unit& u) const { return (unsigned)u.pn * 256u * 2048u; }
    __device__ __forceinline__ unsigned a_off1(const pg8::Unit&, int h, int R, int C) const { return (unsigned)((h * 128 + R) * 1024 + C) * 2u; }
    __device__ __forceinline__ void epi(const f32x4 (&acc)[2][2][4][2], const pg8::Unit& u, int wr, int wc, int fr, int fq) const {
        const int row0 = u.pm * 256 + wr * 64 + fr, col0 = u.pn * 256 + wc * 32 + 8 * fq;
        const int ldc = mode == 0 ? QKVP : DM;
        const float sc = (mode == 0 && (u.pn < 2 || u.pn == 6 || u.pn == 7)) ? QSCALE : 1.0f;
#pragma unroll
        for (int ai = 0; ai < 2; ++ai)
#pragma unroll
            for (int m = 0; m < 4; ++m) {
                const size_t off = (size_t)(row0 + ai * 128 + m * 16) * ldc + col0;
#pragma unroll
                for (int bj = 0; bj < 2; ++bj) {
                    f32x4 v0 = acc[ai][bj][m][0] * sc, v1 = acc[ai][bj][m][1] * sc;
                    if (mode == 1) {
                        const u32x4 h = *(const u32x4*)(H0 + off + bj * 128);
                        v0[0] += DN_ALPHA * __uint_as_float(h.x << 16); v0[1] += DN_ALPHA * __uint_as_float(h.x & 0xffff0000u); v0[2] += DN_ALPHA * __uint_as_float(h.y << 16); v0[3] += DN_ALPHA * __uint_as_float(h.y & 0xffff0000u);
                        v1[0] += DN_ALPHA * __uint_as_float(h.z << 16); v1[1] += DN_ALPHA * __uint_as_float(h.z & 0xffff0000u); v1[2] += DN_ALPHA * __uint_as_float(h.w << 16); v1[3] += DN_ALPHA * __uint_as_float(h.w & 0xffff0000u);
                    }
                    u32x4 w; w.x = pg8::cvt_pk_bf16(v0[0], v0[1]); w.y = pg8::cvt_pk_bf16(v0[2], v0[3]); w.z = pg8::cvt_pk_bf16(v1[0], v1[1]); w.w = pg8::cvt_pk_bf16(v1[2], v1[3]);
                    *(u32x4*)(out + off + bj * 128) = w;
                }
            }
    }
};

struct MoeTab { LAS int* tb; LAS int* cn; LAS int* rowoff; };
__device__ __forceinline__ MoeTab moe_tab(LAS unsigned char* lds) { MoeTab t; t.rowoff = (LAS int*)(lds + TAB_OFF); t.tb = (LAS int*)(lds + TAB_OFF + 20480); t.cn = t.tb + 40; return t; }
__device__ __forceinline__ void moe_tables(const MoeTab& T, const int* cnt) {
    if (threadIdx.x == 0) { int s = 0; for (int e = 0; e < NEXP; ++e) { const int c = __hip_atomic_load(cnt + e, RLX_AGENT); T.cn[e] = c; T.tb[e] = s; s += (c + 255) >> 8; } T.tb[NEXP] = s; }
    __syncthreads();
}
__device__ __forceinline__ int moe_find_e(const MoeTab& T, int RT) { int e = 0; while (e < NEXP - 1 && RT >= T.tb[e + 1]) ++e; return e; }

template <int UP>
struct PMoe {
    static constexpr bool PERM = true, FP8 = true; static constexpr int SCALE_A = UP ? 0x7c7c7c7c : 0x7d7d7d7d, SCALE_B = UP ? 0x75757575 : 0x74747474;
    static constexpr int NPN = UP ? 8 : 4, RPG = UP ? 4 : 8;
    const unsigned char* A; const unsigned char* Bt; void* out; const int* list; const float* gate; const float* bias; MoeTab T; int c, ntot;
    __device__ __forceinline__ bool next(int i, pg8::Unit& u) const {
        const int x = c & 7, s = c >> 3; const int RT = (i * 8 + x) * RPG + (s % RPG);
        if (RT >= ntot) return false;
        u.pm = RT; u.pn = s / RPG; u.e = moe_find_e(T, RT); u.idx = i; return true;
    }
    __device__ __forceinline__ const void* a_ptr() const { return A; }
    __device__ __forceinline__ const void* b_ptr() const { return Bt; }
    __device__ __forceinline__ unsigned a_base(const pg8::Unit& u) const { return UP ? 0u : (unsigned)u.pm * 256u * 1024u; }
    __device__ __forceinline__ unsigned b_base(const pg8::Unit& u) const { return ((unsigned)u.e * (UP ? 2048u : 1024u) + (unsigned)u.pn * 256u) * 1024u; }
    __device__ __forceinline__ unsigned a_off1(const pg8::Unit& u, int h, int R, int C) const { return UP ? (unsigned)T.rowoff[u.idx * 256 + h * 128 + R] + (unsigned)C * 2u : (unsigned)((h * 128 + R) * 1024 + C * 2); }
    __device__ __forceinline__ void prepare() const {
        if (UP) {
            pg8::Unit u;
            for (int i = 0; next(i, u); ++i) {
                if (threadIdx.x < 256) { const int r = (u.pm - T.tb[u.e]) * 256 + (int)threadIdx.x; const int ent = list[(size_t)u.e * NTOK + (r < T.cn[u.e] ? r : 0)]; T.rowoff[i * 256 + threadIdx.x] = (ent >> 2) * 1024; }
            }
        }
        __syncthreads();
    }
    __device__ __forceinline__ void epi(const f32x4 (&acc)[2][2][4][2], const pg8::Unit& u, int wr, int wc, int fr, int fq) const {
        const int rl0 = wr * 64 + fr, col0 = u.pn * 256 + wc * 32 + 8 * fq;
        if (UP) {
            const float* bp = bias + (size_t)u.e * 2048 + col0;
            f32x4 bv[2][2];
#pragma unroll
            for (int bj = 0; bj < 2; ++bj) { bv[bj][0] = *(const f32x4*)(bp + bj * 128); bv[bj][1] = *(const f32x4*)(bp + bj * 128 + 4); }
#pragma unroll
            for (int ai = 0; ai < 2; ++ai)
#pragma unroll
                for (int m = 0; m < 4; ++m) {
                    unsigned char* rowp = (unsigned char*)out + (size_t)(u.pm * 256 + rl0 + ai * 128 + m * 16) * 1024 + (col0 >> 1);
#pragma unroll
                    for (int bj = 0; bj < 2; ++bj) {
                        const f32x4 v0 = acc[ai][bj][m][0] + bv[bj][0], v1 = acc[ai][bj][m][1] + bv[bj][1];
                        float a[4];
#pragma unroll
                        for (int p = 0; p < 4; ++p) {
                            const float glu = p < 2 ? v0[2 * p] : v1[2 * p - 4], lin = p < 2 ? v0[2 * p + 1] : v1[2 * p - 3];
                            const float xg = fminf(glu, 7.0f), xl = fminf(fmaxf(lin, -7.0f), 7.0f);
                            a[p] = xg * __builtin_amdgcn_rcpf(1.0f + __builtin_amdgcn_exp2f(-1.702f * LOG2E * xg)) * (xl + 1.0f);
                        }
                        int w = __builtin_amdgcn_cvt_pk_fp8_f32(a[0] * 4.0f, a[1] * 4.0f, 0, false); w = __builtin_amdgcn_cvt_pk_fp8_f32(a[2] * 4.0f, a[3] * 4.0f, w, true);
                        *(int*)(rowp + bj * 64) = w;
                    }
                }
        } else {
            const float* bp = bias + (size_t)u.e * 1024 + col0;
            f32x4 bv[2][2];
#pragma unroll
            for (int bj = 0; bj < 2; ++bj) { bv[bj][0] = *(const f32x4*)(bp + bj * 128); bv[bj][1] = *(const f32x4*)(bp + bj * 128 + 4); }
            const int rbase = (u.pm - T.tb[u.e]) * 256, cnt = T.cn[u.e];
#pragma unroll
            for (int ai = 0; ai < 2; ++ai)
#pragma unroll
                for (int m = 0; m < 4; ++m) {
                    const int r = rbase + rl0 + ai * 128 + m * 16;
                    if (r < cnt) {
                        const int ent = list[(size_t)u.e * NTOK + r]; const float gt = gate[ent];
                        u16* rowp = (u16*)out + (size_t)ent * 1024 + col0;
#pragma unroll
                        for (int bj = 0; bj < 2; ++bj) {
                            const f32x4 v0 = (acc[ai][bj][m][0] + bv[bj][0]) * gt, v1 = (acc[ai][bj][m][1] + bv[bj][1]) * gt;
                            u32x4 w; w.x = pg8::cvt_pk_bf16(v0[0], v0[1]); w.y = pg8::cvt_pk_bf16(v0[2], v0[3]); w.z = pg8::cvt_pk_bf16(v1[0], v1[1]); w.w = pg8::cvt_pk_bf16(v1[2], v1[3]);
                            *(u32x4*)(rowp + bj * 128) = w;
                        }
                    }
                }
        }
    }
};

struct Frame {
    LAS unsigned char* lds; volatile LAS unsigned* MISC; gu32* ctl; int tid, lane, wave, G, bid;
};
__device__ __forceinline__ void p0_transpose_item(const float* W, int K, int N, u16* WT, LAS float* scr, int item, int lane) {
    const int nblk = N / 32, kb = item / nblk, nb = item % nblk, k0 = 64 * kb, n0 = 32 * nb;
    f32x4 v[8];
#pragma unroll
    for (int it = 0; it < 8; ++it) v[it] = *(const f32x4*)(W + (size_t)(k0 + (lane >> 3) + 8 * it) * N + n0 + (lane & 7) * 4);
#pragma unroll
    for (int it = 0; it < 8; ++it) { const int k = (lane >> 3) + 8 * it, n4 = (lane & 7) * 4; scr[(n4 + 0) * 68 + k] = v[it].x; scr[(n4 + 1) * 68 + k] = v[it].y; scr[(n4 + 2) * 68 + k] = v[it].z; scr[(n4 + 3) * 68 + k] = v[it].w; }
    LDS_WAIT(); asm volatile("" ::: "memory");
#pragma unroll
    for (int it = 0; it < 4; ++it) {
        const int n = (lane >> 3) + 8 * it, c = lane & 7; const LAS float* s = scr + n * 68 + 8 * c;
        const f32x4 a = *(const LAS f32x4*)s, b = *(const LAS f32x4*)(s + 4);
        u32x4 o; o.x = pk2(a.x, a.y); o.y = pk2(a.z, a.w); o.z = pk2(b.x, b.y); o.w = pk2(b.z, b.w);
        *(u32x4*)(WT + (size_t)(n0 + n) * K + k0 + 8 * c) = o;
    }
    LDS_WAIT(); asm volatile("" ::: "memory");
}
__device__ __forceinline__ void p0_transpose_item_fp8(const float* W, int K, int N, unsigned char* WT, LAS float* scr, int item, int lane, float scale) {
    const int nblk = N / 32, kb = item / nblk, nb = item % nblk, k0 = 64 * kb, n0 = 32 * nb;
    f32x4 v[8];
#pragma unroll
    for (int it = 0; it < 8; ++it) v[it] = *(const f32x4*)(W + (size_t)(k0 + (lane >> 3) + 8 * it) * N + n0 + (lane & 7) * 4);
#pragma unroll
    for (int it = 0; it < 8; ++it) { const int k = (lane >> 3) + 8 * it, n4 = (lane & 7) * 4; scr[(n4 + 0) * 68 + k] = v[it].x; scr[(n4 + 1) * 68 + k] = v[it].y; scr[(n4 + 2) * 68 + k] = v[it].z; scr[(n4 + 3) * 68 + k] = v[it].w; }
    LDS_WAIT(); asm volatile("" ::: "memory");
#pragma unroll
    for (int it = 0; it < 2; ++it) {
        const int n = (lane >> 2) + 16 * it, c = lane & 3; const LAS float* s = scr + n * 68 + 16 * c;
        u32x4 o;
#pragma unroll
        for (int q = 0; q < 4; ++q) { f32x4 a = *(const LAS f32x4*)(s + 4 * q) * scale;
            a.x = fminf(fmaxf(a.x, -448.f), 448.f); a.y = fminf(fmaxf(a.y, -448.f), 448.f); a.z = fminf(fmaxf(a.z, -448.f), 448.f); a.w = fminf(fmaxf(a.w, -448.f), 448.f);
            int w = __builtin_amdgcn_cvt_pk_fp8_f32(a.x, a.y, 0, false); w = __builtin_amdgcn_cvt_pk_fp8_f32(a.z, a.w, w, true); o[q] = (unsigned)w; }
        *(u32x4*)(WT + (size_t)(n0 + n) * K + k0 + 16 * c) = o;
    }
    LDS_WAIT(); asm volatile("" ::: "memory");
}
__device__ __forceinline__ void ln_row_in(const float* xrow, const float* g, const float* b, u16* orow, int lane) {
    const f32x4* xr = (const f32x4*)xrow + lane;
    f32x4 v[4]; float s = 0.f;
#pragma unroll
    for (int j = 0; j < 4; ++j) { v[j] = xr[64 * j]; s += (v[j].x + v[j].y) + (v[j].z + v[j].w); }
    const float mean = wave_sum(s) * (1.f / DM); float s2 = 0.f;
#pragma unroll
    for (int j = 0; j < 4; ++j) { v[j] = v[j] - mean; s2 += (v[j].x * v[j].x + v[j].y * v[j].y) + (v[j].z * v[j].z + v[j].w * v[j].w); }
    const float rstd = 1.f / sqrtf(wave_sum(s2) * (1.f / DM) + LN_EPS);
    u32x2* o8 = (u32x2*)orow + lane;
#pragma unroll
    for (int j = 0; j < 4; ++j) {
        const f32x4 gg = ((const f32x4*)g)[lane + 64 * j], bb = ((const f32x4*)b)[lane + 64 * j];
        u32x2 w; w.x = pk2(v[j].x * rstd * gg.x + bb.x, v[j].y * rstd * gg.y + bb.y); w.y = pk2(v[j].z * rstd * gg.z + bb.z, v[j].w * rstd * gg.w + bb.w);
        o8[64 * j] = w;
    }
}

struct Args { const float* in[21]; float* out; unsigned char* ws; int ph_lo, ph_hi, li, pad; };

__device__ __forceinline__ void p0_prologue(const Frame& F, const Args& a) {
    unsigned char* ws = a.ws;
    u16* WIN = (u16*)(ws + WS_WIN); u16* WOUT = (u16*)(ws + WS_WOUT); unsigned char* W1T = ws + WS_W1; unsigned char* W2T = ws + WS_W2; u16* H0 = (u16*)(ws + WS_H0);
    LAS float* scr = (LAS float*)(F.lds + RING_OFF + F.wave * 8704);
    const int gw = F.bid * NWAVES + F.wave, NGW = F.G * NWAVES;
    constexpr int I_IN = 16 * 96, I_OUT = 16 * 32, I_W1 = 16 * 64, I_W2 = 16 * 32;
    constexpr int NITEMS = I_IN + I_OUT + NEXP * I_W1 + NEXP * I_W2;
    for (int it = gw; it < NITEMS; it += NGW) {
        int r = it;
        if (r < I_IN) { p0_transpose_item(a.in[3], 1024, 3072, WIN, scr, r, F.lane); continue; } r -= I_IN;
        if (r < I_OUT) { p0_transpose_item(a.in[10], 1024, 1024, WOUT, scr, r, F.lane); continue; } r -= I_OUT;
        if (r < NEXP * I_W1) { const int e = r / I_W1; p0_transpose_item_fp8(a.in[15] + (size_t)e * 1024 * 2048, 1024, 2048, W1T + (size_t)e * 1024 * 2048, scr, r % I_W1, F.lane, 1024.0f); continue; } r -= NEXP * I_W1;
        { const int e = r / I_W2; p0_transpose_item_fp8(a.in[17] + (size_t)e * 1024 * 1024, 1024, 1024, W2T + (size_t)e * 1024 * 1024, scr, r % I_W2, F.lane, 2048.0f); }
    }
    { u16* RW = (u16*)(ws + WS_RWT); const float* rw = a.in[13];
      for (int idx = F.bid * NTHR + F.tid; idx < 32768; idx += F.G * NTHR) { const int e = idx >> 10, k = idx & 1023; const float v = rw[k * 32 + e]; const u16 hi = f2bf(v); RW[idx] = hi; RW[32768 + idx] = f2bf(v - bf2f(hi)); } }
    for (int m = gw; m < NTOK; m += NGW) ln_row_in(a.in[0] + (size_t)m * DM, a.in[1], a.in[2], H0 + (size_t)m * DM, F.lane);
}

__device__ __forceinline__ void p4_router(const Frame& F, const Args& a) {
    unsigned char* ws = a.ws;
    const u16* U = (const u16*)(ws + WS_U); u16* H1 = (u16*)(ws + WS_H1); int* LIST = (int*)(ws + WS_LIST); float* GATE = (float*)(ws + WS_GATE); int* CNT = (int*)(F.ctl + CW_CNT);
    const float* g1 = a.in[11]; const float* b1 = a.in[12]; const float* rb = a.in[14];
    const u32x4* RWT = (const u32x4*)(ws + WS_RWT);
    LAS int* lcnt = (LAS int*)(F.lds + TAB_OFF); LAS int* lbase = lcnt + 32; LAS int* ent_e = lcnt + 64; LAS int* ent_p = ent_e + 512;
    const int lane = F.lane, tok = lane & 15, kg = lane >> 4;
    for (int i = F.tid; i < 8192; i += NTHR) { const int img = i >> 12, e = (i >> 7) & 31, c = i & 127; *(LAS u32x4*)(F.lds + RING_OFF + img * 65536 + e * 2048 + 16 * (c ^ (e & 15))) = RWT[i]; }
    for (int batch = F.bid; batch < NTOK / 128; batch += F.G) {
        __syncthreads();
        if (F.tid < 32) lcnt[F.tid] = 0;
        __syncthreads();
        const int tl = F.wave * 16 + tok, t = batch * 128 + tl;
        const u32x4* ur = (const u32x4*)(U + (size_t)t * DM) + kg;
        float s1 = 0.f;
#pragma unroll 8
        for (int s = 0; s < 32; ++s) { const u32x4 w = ur[4 * s];
            s1 += (__uint_as_float(w.x << 16) + __uint_as_float(w.x & 0xffff0000u)) + (__uint_as_float(w.y << 16) + __uint_as_float(w.y & 0xffff0000u))
                + (__uint_as_float(w.z << 16) + __uint_as_float(w.z & 0xffff0000u)) + (__uint_as_float(w.w << 16) + __uint_as_float(w.w & 0xffff0000u)); }
        s1 += __shfl_xor(s1, 16); s1 += __shfl_xor(s1, 32);
        const float mean = s1 * (1.f / DM);
        float s2 = 0.f;
#pragma unroll 8
        for (int s = 0; s < 32; ++s) { const u32x4 w = ur[4 * s];
            const float d0 = __uint_as_float(w.x << 16) - mean, d1 = __uint_as_float(w.x & 0xffff0000u) - mean, d2 = __uint_as_float(w.y << 16) - mean, d3 = __uint_as_float(w.y & 0xffff0000u) - mean;
            const float d4 = __uint_as_float(w.z << 16) - mean, d5 = __uint_as_float(w.z & 0xffff0000u) - mean, d6 = __uint_as_float(w.w << 16) - mean, d7 = __uint_as_float(w.w & 0xffff0000u) - mean;
            s2 += (d0 * d0 + d1 * d1) + (d2 * d2 + d3 * d3) + (d4 * d4 + d5 * d5) + (d6 * d6 + d7 * d7); }
        s2 += __shfl_xor(s2, 16); s2 += __shfl_xor(s2, 32);
        const float rstd = 1.f / sqrtf(s2 * (1.f / DM) + LN_EPS);
        f32x4 acc[2];
        acc[0] = (f32x4){0.f, 0.f, 0.f, 0.f}; acc[1] = (f32x4){0.f, 0.f, 0.f, 0.f};
        u32x4* hr = (u32x4*)(H1 + (size_t)t * DM) + kg;
        u32x2* hq = (u32x2*)(ws + WS_H1Q + (size_t)t * DM) + kg;
        LAS const unsigned char* wimg = F.lds + RING_OFF + tok * 2048;
#pragma unroll 2
        for (int s = 0; s < 32; ++s) {
            const u32x4 w = ur[4 * s];
            const f32x4 ga = *(const f32x4*)(g1 + 32 * s + 8 * kg), gb = *(const f32x4*)(g1 + 32 * s + 8 * kg + 4), ba = *(const f32x4*)(b1 + 32 * s + 8 * kg), bb = *(const f32x4*)(b1 + 32 * s + 8 * kg + 4);
            float h[8];
            h[0] = (__uint_as_float(w.x << 16) - mean) * rstd * ga.x + ba.x; h[1] = (__uint_as_float(w.x & 0xffff0000u) - mean) * rstd * ga.y + ba.y;
            h[2] = (__uint_as_float(w.y << 16) - mean) * rstd * ga.z + ba.z; h[3] = (__uint_as_float(w.y & 0xffff0000u) - mean) * rstd * ga.w + ba.w;
            h[4] = (__uint_as_float(w.z << 16) - mean) * rstd * gb.x + bb.x; h[5] = (__uint_as_float(w.z & 0xffff0000u) - mean) * rstd * gb.y + bb.y;
            h[6] = (__uint_as_float(w.w << 16) - mean) * rstd * gb.z + bb.z; h[7] = (__uint_as_float(w.w & 0xffff0000u) - mean) * rstd * gb.w + bb.w;
            u32x4 hh, hl;
            hh.x = pk2(h[0], h[1]); hh.y = pk2(h[2], h[3]); hh.z = pk2(h[4], h[5]); hh.w = pk2(h[6], h[7]);
            hr[4 * s] = hh;
            { u32x2 q8; int w0 = __builtin_amdgcn_cvt_pk_fp8_f32(h[0] * 8.0f, h[1] * 8.0f, 0, false); w0 = __builtin_amdgcn_cvt_pk_fp8_f32(h[2] * 8.0f, h[3] * 8.0f, w0, true);
              int w1 = __builtin_amdgcn_cvt_pk_fp8_f32(h[4] * 8.0f, h[5] * 8.0f, 0, false); w1 = __builtin_amdgcn_cvt_pk_fp8_f32(h[6] * 8.0f, h[7] * 8.0f, w1, true); q8.x = (unsigned)w0; q8.y = (unsigned)w1; hq[4 * s] = q8; }
            hl.x = pk2(h[0] - __uint_as_float(hh.x << 16), h[1] - __uint_as_float(hh.x & 0xffff0000u)); hl.y = pk2(h[2] - __uint_as_float(hh.y << 16), h[3] - __uint_as_float(hh.y & 0xffff0000u));
            hl.z = pk2(h[4] - __uint_as_float(hh.z << 16), h[5] - __uint_as_float(hh.z & 0xffff0000u)); hl.w = pk2(h[6] - __uint_as_float(hh.w << 16), h[7] - __uint_as_float(hh.w & 0xffff0000u));
            const bf16x8 bh = __builtin_bit_cast(bf16x8, hh), bl = __builtin_bit_cast(bf16x8, hl);
            const unsigned co = 16u * ((unsigned)(4 * s + kg) ^ (unsigned)tok);
#pragma unroll
            for (int eh = 0; eh < 2; ++eh) {
                const bf16x8 wh = *(const LAS bf16x8*)(wimg + eh * 32768 + co), wl = *(const LAS bf16x8*)(wimg + 65536 + eh * 32768 + co);
                acc[eh] = __builtin_amdgcn_mfma_f32_16x16x32_bf16(wh, bh, acc[eh], 0, 0, 0);
                acc[eh] = __builtin_amdgcn_mfma_f32_16x16x32_bf16(wl, bh, acc[eh], 0, 0, 0);
                acc[eh] = __builtin_amdgcn_mfma_f32_16x16x32_bf16(wh, bl, acc[eh], 0, 0, 0);
            }
        }
        float lg[8];
#pragma unroll
        for (int eh = 0; eh < 2; ++eh)
#pragma unroll
            for (int r = 0; r < 4; ++r) lg[eh * 4 + r] = acc[eh][r] + rb[16 * eh + 4 * kg + r];
        unsigned used = 0u; float tv[4]; int ti[4];
#pragma unroll
        for (int k = 0; k < 4; ++k) {
            float best = -INFINITY; int bi = 1 << 20;
#pragma unroll
            for (int j = 0; j < 8; ++j) { const int e = 16 * (j >> 2) + 4 * kg + (j & 3); const bool ok = !((used >> j) & 1u) && (lg[j] > best || (lg[j] == best && e < bi)); best = ok ? lg[j] : best; bi = ok ? e : bi; }
#pragma unroll
            for (int off = 16; off <= 32; off <<= 1) { const float ov = __shfl_xor(best, off); const int oi = __shfl_xor(bi, off); const bool tk = ov > best || (ov == best && oi < bi); best = tk ? ov : best; bi = tk ? oi : bi; }
            tv[k] = best; ti[k] = bi;
#pragma unroll
            for (int j = 0; j < 8; ++j) { const int e = 16 * (j >> 2) + 4 * kg + (j & 3); if (e == bi) used |= 1u << j; }
        }
        const float e1 = __expf(tv[1] - tv[0]), e2 = __expf(tv[2] - tv[0]), e3 = __expf(tv[3] - tv[0]);
        const float inv = 1.f / (1.f + e1 + e2 + e3);
        {
            const int me = kg == 0 ? ti[0] : kg == 1 ? ti[1] : kg == 2 ? ti[2] : ti[3];
            const float mg = (kg == 0 ? 1.f : kg == 1 ? e1 : kg == 2 ? e2 : e3) * inv;
            const int pos = __hip_atomic_fetch_add(lcnt + me, 1, __ATOMIC_RELAXED, __HIP_MEMORY_SCOPE_WORKGROUP);
            ent_e[tl * 4 + kg] = me; ent_p[tl * 4 + kg] = pos; GATE[t * 4 + kg] = mg;
        }
        __syncthreads();
        if (F.tid < 32) lbase[F.tid] = atomicAdd(CNT + F.tid, lcnt[F.tid]);
        __syncthreads();
        { const int e = ent_e[F.tid]; LIST[(size_t)e * NTOK + lbase[e] + ent_p[F.tid]] = (batch * 128 + (F.tid >> 2)) * 4 + (F.tid & 3); }
    }
}

__device__ __forceinline__ void p7_final(const Frame& F, const Args& a) {
    const u16* H1 = (const u16*)(a.ws + WS_H1); const u16* YS = (const u16*)(a.ws + WS_YS); const float* g2 = a.in[19]; const float* b2 = a.in[20];
    const int lane = F.lane, gw = F.bid * NWAVES + F.wave, NGW = F.G * NWAVES;
    for (int t = gw; t < NTOK; t += NGW) {
        float v[16]; float s = 0.f;
#pragma unroll
        for (int j = 0; j < 4; ++j) {
            const u32x2 w = ((const u32x2*)(H1 + (size_t)t * DM) + lane)[64 * j];
            float a0 = DN_ALPHA * __uint_as_float(w.x << 16), a1 = DN_ALPHA * __uint_as_float(w.x & 0xffff0000u), a2 = DN_ALPHA * __uint_as_float(w.y << 16), a3 = DN_ALPHA * __uint_as_float(w.y & 0xffff0000u);
#pragma unroll
            for (int k = 0; k < 4; ++k) {
                const u32x2 y = ((const u32x2*)(YS + ((size_t)t * 4 + k) * DM) + lane)[64 * j];
                a0 += __uint_as_float(y.x << 16); a1 += __uint_as_float(y.x & 0xffff0000u); a2 += __uint_as_float(y.y << 16); a3 += __uint_as_float(y.y & 0xffff0000u);
            }
            v[4 * j] = a0; v[4 * j + 1] = a1; v[4 * j + 2] = a2; v[4 * j + 3] = a3; s += (a0 + a1) + (a2 + a3);
        }
        const float mean = wave_sum(s) * (1.f / DM); float s2 = 0.f;
#pragma unroll
        for (int i = 0; i < 16; ++i) { v[i] -= mean; s2 += v[i] * v[i]; }
        const float rstd = 1.f / sqrtf(wave_sum(s2) * (1.f / DM) + LN_EPS);
        f32x4* o = (f32x4*)(a.out + (size_t)t * DM) + lane;
#pragma unroll
        for (int j = 0; j < 4; ++j) {
            const f32x4 gg = ((const f32x4*)g2)[lane + 64 * j], bb = ((const f32x4*)b2)[lane + 64 * j];
            o[64 * j] = (f32x4){v[4 * j] * rstd * gg.x + bb.x, v[4 * j + 1] * rstd * gg.y + bb.y, v[4 * j + 2] * rstd * gg.z + bb.z, v[4 * j + 3] * rstd * gg.w + bb.w};
        }
    }
}


namespace att {
typedef float f32x16 __attribute__((ext_vector_type(16)));
typedef short s16x4 __attribute__((ext_vector_type(4)));
typedef short v4i16_t __attribute__((ext_vector_type(4)));
constexpr int KV_BUF = 32768, X_OFF = 65536, WSF_OFF = TAB_OFF, TBL_OFF = TAB_OFF + 2048;
constexpr float THR = 6.0f;
__device__ __forceinline__ int crow(int r, int hi) { return (r & 3) + 8 * (r >> 2) + 4 * hi; }
__device__ __forceinline__ unsigned cvtpk(float lo, float hi) { typedef float f2 __attribute__((ext_vector_type(2))); typedef __bf16 b2 __attribute__((ext_vector_type(2))); f2 v = {lo, hi}; b2 b = __builtin_convertvector(v, b2); return __builtin_bit_cast(unsigned, b); }
__device__ __forceinline__ s16x4 vtr(LAS const unsigned char* p) { return __builtin_bit_cast(s16x4, __builtin_amdgcn_ds_read_tr16_b64_v4i16((LAS v4i16_t*)p)); }
__device__ __forceinline__ float swapmax(float m) { auto rr = __builtin_amdgcn_permlane32_swap(__float_as_uint(m), __float_as_uint(m), false, false); return fmaxf(__uint_as_float(rr[0]), __uint_as_float(rr[1])); }
__device__ __forceinline__ float swapsum(float m) { auto rr = __builtin_amdgcn_permlane32_swap(__float_as_uint(m), __float_as_uint(m), false, false); return __uint_as_float(rr[0]) + __uint_as_float(rr[1]); }

template <bool ISA>
__device__ __forceinline__ void attn_unit(const Frame& F, const u16* QKV, u16* O, int b, int hx, int jq, float lam, const float* subg, const float* relb) {
    constexpr int DVB = ISA ? 4 : 2;
    const int lane = F.lane, w = F.wave, sub = w >> 2, rg = w & 3, r32 = lane & 31, hi = lane >> 5;
    const int q0 = jq * 128, cq = 2 * jq + (rg >> 1);
    const int qpos = q0 + rg * 32 + r32;
    const size_t tok0 = (size_t)b * SEQ;
    const int qcol = (ISA ? hx * 128 : 1536 + hx * 128) + sub * 64;
    const int kcol0 = ISA ? 512 + hx * 128 : 2048 + hx * 128, vcol0 = ISA ? 1024 + hx * 128 : 2560 + hx * 128;
    const int ktop = 2 * jq + 1, kbot = ISA ? 0 : (2 * jq - 8 > 0 ? 2 * jq - 8 : 0);
    const int NTs = ktop - kbot + 1;
    LAS unsigned char* lds = F.lds;
    unsigned soff[2];
#pragma unroll
    for (int i = 0; i < 2; ++i) { const unsigned row = 4u * (8u * i + w) + (lane >> 4); const unsigned f = ((row & 3u) << 2) | ((row >> 2) & 3u); soff[i] = row * (QKVP * 2) + (((unsigned)lane & 15u) ^ f) * 16u; }
    const char* kvbase = (const char*)QKV + (tok0 * QKVP + kcol0) * 2;
    const unsigned ldsw = (unsigned)w * 1024u;
#define ATT_ISSUE(kt, buf) do { const char* kb_ = kvbase + (size_t)(kt) * 64 * QKVP * 2; const char* vb_ = kb_ + (vcol0 - kcol0) * 2; \
        _Pragma("unroll") for (int i_ = 0; i_ < 2; ++i_) { \
            __builtin_amdgcn_global_load_lds((const unsigned*)(kb_ + soff[i_]), (LAS unsigned*)(lds + (buf) * KV_BUF + i_ * 8192 + ldsw), 16, 0, 0); \
            __builtin_amdgcn_global_load_lds((const unsigned*)(vb_ + soff[i_]), (LAS unsigned*)(lds + (buf) * KV_BUF + 16384 + i_ * 8192 + ldsw), 16, 0, 0); } } while (0)
    ATT_ISSUE(ktop, 0);
    if (!ISA) {
        LAS float* tbl = (LAS float*)(lds + TBL_OFF);
        for (int i = F.tid; i < 1280; i += NTHR) { const int hd = i / 640, idx = i % 640; int rel = idx - 64; rel = rel < -256 ? -256 : (rel > 256 ? 256 : rel); tbl[i] = relb[(2 * hx + hd) * 513 + rel + 256] * LOG2E; }
    }
    bf16x8 qf[4];
    { const u16* qp = QKV + (tok0 + q0 + rg * 32 + r32) * QKVP + qcol + 8 * hi;
#pragma unroll
      for (int s = 0; s < 4; ++s) qf[s] = *(const bf16x8*)(qp + 16 * s); }
    const unsigned fr_ = ((r32 & 3u) << 2) | ((r32 >> 2) & 3u);
    unsigned kad[4];
#pragma unroll
    for (int s = 0; s < 4; ++s) kad[s] = 256u * r32 + 16u * ((8u * sub + 2u * s + hi) ^ fr_);
    const unsigned qd = (lane & 15) >> 2, pd = lane & 3, blk = (lane >> 4) & 1, xlow = 2 * blk + (pd >> 1);
    unsigned vad[DVB][2];
#pragma unroll
    for (int c = 0; c < DVB; ++c)
#pragma unroll
        for (int t = 0; t < 2; ++t) { const unsigned ci = ISA ? (unsigned)c : (unsigned)(2 * sub + c);
            vad[c][t] = 2048u * t + 256u * (4u * hi + qd) + 64u * (ci ^ qd) + 16u * (xlow ^ ((2u * t + hi) & 3u)) + 8u * (pd & 1u); }
    const float sl2 = ISA ? exp2f(-2.0f * (float)(hx + 1)) * LOG2E : 0.f;
    LAS float* wsf = (LAS float*)(lds + WSF_OFF) + w * 64;
    float mrun = -INFINITY, lrun = 0.f;
    f32x16 o[DVB];
#pragma unroll
    for (int c = 0; c < DVB; ++c)
#pragma unroll
        for (int r = 0; r < 16; ++r) o[c][r] = 0.f;

    for (int i = 0; i < NTs; ++i) {
        const int kt = ktop - i, buf = i & 1;
        asm volatile("s_waitcnt vmcnt(0)" ::: "memory");
        __syncthreads();
        if (i + 1 < NTs) ATT_ISSUE(kt - 1, buf ^ 1);
        const bool active = ISA ? (kt <= cq) : (kt <= cq && kt >= cq - 8);
        if (active) {
            LAS const unsigned char* kbuf = lds + buf * KV_BUF; LAS const unsigned char* vbuf = kbuf + 16384;
            f32x16 p0, p1;
#pragma unroll
            for (int r = 0; r < 16; ++r) { p0[r] = 0.f; p1[r] = 0.f; }
#pragma unroll
            for (int s = 0; s < 4; ++s) {
                const bf16x8 k0 = *(const LAS bf16x8*)(kbuf + kad[s]);
                const bf16x8 k1 = *(const LAS bf16x8*)(kbuf + kad[s] + 8192);
                p0 = __builtin_amdgcn_mfma_f32_32x32x16_bf16(k0, qf[s], p0, 0, 0, 0);
                p1 = __builtin_amdgcn_mfma_f32_32x32x16_bf16(k1, qf[s], p1, 0, 0, 0);
            }
            if (ISA) {
                const float dl = (float)(kt * 64 + 4 * hi - qpos);
#pragma unroll
                for (int r = 0; r < 16; ++r) { const float kc = (float)((r & 3) + 8 * (r >> 2)); p0[r] = fmaf(-sl2, fabsf(dl + kc), p0[r]); p1[r] = fmaf(-sl2, fabsf(dl + kc + 32.0f), p1[r]); }
            } else {
                LAS const float* tb = (LAS const float*)(lds + TBL_OFF) + sub * 640 + (qpos + 64 - kt * 64 - 4 * hi - 63);
#pragma unroll
                for (int r = 0; r < 16; ++r) { const int kc = (r & 3) + 8 * (r >> 2); p0[r] += tb[63 - kc]; p1[r] += tb[63 - 32 - kc]; }
            }
            float mx = fmaxf(p0[0], p1[0]);
#pragma unroll
            for (int r = 1; r < 16; ++r) mx = fmaxf(mx, fmaxf(p0[r], p1[r]));
            const float mt = swapmax(mx);
            if (__any(mt > mrun + THR)) {
                const float mnew = fmaxf(mrun, mt), alpha = __builtin_amdgcn_exp2f(mrun - mnew);
                lrun *= alpha; mrun = mnew;
                if (hi == 0) wsf[r32] = alpha;
#pragma unroll
                for (int r = 0; r < 16; ++r) { const float a_ = wsf[crow(r, hi)];
#pragma unroll
                    for (int c = 0; c < DVB; ++c) o[c][r] *= a_; }
            }
            float ps = 0.f;
#pragma unroll
            for (int r = 0; r < 16; ++r) { p0[r] = __builtin_amdgcn_exp2f(p0[r] - mrun); p1[r] = __builtin_amdgcn_exp2f(p1[r] - mrun); ps += p0[r] + p1[r]; }
            lrun += ps;
            u32x4 pw[4];
#pragma unroll
            for (int q = 0; q < 4; ++q) { pw[0][q] = cvtpk(p0[2 * q], p0[2 * q + 1]); pw[1][q] = cvtpk(p0[8 + 2 * q], p0[8 + 2 * q + 1]); pw[2][q] = cvtpk(p1[2 * q], p1[2 * q + 1]); pw[3][q] = cvtpk(p1[8 + 2 * q], p1[8 + 2 * q + 1]); }
#pragma unroll
            for (int c = 0; c < DVB; ++c)
#pragma unroll
                for (int ks = 0; ks < 4; ++ks) {
                    const s16x4 lo = vtr(vbuf + vad[c][0] + 4096 * ks), h4 = vtr(vbuf + vad[c][1] + 4096 * ks);
                    const bf16x8 vf = (bf16x8){lo[0], lo[1], lo[2], lo[3], h4[0], h4[1], h4[2], h4[3]};
                    o[c] = __builtin_amdgcn_mfma_f32_32x32x16_bf16(__builtin_bit_cast(bf16x8, pw[ks]), vf, o[c], 0, 0, 0);
                }
        }
    }
    { const float lt = swapsum(lrun); const float inv = 1.0f / lt;
      if (hi == 0) wsf[r32] = inv;
#pragma unroll
      for (int r = 0; r < 16; ++r) { const float a_ = wsf[crow(r, hi)];
#pragma unroll
          for (int c = 0; c < DVB; ++c) o[c][r] *= a_; } }
    __syncthreads();
    if (ISA) {
        LAS float* X = (LAS float*)(lds + X_OFF) + rg * 4096;
        if (sub == 1) {
#pragma unroll
            for (int c = 0; c < 4; ++c)
#pragma unroll
                for (int r = 0; r < 16; ++r) X[(c * 16 + r) * 64 + lane] = o[c][r];
        }
        __syncthreads();
        if (sub == 0) {
            float ss[16];
#pragma unroll
            for (int r = 0; r < 16; ++r) ss[r] = 0.f;
#pragma unroll
            for (int c = 0; c < 4; ++c)
#pragma unroll
                for (int r = 0; r < 16; ++r) { const float y = o[c][r] - lam * X[(c * 16 + r) * 64 + lane]; o[c][r] = y; ss[r] += y * y; }
#pragma unroll
            for (int r = 0; r < 16; ++r) {
                float v = ss[r];
                v += __shfl_xor(v, 1); v += __shfl_xor(v, 2); v += __shfl_xor(v, 4); v += __shfl_xor(v, 8); v += __shfl_xor(v, 16);
                ss[r] = 0.8f / sqrtf(v * (1.0f / 128.0f) + 1e-5f);
            }
            float gg[4];
#pragma unroll
            for (int c = 0; c < 4; ++c) gg[c] = subg[32 * c + r32];
            LAS u16* stg = (LAS u16*)(lds + X_OFF + rg * 16384);
            asm volatile("s_waitcnt lgkmcnt(0)" ::: "memory");
#pragma unroll
            for (int c = 0; c < 4; ++c)
#pragma unroll
                for (int r = 0; r < 16; ++r) stg[crow(r, hi) * 128 + 32 * c + r32] = f2bf(o[c][r] * ss[r] * gg[c]);
            asm volatile("s_waitcnt lgkmcnt(0)" ::: "memory");
            u16* og = O + (tok0 + q0 + rg * 32) * DM + hx * 128;
#pragma unroll
            for (int i = 0; i < 8; ++i) { const int row = 4 * i + (lane >> 4), ch = lane & 15; const u32x4 v = *(const LAS u32x4*)((LAS const unsigned char*)stg + row * 256 + ch * 16); *(u32x4*)(og + (size_t)row * DM + ch * 8) = v; }
        }
    } else {
        LAS u16* stg = (LAS u16*)(lds + X_OFF + w * 4096);
#pragma unroll
        for (int c = 0; c < 2; ++c)
#pragma unroll
            for (int r = 0; r < 16; ++r) stg[crow(r, hi) * 64 + 32 * c + r32] = f2bf(o[c][r]);
        asm volatile("s_waitcnt lgkmcnt(0)" ::: "memory");
        u16* og = O + (tok0 + q0 + rg * 32) * DM + 512 + (2 * hx + sub) * 64;
#pragma unroll
        for (int i = 0; i < 4; ++i) { const int row = 8 * i + (lane >> 3), ch = lane & 7; const u32x4 v = *(const LAS u32x4*)((LAS const unsigned char*)stg + row * 128 + ch * 16); *(u32x4*)(og + (size_t)row * DM + ch * 8) = v; }
    }
    __syncthreads();
#undef ATT_ISSUE
}

__device__ __forceinline__ void p2_attention(const Frame& F, const Args& a) {
    const u16* QKV = (const u16*)(a.ws + WS_QKV); u16* O = (u16*)(a.ws + WS_O);
    float d1 = 0.f, d2 = 0.f;
    for (int i = 0; i < 64; ++i) { d1 += a.in[4][i] * a.in[5][i]; d2 += a.in[6][i] * a.in[7][i]; }
    const float lam = expf(d1) - expf(d2) + 0.2f;
    const int vcu = (F.G % 8 == 0) ? (F.bid % 8) * (F.G / 8) + F.bid / 8 : F.bid;
    for (int g = vcu; g < 256; g += F.G) {
        const int grp = g >> 3, s = g & 7, b = grp >> 2, hx = grp & 3;
        for (int i = 0; i < 4; ++i) { const int jq = i == 0 ? 31 - s : i == 1 ? 16 + s : i == 2 ? 15 - s : s; attn_unit<true>(F, QKV, O, b, hx, jq, lam, a.in[8], a.in[9]); }
        for (int i = 0; i < 4; ++i) { const int jq = i == 0 ? 31 - s : i == 1 ? 16 + s : i == 2 ? 15 - s : s; attn_unit<false>(F, QKV, O, b, hx, jq, lam, a.in[8], a.in[9]); }
    }
}
}
#ifndef REP_MASK
#define REP_MASK 0
#endif
__global__ void __launch_bounds__(NTHR, 2) mk_fwd(Args args) {
    extern __shared__ __attribute__((aligned(16))) unsigned char lds_raw[];
    Frame F;
    F.lds = (LAS unsigned char*)lds_raw; F.MISC = (volatile LAS unsigned*)(F.lds + MISC_OFF);
    F.tid = threadIdx.x; F.lane = F.tid & 63; F.wave = __builtin_amdgcn_readfirstlane(F.tid >> 6); F.G = gridDim.x; F.bid = blockIdx.x;
    F.ctl = (gu32*)(args.ws + WS_CTL);
    for (int u = F.tid; u < 256; u += NTHR) ((LAS unsigned*)(F.lds + MISC_OFF))[u] = 0u;
    __syncthreads();
    const int lo = args.ph_lo, hi = args.ph_hi;
    const bool multi = (hi - lo) > 1;
    XcdBarrier bar; bar.bar = (unsigned*)(F.ctl + CW_BAR) + args.li * XCD_BAR_WORDS; bar.x = 0; bar.st = nullptr;
    if (multi) bar = xcd_barrier_post((unsigned*)(F.ctl + CW_BAR) + args.li * XCD_BAR_WORDS, F.MISC + 8);
#define IN(k) (lo <= (k) && (k) < hi)
#define SEAM(k) do { if (IN(k) && IN((k) + 1)) xcd_barrier(bar); } while (0)
    unsigned char* ws = args.ws;
    if (IN(0)) { p0_prologue(F, args); if (REP_MASK & 1) p0_prologue(F, args); SEAM(0); }
    if (IN(1)) {
        PDense S; S.A = (const u16*)(ws + WS_H0); S.Bt = (const u16*)(ws + WS_WIN); S.out = (u16*)(ws + WS_QKV); S.H0 = nullptr; S.mode = 0; S.ord.init(NTOK, QKVP, F.G, F.bid);
        pg8::gemm_phase(F.lds + RING_OFF, S); if (REP_MASK & 2) pg8::gemm_phase(F.lds + RING_OFF, S); SEAM(1);
    }
    if (IN(2)) { att::p2_attention(F, args); if (REP_MASK & 4) att::p2_attention(F, args); SEAM(2); }
    if (IN(3)) {
        PDense S; S.A = (const u16*)(ws + WS_O); S.Bt = (const u16*)(ws + WS_WOUT); S.out = (u16*)(ws + WS_U); S.H0 = (const u16*)(ws + WS_H0); S.mode = 1; S.ord.init(NTOK, DM, F.G, F.bid);
        pg8::gemm_phase(F.lds + RING_OFF, S); if (REP_MASK & 8) pg8::gemm_phase(F.lds + RING_OFF, S); SEAM(3);
    }
    if (IN(4)) { p4_router(F, args); SEAM(4); }
    if (IN(5)) {
        const MoeTab T = moe_tab(F.lds); moe_tables(T, (const int*)(F.ctl + CW_CNT));
        PMoe<1> S; S.A = ws + WS_H1Q; S.Bt = ws + WS_W1; S.out = (void*)(ws + WS_ACT); S.list = (const int*)(ws + WS_LIST); S.gate = nullptr; S.bias = args.in[16]; S.T = T; S.c = F.bid; S.ntot = __builtin_amdgcn_readfirstlane(T.tb[NEXP]);
        S.prepare();
        pg8::gemm_phase(F.lds + RING_OFF, S); if (REP_MASK & 32) pg8::gemm_phase(F.lds + RING_OFF, S); SEAM(5);
    }
    if (IN(6)) {
        const MoeTab T = moe_tab(F.lds); moe_tables(T, (const int*)(F.ctl + CW_CNT));
        PMoe<0> S; S.A = ws + WS_ACT; S.Bt = ws + WS_W2; S.out = (void*)(ws + WS_YS); S.list = (const int*)(ws + WS_LIST); S.gate = (const float*)(ws + WS_GATE); S.bias = args.in[18]; S.T = T; S.c = F.bid; S.ntot = __builtin_amdgcn_readfirstlane(T.tb[NEXP]);
        S.prepare();
        pg8::gemm_phase(F.lds + RING_OFF, S); if (REP_MASK & 64) pg8::gemm_phase(F.lds + RING_OFF, S); SEAM(6);
    }
    if (IN(7)) { p7_final(F, args); if (REP_MASK & 128) p7_final(F, args); }
#undef IN
#undef SEAM
}

extern "C" void kernel_launch(void* const* d_in, const int* in_sizes, int n_in, void* d_out, int out_size, void* d_ws, size_t ws_size, hipStream_t stream) {
    static int grid = 0;
    if (grid == 0) {
        if (n_in != 21 || in_sizes[0] != NTOK * DM || out_size != NTOK * DM || ws_size < WS_END) { fprintf(stderr, "kernel_launch: unexpected shapes / workspace (%d inputs, ws %zu)\n", n_in, ws_size); grid = -1; return; }
        int dev = 0, cus = 0, per_cu = 0;
        if (hipGetDevice(&dev) != hipSuccess || hipDeviceGetAttribute(&cus, hipDeviceAttributeMultiprocessorCount, dev) != hipSuccess) { grid = -1; return; }
        if (hipFuncSetAttribute((const void*)mk_fwd, hipFuncAttributeMaxDynamicSharedMemorySize, LDS_BYTES) != hipSuccess) { fprintf(stderr, "kernel_launch: hipFuncSetAttribute failed\n"); grid = -1; return; }
        if (hipOccupancyMaxActiveBlocksPerMultiprocessor(&per_cu, (const void*)mk_fwd, NTHR, LDS_BYTES) != hipSuccess || per_cu < 1) { fprintf(stderr, "kernel_launch: occupancy query says %d blocks per CU\n", per_cu); (void)hipGetLastError(); grid = -1; return; }
        if (cus < 256) { fprintf(stderr, "kernel_launch: needs 256 CUs, device has %d\n", cus); grid = -1; return; }
        grid = 256;
    }
    if (grid < 0) return;
    const float* lq1 = (const float*)d_in[4]; const float* lk1 = (const float*)d_in[5]; const float* lq2 = (const float*)d_in[6]; const float* lk2 = (const float*)d_in[7];
    const float* subg = (const float*)d_in[8]; const float* relb = (const float*)d_in[9];
    char* ws = (char*)d_ws;
    u16* QKV = (u16*)(ws + WS_QKV); u16* O = (u16*)(ws + WS_O);
    (void)hipMemsetAsync(ws + WS_CTL, 0, CTL_BYTES, stream);
    Args a{};
    for (int i = 0; i < 21; ++i) a.in[i] = (const float*)d_in[i];
    a.out = (float*)d_out; a.ws = (unsigned char*)d_ws;
    int nl = 0;
    auto run = [&](int lo, int hi) { a.ph_lo = lo; a.ph_hi = hi; a.li = nl++; hipLaunchKernelGGL(mk_fwd, dim3(grid), dim3(NTHR), LDS_BYTES, stream, a); };
    run(0, 8);
}
```

```cpp
#define REP_MASK 0
#include <hip/hip_runtime.h>
#include <cstdint>
#include <cstdio>

typedef unsigned short u16;
typedef short bf16x8 __attribute__((ext_vector_type(8)));
typedef float f32x4 __attribute__((ext_vector_type(4)));
typedef unsigned u32x4 __attribute__((ext_vector_type(4)));
typedef unsigned u32x2 __attribute__((ext_vector_type(2)));
#define LAS __attribute__((address_space(3)))

constexpr int NTOK = 32768, DM = 1024, SEQ = 4096, NBATCH = 8;
constexpr int QKVP = 3072;
constexpr int NEXP = 32;
constexpr float LOG2E = 1.4426950408889634f;
constexpr float QSCALE = 0.125f * LOG2E;
constexpr float DN_ALPHA = 1.189207115002721f;
constexpr float LN_EPS = 1e-5f;

constexpr size_t MiB = 1u << 20;
constexpr size_t WS_CTL = 0, CTL_BYTES = 1 * MiB;
constexpr size_t WS_RWT = 1 * MiB;
constexpr size_t WS_H1Q = 80 * MiB;
constexpr size_t WS_WIN = 2 * MiB, WS_WOUT = 8 * MiB, WS_W1 = 16 * MiB, WS_W2 = 144 * MiB;
constexpr size_t WS_H1 = 208 * MiB, WS_LIST = 272 * MiB, WS_GATE = 276 * MiB;
constexpr size_t WS_H0 = 280 * MiB, WS_QKV = 344 * MiB, WS_O = 536 * MiB, WS_U = 344 * MiB, WS_ACT = 280 * MiB;
constexpr size_t WS_YS = 600 * MiB, WS_END = 856 * MiB;

__device__ __forceinline__ float bf2f(u16 v) { return __uint_as_float((unsigned)v << 16); }
__device__ __forceinline__ u16 f2bf(float f) { unsigned u = __float_as_uint(f); return (u16)((u + 0x7fffu + ((u >> 16) & 1u)) >> 16); }
__device__ __forceinline__ unsigned pk2(float lo, float hi) { return (unsigned)f2bf(lo) | ((unsigned)f2bf(hi) << 16); }
__device__ __forceinline__ float wave_sum(float v) {
#pragma unroll
    for (int o = 1; o < 64; o <<= 1) v += __shfl_xor(v, o);
    return v;
}


#define GAS __attribute__((address_space(1)))
typedef GAS unsigned gu32;
#define RLX_AGENT __ATOMIC_RELAXED, __HIP_MEMORY_SCOPE_AGENT
#define LDS_WAIT() asm volatile("s_waitcnt lgkmcnt(0)" ::: "memory")
#define VM_WAIT() asm volatile("s_waitcnt vmcnt(0)" ::: "memory")

constexpr int NWAVES = 8, NTHR = 512;
__device__ __forceinline__ int lane_id() { int l; asm volatile("v_mbcnt_lo_u32_b32 %0, -1, 0\n\tv_mbcnt_hi_u32_b32 %0, -1, %0" : "=v"(l)); return l; }
constexpr int RING_OFF = 0, RING_BYTES = 131072, TAB_OFF = 131072, TAB_BYTES = 24576, MISC_OFF = TAB_OFF + TAB_BYTES, LDS_BYTES = MISC_OFF + 1024;
constexpr int CW_CNT = 0;
constexpr int CW_BAR = 4096;

#define XB_TMO      128
#define XB_XCNT(j)  (256  + 64 * (j))
#define XB_XSUB(j)  (1280 + 64 * (j))
#define XB_XGEN(j)  (2304 + 64 * (j))
#define XB_TOP      3328
#define XB_TOPGEN   3392
#define XCD_BAR_WORDS 3456
#define XB_SPIN_CAP (1u << 20)
__device__ __forceinline__ unsigned xb_ld(unsigned* p)              { return __hip_atomic_load(p, __ATOMIC_RELAXED, __HIP_MEMORY_SCOPE_AGENT); }
__device__ __forceinline__ unsigned xb_add(unsigned* p, unsigned v) { return __hip_atomic_fetch_add(p, v, __ATOMIC_RELAXED, __HIP_MEMORY_SCOPE_AGENT); }
__device__ __forceinline__ unsigned xb_xcc_id() { return (unsigned)__builtin_amdgcn_s_getreg((3 << 11) | 20) & 0xFu; }
#define XB_SPIN(cond, bar) do { unsigned _sp = 0; while (cond) { __builtin_amdgcn_s_sleep(1); \
    if ((++_sp & 255u) == 0u) { if (xb_ld(&(bar)[XB_TMO])) break; if (_sp > XB_SPIN_CAP) { atomicAdd(&(bar)[XB_TMO], 1u); break; } } } } while (0)
struct XcdBarrier { unsigned* bar; unsigned x; volatile LAS unsigned* st; int wave; };
__device__ __forceinline__ XcdBarrier xcd_barrier_post(unsigned* bar, volatile LAS unsigned* st, int wave) {
    XcdBarrier b; b.bar = bar; b.x = xb_xcc_id(); b.st = st; b.wave = wave;
    if (wave == 0 && lane_id() == 0) (void)xb_add(&bar[XB_XCNT(b.x)], 1u);
    return b;
}
__device__ __forceinline__ void xcd_barrier_complete(unsigned* bar, unsigned x, unsigned& nloc, unsigned& nx) {
    const unsigned G = gridDim.x * gridDim.y * gridDim.z;
    unsigned sum, cnt, mine, sp = 0u;
    for (;;) {
        sum = 0u; cnt = 0u; mine = 0u;
#pragma unroll
        for (unsigned j = 0; j < 16; ++j) { const unsigned c = xb_ld(&bar[XB_XCNT(j)]); sum += c; cnt += (c > 0u) ? 1u : 0u; mine = (j == x) ? c : mine; }
        if (sum == G) break;
        __builtin_amdgcn_s_sleep(1);
        if ((++sp & 255u) == 0u) { if (xb_ld(&bar[XB_TMO])) break; if (sp > XB_SPIN_CAP) { atomicAdd(&bar[XB_TMO], 1u); break; } }
    }
    nloc = mine > 0u ? mine : 1u; nx = cnt > 0u ? cnt : 1u;
}
__device__ __forceinline__ void xcd_barrier(const XcdBarrier& b) {
    asm volatile("s_waitcnt vmcnt(0)" ::: "memory");
    __syncthreads();
    if (b.wave == 0 && lane_id() == 0) {
        unsigned* bar = b.bar;
        __builtin_amdgcn_s_waitcnt(0);
        unsigned nloc = b.st[0], nx = b.st[1];
        if (nloc == 0u) { xcd_barrier_complete(bar, b.x, nloc, nx); b.st[0] = nloc; b.st[1] = nx; }
        const unsigned old = xb_add(&bar[XB_XSUB(b.x)], 1u);
        const unsigned gen = old / nloc;
        if (old + 1u == (gen + 1u) * nloc) {
            __builtin_amdgcn_fence(__ATOMIC_RELEASE, "agent");
            asm volatile("s_waitcnt vmcnt(0)" ::: "memory");
            const unsigned og = xb_add(&bar[XB_TOP], 1u);
            const unsigned tg = og / nx;
            if (og + 1u == (tg + 1u) * nx) xb_add(&bar[XB_TOPGEN], 1u);
            else XB_SPIN(xb_ld(&bar[XB_TOPGEN]) == tg, bar);
            __builtin_amdgcn_fence(__ATOMIC_ACQUIRE, "agent");
            xb_add(&bar[XB_XGEN(b.x)], 1u);
            asm volatile("s_waitcnt vmcnt(0)" ::: "memory");
        } else {
            XB_SPIN(xb_ld(&bar[XB_XGEN(b.x)]) == gen, bar);
            __builtin_amdgcn_fence(__ATOMIC_ACQUIRE, "agent");
            asm volatile("s_waitcnt vmcnt(0)" ::: "memory");
        }
    }
    __syncthreads();
}

namespace pg8 {
constexpr int BM = 256, BK = 64, HALF = 128, HTB = HALF * BK * 2, NXCD = 8, WGM = 8, KD = 1024, NT = KD / BK;
__host__ __device__ __forceinline__ int lds_byte(int r, int c) { const int st = (r >> 4) * 2 + (c >> 5), rr = r & 15, cc = c & 31, ob = rr * 64 + cc * 2; return st * 1024 + (ob ^ (((ob >> 9) & 1) << 5)); }
__host__ __device__ __forceinline__ void stage_rc(int b, int& R, int& C) { const int st = b / 1024, sb = b % 1024, swz = sb ^ (((sb >> 9) & 1) << 5); R = (st >> 1) * 16 + swz / 64; C = (st & 1) * 32 + (swz % 64) / 2; }
__host__ __device__ __forceinline__ int perm32(int rho) { const int n = rho >> 4, i = rho & 15; return 8 * (i >> 2) + 4 * n + (i & 3); }
__device__ __forceinline__ unsigned cvt_pk_bf16(float lo, float hi) { unsigned r; asm volatile("v_cvt_pk_bf16_f32 %0, %1, %2" : "=v"(r) : "v"(lo), "v"(hi)); return r; }

typedef int v8i32 __attribute__((ext_vector_type(8)));
struct Unit { int pm, pn, e, idx; };

struct StaticOrder {
    int nM, nN, nwg, G, c;
    __device__ void init(int M, int N, int G_, int c_) { nM = M / BM; nN = N / BM; nwg = nM * nN; G = G_; c = c_; }
    __device__ bool next(int i, Unit& u) const {
        const long L = (long)i * G + c; if (L >= nwg) return false;
        int wgid = (int)L; { const int q = nwg / NXCD, r = nwg % NXCD, xcd = wgid % NXCD, off = wgid / NXCD; wgid = (xcd < r ? xcd * (q + 1) : r * (q + 1) + (xcd - r) * q) + off; }
        const int nig = WGM * nN, gid = wgid / nig, fm = gid * WGM, gsz = (nM - fm) < WGM ? (nM - fm) : WGM;
        u.pm = fm + ((wgid % nig) % gsz); u.pn = (wgid % nig) / gsz; u.e = 0; u.idx = i; return true;
    }
};

template <class P>
__device__ __forceinline__ void gemm_phase(LAS unsigned char* lds, const P& S, int wave) {
    const int wid = wave, lane = lane_id(), tid = wid * 64 + lane, wr = wid >> 2, wc = wid & 3, fr = lane & 15, fq = lane >> 4;
    constexpr int KB = P::FP8 ? 1024 : 2048, nt = KB / 128;
    int Rr[2], Cc[2]; unsigned voffB[2];
#pragma unroll
    for (int i = 0; i < 2; ++i) { int R, C; stage_rc(tid * 16 + i * 8192, R, C); const int Rb = 64 * (R >> 5) + perm32(R & 31); Rr[i] = R; Cc[i] = C; voffB[i] = (unsigned)(Rb * KB + C * 2); }
    constexpr unsigned kstep = (unsigned)(BK * 2);
    constexpr unsigned hstep = 32u * KB;
    const __amdgpu_buffer_rsrc_t rA = __builtin_amdgcn_make_buffer_rsrc((void*)S.a_ptr(), 0, 0x7fffffff, 0x00020000), rB = __builtin_amdgcn_make_buffer_rsrc((void*)S.b_ptr(), 0, 0x7fffffff, 0x00020000);
    const unsigned ldsw = (unsigned)wid * 1024u;
    const int aoff = lds_byte(wr * 64 + fr, fq * 8), boff = lds_byte(wc * 32 + fr, fq * 8);
#define PG8_SA(b, h) (((b) * 2 + (h)) * HTB)
#define PG8_SB(b, h) ((4 + (b) * 2 + (h)) * HTB)
#define PG8_STAGE(bufoff, rs, sbase, voff) do { _Pragma("unroll") for (int _i = 0; _i < 2; ++_i) \
        __builtin_amdgcn_raw_ptr_buffer_load_lds(rs, (LAS unsigned*)(lds + (bufoff) + ldsw + _i * 8192), 16, (int)(voff)[_i], (int)(sbase), 0, 0); } while (0)
#define PG8_STAGE_A(bufoff, sbase, un, h) do { _Pragma("unroll") for (int _i = 0; _i < 2; ++_i) \
        __builtin_amdgcn_raw_ptr_buffer_load_lds(rA, (LAS unsigned*)(lds + (bufoff) + ldsw + _i * 8192), 16, (int)S.a_off1(un, h, Rr[_i], Cc[_i]), (int)(sbase), 0, 0); } while (0)
#define PG8_LDA(dst, b, h) do { _Pragma("unroll") for (int m = 0; m < 4; ++m) _Pragma("unroll") for (int k = 0; k < 2; ++k) dst[m][k] = *(const LAS bf16x8*)(lds + PG8_SA(b, h) + aoff + m * 2048 + k * 1024); } while (0)
#define PG8_LDB(dst, b, h) do { _Pragma("unroll") for (int n = 0; n < 2; ++n) _Pragma("unroll") for (int k = 0; k < 2; ++k) dst[n][k] = *(const LAS bf16x8*)(lds + PG8_SB(b, h) + boff + n * 2048 + k * 1024); } while (0)
#define PG8_CAT(x) __builtin_bit_cast(v8i32, __builtin_shufflevector((x)[0], (x)[1], 0, 1, 2, 3, 4, 5, 6, 7, 8, 9, 10, 11, 12, 13, 14, 15))
#define PG8_MMA(ai, bj, At, Bt) do { __builtin_amdgcn_sched_barrier(0); __builtin_amdgcn_s_setprio(1); \
        if constexpr (P::FP8) { _Pragma("unroll") for (int m = 0; m < 4; ++m) _Pragma("unroll") for (int n = 0; n < 2; ++n) \
            acc[ai][bj][m][n] = __builtin_amdgcn_mfma_scale_f32_16x16x128_f8f6f4(PG8_CAT(Bt[n]), PG8_CAT(At[m]), acc[ai][bj][m][n], 0, 0, 0, P::SCALE_B, 0, P::SCALE_A); } \
        else { _Pragma("unroll") for (int m = 0; m < 4; ++m) _Pragma("unroll") for (int n = 0; n < 2; ++n) _Pragma("unroll") for (int k = 0; k < 2; ++k) \
            acc[ai][bj][m][n] = __builtin_amdgcn_mfma_f32_16x16x32_bf16(Bt[n][k], At[m][k], acc[ai][bj][m][n], 0, 0, 0); } \
        __builtin_amdgcn_s_setprio(0); __builtin_amdgcn_sched_barrier(0); } while (0)
#define PG8_WAIT_V(n) asm volatile("s_waitcnt vmcnt(" #n ")" ::: "memory")
#define PG8_WAIT_L(n) asm volatile("s_waitcnt lgkmcnt(" #n ")" ::: "memory")
#define PG8_BAR __builtin_amdgcn_s_barrier()
#define PG8_SCHED __builtin_amdgcn_sched_barrier(0)
    Unit cur, nxt; int ui = 0;
    if (!S.next(0, cur)) return;
    f32x4 acc[2][2][4][2];
#pragma unroll
    for (int a = 0; a < 2; ++a)
#pragma unroll
        for (int b = 0; b < 2; ++b)
#pragma unroll
            for (int m = 0; m < 4; ++m)
#pragma unroll
                for (int n = 0; n < 2; ++n) acc[a][b][m][n] = (f32x4){0.f, 0.f, 0.f, 0.f};
    bf16x8 At[4][2], B0[2][2], B1[2][2];
    unsigned cA = S.a_base(cur), cB = S.b_base(cur);
    PG8_STAGE(PG8_SB(0, 0), rB, cB, voffB); PG8_STAGE(PG8_SB(0, 1), rB, cB + hstep, voffB); PG8_STAGE_A(PG8_SA(0, 0), cA, cur, 0); PG8_STAGE_A(PG8_SA(0, 1), cA, cur, 1);
    if (wr == 1) PG8_BAR;
    PG8_WAIT_V(2); PG8_BAR;
    PG8_STAGE(PG8_SB(1, 0), rB, cB + kstep, voffB); PG8_STAGE_A(PG8_SA(1, 0), cA + kstep, cur, 0); PG8_STAGE(PG8_SB(1, 1), rB, cB + hstep + kstep, voffB);
    PG8_WAIT_V(6); PG8_BAR;
    for (;;) {
        const bool has_next = S.next(ui + 1, nxt);
        const unsigned nA = has_next ? S.a_base(nxt) : cA, nB = has_next ? S.b_base(nxt) : cB;
#pragma unroll 1
        for (int t = 0; t < nt; t += 2) {
            const bool last = (t == nt - 2);
            const unsigned a1 = cA + (unsigned)(t + 1) * kstep;
            const unsigned a2 = last ? nA : cA + (unsigned)(t + 2) * kstep, b2 = last ? nB : cB + (unsigned)(t + 2) * kstep;
            const unsigned a3 = a2 + kstep, b3 = b2 + kstep;
            Unit un2; { const bool nx_ = last && has_next; un2.pm = nx_ ? nxt.pm : cur.pm; un2.pn = nx_ ? nxt.pn : cur.pn; un2.e = nx_ ? nxt.e : cur.e; un2.idx = nx_ ? nxt.idx : cur.idx; }
            PG8_LDB(B0, 0, 0); PG8_LDB(B1, 0, 1); PG8_SCHED; PG8_LDA(At, 0, 0); PG8_STAGE_A(PG8_SA(1, 1), a1, cur, 1);
            PG8_WAIT_V(8); PG8_WAIT_L(0); PG8_BAR; PG8_MMA(0, 0, At, B0); PG8_MMA(0, 1, At, B1); PG8_BAR; PG8_SCHED;
            PG8_LDA(At, 0, 1); PG8_STAGE(PG8_SB(0, 0), rB, b2, voffB); PG8_STAGE(PG8_SB(0, 1), rB, b2 + hstep, voffB); PG8_STAGE_A(PG8_SA(0, 0), a2, un2, 0);
            PG8_WAIT_V(8); PG8_WAIT_L(0); PG8_BAR; PG8_MMA(1, 0, At, B0); PG8_MMA(1, 1, At, B1); PG8_BAR; PG8_SCHED;
            PG8_LDB(B0, 1, 0); PG8_LDB(B1, 1, 1); PG8_SCHED; PG8_LDA(At, 1, 0); PG8_STAGE_A(PG8_SA(0, 1), a2, un2, 1);
            PG8_WAIT_V(8); PG8_WAIT_L(0); PG8_BAR; PG8_MMA(0, 0, At, B0); PG8_MMA(0, 1, At, B1); PG8_BAR; PG8_SCHED;
            PG8_LDA(At, 1, 1); PG8_STAGE(PG8_SB(1, 0), rB, b3, voffB); PG8_STAGE(PG8_SB(1, 1), rB, b3 + hstep, voffB); PG8_STAGE_A(PG8_SA(1, 0), a3, un2, 0);
            PG8_WAIT_V(8); PG8_WAIT_L(0); PG8_BAR; PG8_MMA(1, 0, At, B0); PG8_MMA(1, 1, At, B1); PG8_BAR; PG8_SCHED;
        }
        if (wr == 0) PG8_BAR;
        { const int le_ = lane_id(); S.epi(acc, cur, wr, wc, le_ & 15, le_ >> 4); }
        if (!has_next) break;
#pragma unroll
        for (int a = 0; a < 2; ++a)
#pragma unroll
            for (int b = 0; b < 2; ++b)
#pragma unroll
                for (int m = 0; m < 4; ++m)
#pragma unroll
                    for (int n = 0; n < 2; ++n) acc[a][b][m][n] = (f32x4){0.f, 0.f, 0.f, 0.f};
        cur = nxt; cA = nA; cB = nB; ++ui;
        if (wr == 1) PG8_BAR;
    }
    PG8_WAIT_V(0);
    PG8_BAR;
#undef PG8_SA
#undef PG8_SB
#undef PG8_STAGE
#undef PG8_STAGE_A
#undef PG8_LDA
#undef PG8_LDB
#undef PG8_MMA
#undef PG8_CAT
#undef PG8_WAIT_V
#undef PG8_WAIT_L
#undef PG8_BAR
#undef PG8_SCHED
}
}

__device__ __forceinline__ u32x4 ror8(u32x4 v) { u32x4 r;
#pragma unroll
    for (int q = 0; q < 4; ++q) r[q] = (unsigned)__builtin_amdgcn_update_dpp(0, (int)v[q], 0x128, 0xf, 0xf, true);
    return r; }
struct PDense {
    static constexpr bool PERM = true, FP8 = false; static constexpr int SCALE_A = 0, SCALE_B = 0;
    const u16* A; const u16* Bt; u16* out; const u16* H0; int mode; pg8::StaticOrder ord;
    __device__ __forceinline__ bool next(int i, pg8::Unit& u) const { return ord.next(i, u); }
    __device__ __forceinline__ const void* a_ptr() const { return A; }
    __device__ __forceinline__ const void* b_ptr() const { return Bt; }
    __device__ __forceinline__ unsigned a_base(const pg8::Unit& u) const { return (unsigned)u.pm * 256u * 2048u; }
    __device__ __forceinline__ unsigned b_base(const pg8::Unit& u) const { return (unsigned)u.pn * 256u * 2048u; }
    __device__ __forceinline__ unsigned a_off1(const pg8::Unit&, int h, int R, int C) const { return (unsigned)((h * 128 + R) * 1024 + C) * 2u; }
    __device__ __forceinline__ void epi(const f32x4 (&acc)[2][2][4][2], const pg8::Unit& u, int wr, int wc, int fr, int fq) const {
        const int ldc = mode == 0 ? QKVP : DM;
        const float sc = (mode == 0 && (u.pn < 2 || u.pn == 6 || u.pn == 7)) ? QSCALE : 1.0f;
        const int hh = fr >> 3, frl = fr & 7;
        const int rowb = u.pm * 256 + wr * 64, colo = u.pn * 256 + wc * 64 + 8 * fq;
#pragma unroll
        for (int ai = 0; ai < 2; ++ai)
#pragma unroll
            for (int m = 0; m < 4; ++m) {
                u32x4 W[2];
#pragma unroll
                for (int bj = 0; bj < 2; ++bj) {
                    f32x4 v0 = acc[ai][bj][m][0] * sc, v1 = acc[ai][bj][m][1] * sc;
                    if (mode == 1) {
                        const u32x4 h = *(const u32x4*)(H0 + (size_t)(rowb + ai * 128 + m * 16 + fr) * DM + colo + 32 * bj);
                        v0[0] += DN_ALPHA * __uint_as_float(h.x << 16); v0[1] += DN_ALPHA * __uint_as_float(h.x & 0xffff0000u); v0[2] += DN_ALPHA * __uint_as_float(h.y << 16); v0[3] += DN_ALPHA * __uint_as_float(h.y & 0xffff0000u);
                        v1[0] += DN_ALPHA * __uint_as_float(h.z << 16); v1[1] += DN_ALPHA * __uint_as_float(h.z & 0xffff0000u); v1[2] += DN_ALPHA * __uint_as_float(h.w << 16); v1[3] += DN_ALPHA * __uint_as_float(h.w & 0xffff0000u);
                    }
                    W[bj].x = pg8::cvt_pk_bf16(v0[0], v0[1]); W[bj].y = pg8::cvt_pk_bf16(v0[2], v0[3]); W[bj].z = pg8::cvt_pk_bf16(v1[0], v1[1]); W[bj].w = pg8::cvt_pk_bf16(v1[2], v1[3]);
                }
                const u32x4 rcv = ror8(hh ? W[0] : W[1]);
                const u32x4 s1 = hh ? rcv : W[0], s2 = hh ? W[1] : rcv;
                u16* p1 = out + (size_t)(rowb + ai * 128 + m * 16 + frl) * ldc + colo + 32 * hh;
                *(u32x4*)p1 = s1; *(u32x4*)(p1 + (size_t)8 * ldc) = s2;
            }
    }
};

struct MoeTab { LAS int* tb; LAS int* cn; LAS int* rowoff; };
__device__ __forceinline__ MoeTab moe_tab(LAS unsigned char* lds) { MoeTab t; t.rowoff = (LAS int*)(lds + TAB_OFF); t.tb = (LAS int*)(lds + TAB_OFF + 20480); t.cn = t.tb + 40; return t; }
__device__ __forceinline__ void moe_tables(const MoeTab& T, const int* cnt, int wave) {
    if (wave == 0 && lane_id() == 0) { int s = 0; for (int e = 0; e < NEXP; ++e) { const int c = __hip_atomic_load(cnt + e, RLX_AGENT); T.cn[e] = c; T.tb[e] = s; s += (c + 255) >> 8; } T.tb[NEXP] = s; }
    __syncthreads();
}
__device__ __forceinline__ int moe_find_e(const MoeTab& T, int RT) { int e = 0; while (e < NEXP - 1 && RT >= T.tb[e + 1]) ++e; return e; }

template <int UP>
struct PMoe {
    static constexpr bool PERM = true, FP8 = true; static constexpr int SCALE_A = UP ? 0x7c7c7c7c : 0x7d7d7d7d, SCALE_B = UP ? 0x75757575 : 0x74747474;
    static constexpr int NPN = UP ? 8 : 4, RPG = UP ? 4 : 8;
    const unsigned char* A; const unsigned char* Bt; void* out; const int* list; const float* gate; const float* bias; MoeTab T; int c, ntot;
    __device__ __forceinline__ bool next(int i, pg8::Unit& u) const {
        const int x = c & 7, s = c >> 3; const int RT = (i * 8 + x) * RPG + (s % RPG);
        if (RT >= ntot) return false;
        u.pm = RT; u.pn = s / RPG; u.e = moe_find_e(T, RT); u.idx = i; return true;
    }
    __device__ __forceinline__ const void* a_ptr() const { return A; }
    __device__ __forceinline__ const void* b_ptr() const { return Bt; }
    __device__ __forceinline__ unsigned a_base(const pg8::Unit& u) const { return UP ? 0u : (unsigned)u.pm * 256u * 1024u; }
    __device__ __forceinline__ unsigned b_base(const pg8::Unit& u) const { return ((unsigned)u.e * (UP ? 2048u : 1024u) + (unsigned)u.pn * 256u) * 1024u; }
    __device__ __forceinline__ unsigned a_off1(const pg8::Unit& u, int h, int R, int C) const { return UP ? (unsigned)T.rowoff[u.idx * 256 + h * 128 + R] + (unsigned)C * 2u : (unsigned)((h * 128 + R) * 1024 + C * 2); }
    __device__ __forceinline__ void prepare(int wave) const {
        const int tidx = wave * 64 + lane_id();
        pg8::Unit u;
        if (UP) {
            for (int i = 0; next(i, u); ++i) {
                if (tidx < 256) { const int r = (u.pm - T.tb[u.e]) * 256 + tidx; const int ent = list[(size_t)u.e * NTOK + (r < T.cn[u.e] ? r : 0)]; T.rowoff[i * 256 + tidx] = (ent >> 2) * 1024; }
            }
        } else {
            for (int i = 0; next(i, u); ++i) {
                if (tidx < 256) { const int r = (u.pm - T.tb[u.e]) * 256 + tidx; int ent = -1; float g = 0.f;
                    if (r < T.cn[u.e]) { ent = list[(size_t)u.e * NTOK + r]; g = gate[ent]; }
                    T.rowoff[i * 512 + tidx] = ent; ((LAS float*)T.rowoff)[i * 512 + 256 + tidx] = g; }
            }
        }
        __syncthreads();
    }
    __device__ __forceinline__ void epi(const f32x4 (&acc)[2][2][4][2], const pg8::Unit& u, int wr, int wc, int fr, int fq) const {
        const int colo = u.pn * 256 + wc * 64 + 8 * fq;
        if (UP) {
            const float* bp = bias + (size_t)u.e * 2048 + colo;
            f32x4 bv[2][2];
#pragma unroll
            for (int bj = 0; bj < 2; ++bj) { bv[bj][0] = *(const f32x4*)(bp + bj * 32); bv[bj][1] = *(const f32x4*)(bp + bj * 32 + 4); }
#pragma unroll
            for (int ai = 0; ai < 2; ++ai)
#pragma unroll
                for (int m = 0; m < 4; ++m) {
                    unsigned char* rowp = (unsigned char*)out + (size_t)(u.pm * 256 + wr * 64 + fr + ai * 128 + m * 16) * 1024 + (colo >> 1);
#pragma unroll
                    for (int bj = 0; bj < 2; ++bj) {
                        const f32x4 v0 = acc[ai][bj][m][0] + bv[bj][0], v1 = acc[ai][bj][m][1] + bv[bj][1];
                        float a[4];
#pragma unroll
                        for (int p = 0; p < 4; ++p) {
                            const float glu = p < 2 ? v0[2 * p] : v1[2 * p - 4], lin = p < 2 ? v0[2 * p + 1] : v1[2 * p - 3];
                            const float xg = fminf(glu, 7.0f), xl = fminf(fmaxf(lin, -7.0f), 7.0f);
                            a[p] = xg * __builtin_amdgcn_rcpf(1.0f + __builtin_amdgcn_exp2f(-1.702f * LOG2E * xg)) * (xl + 1.0f);
                        }
                        int w = __builtin_amdgcn_cvt_pk_fp8_f32(a[0] * 4.0f, a[1] * 4.0f, 0, false); w = __builtin_amdgcn_cvt_pk_fp8_f32(a[2] * 4.0f, a[3] * 4.0f, w, true);
                        *(int*)(rowp + bj * 16) = w;
                    }
                }
        } else {
            const float* bp = bias + (size_t)u.e * 1024 + colo;
            f32x4 bv[2][2];
#pragma unroll
            for (int bj = 0; bj < 2; ++bj) { bv[bj][0] = *(const f32x4*)(bp + bj * 32); bv[bj][1] = *(const f32x4*)(bp + bj * 32 + 4); }
            const int hh = fr >> 3, frl = fr & 7;
#pragma unroll
            for (int ai = 0; ai < 2; ++ai)
#pragma unroll
                for (int m = 0; m < 4; ++m) {
                    const int rlb = wr * 64 + ai * 128 + m * 16;
                    const float gt = ((LAS const float*)T.rowoff)[u.idx * 512 + 256 + rlb + fr];
                    const int e1 = T.rowoff[u.idx * 512 + rlb + frl], e2 = T.rowoff[u.idx * 512 + rlb + frl + 8];
                    u32x4 W[2];
#pragma unroll
                    for (int bj = 0; bj < 2; ++bj) {
                        const f32x4 v0 = (acc[ai][bj][m][0] + bv[bj][0]) * gt, v1 = (acc[ai][bj][m][1] + bv[bj][1]) * gt;
                        W[bj].x = pg8::cvt_pk_bf16(v0[0], v0[1]); W[bj].y = pg8::cvt_pk_bf16(v0[2], v0[3]); W[bj].z = pg8::cvt_pk_bf16(v1[0], v1[1]); W[bj].w = pg8::cvt_pk_bf16(v1[2], v1[3]);
                    }
                    const u32x4 rcv = ror8(hh ? W[0] : W[1]);
                    const u32x4 s1 = hh ? rcv : W[0], s2 = hh ? W[1] : rcv;
                    if (e1 >= 0) *(u32x4*)((u16*)out + (size_t)e1 * 1024 + colo + 32 * hh) = s1;
                    if (e2 >= 0) *(u32x4*)((u16*)out + (size_t)e2 * 1024 + colo + 32 * hh) = s2;
                }
        }
    }
};

struct Frame {
    LAS unsigned char* lds; volatile LAS unsigned* MISC; gu32* ctl; int wave, G, bid;
    __device__ __forceinline__ int tid() const { return wave * 64 + lane_id(); }
};
__device__ __forceinline__ void p0_transpose_item(const float* W, int K, int N, u16* WT, LAS float* scr, int item, int lane) {
    const int nblk = N / 32, kb = item / nblk, nb = item % nblk, k0 = 64 * kb, n0 = 32 * nb;
    f32x4 v[8];
#pragma unroll
    for (int it = 0; it < 8; ++it) v[it] = *(const f32x4*)(W + (size_t)(k0 + (lane >> 3) + 8 * it) * N + n0 + (lane & 7) * 4);
#pragma unroll
    for (int it = 0; it < 8; ++it) { const int k = (lane >> 3) + 8 * it, n4 = (lane & 7) * 4; scr[(n4 + 0) * 68 + k] = v[it].x; scr[(n4 + 1) * 68 + k] = v[it].y; scr[(n4 + 2) * 68 + k] = v[it].z; scr[(n4 + 3) * 68 + k] = v[it].w; }
    LDS_WAIT(); asm volatile("" ::: "memory");
#pragma unroll
    for (int it = 0; it < 4; ++it) {
        const int n = (lane >> 3) + 8 * it, c = lane & 7; const LAS float* s = scr + n * 68 + 8 * c;
        const f32x4 a = *(const LAS f32x4*)s, b = *(const LAS f32x4*)(s + 4);
        u32x4 o; o.x = pk2(a.x, a.y); o.y = pk2(a.z, a.w); o.z = pk2(b.x, b.y); o.w = pk2(b.z, b.w);
        *(u32x4*)(WT + (size_t)(n0 + n) * K + k0 + 8 * c) = o;
    }
    LDS_WAIT(); asm volatile("" ::: "memory");
}
__device__ __forceinline__ void p0_transpose_item_fp8(const float* W, int K, int N, unsigned char* WT, LAS float* scr, int item, int lane, float scale) {
    const int nblk = N / 32, kb = item / nblk, nb = item % nblk, k0 = 64 * kb, n0 = 32 * nb;
    f32x4 v[8];
#pragma unroll
    for (int it = 0; it < 8; ++it) v[it] = *(const f32x4*)(W + (size_t)(k0 + (lane >> 3) + 8 * it) * N + n0 + (lane & 7) * 4);
#pragma unroll
    for (int it = 0; it < 8; ++it) { const int k = (lane >> 3) + 8 * it, n4 = (lane & 7) * 4; scr[(n4 + 0) * 68 + k] = v[it].x; scr[(n4 + 1) * 68 + k] = v[it].y; scr[(n4 + 2) * 68 + k] = v[it].z; scr[(n4 + 3) * 68 + k] = v[it].w; }
    LDS_WAIT(); asm volatile("" ::: "memory");
#pragma unroll
    for (int it = 0; it < 2; ++it) {
        const int n = (lane >> 2) + 16 * it, c = lane & 3; const LAS float* s = scr + n * 68 + 16 * c;
        u32x4 o;
#pragma unroll
        for (int q = 0; q < 4; ++q) { f32x4 a = *(const LAS f32x4*)(s + 4 * q) * scale;
            a.x = fminf(fmaxf(a.x, -448.f), 448.f); a.y = fminf(fmaxf(a.y, -448.f), 448.f); a.z = fminf(fmaxf(a.z, -448.f), 448.f); a.w = fminf(fmaxf(a.w, -448.f), 448.f);
            int w = __builtin_amdgcn_cvt_pk_fp8_f32(a.x, a.y, 0, false); w = __builtin_amdgcn_cvt_pk_fp8_f32(a.z, a.w, w, true); o[q] = (unsigned)w; }
        *(u32x4*)(WT + (size_t)(n0 + n) * K + k0 + 16 * c) = o;
    }
    LDS_WAIT(); asm volatile("" ::: "memory");
}
__device__ __forceinline__ void ln_row_in(const float* xrow, const float* g, const float* b, u16* orow, int lane) {
    const f32x4* xr = (const f32x4*)xrow + lane;
    f32x4 v[4]; float s = 0.f;
#pragma unroll
    for (int j = 0; j < 4; ++j) { v[j] = xr[64 * j]; s += (v[j].x + v[j].y) + (v[j].z + v[j].w); }
    const float mean = wave_sum(s) * (1.f / DM); float s2 = 0.f;
#pragma unroll
    for (int j = 0; j < 4; ++j) { v[j] = v[j] - mean; s2 += (v[j].x * v[j].x + v[j].y * v[j].y) + (v[j].z * v[j].z + v[j].w * v[j].w); }
    const float rstd = 1.f / sqrtf(wave_sum(s2) * (1.f / DM) + LN_EPS);
    u32x2* o8 = (u32x2*)orow + lane;
#pragma unroll
    for (int j = 0; j < 4; ++j) {
        const f32x4 gg = ((const f32x4*)g)[lane + 64 * j], bb = ((const f32x4*)b)[lane + 64 * j];
        u32x2 w; w.x = pk2(v[j].x * rstd * gg.x + bb.x, v[j].y * rstd * gg.y + bb.y); w.y = pk2(v[j].z * rstd * gg.z + bb.z, v[j].w * rstd * gg.w + bb.w);
        o8[64 * j] = w;
    }
}

struct Args { const float* in[21]; float* out; unsigned char* ws; int ph_lo, ph_hi, li, pad; };

__device__ __forceinline__ void p0_prologue(const Frame& F, const Args& a) {
    unsigned char* ws = a.ws;
    u16* WIN = (u16*)(ws + WS_WIN); u16* WOUT = (u16*)(ws + WS_WOUT); unsigned char* W1T = ws + WS_W1; unsigned char* W2T = ws + WS_W2; u16* H0 = (u16*)(ws + WS_H0);
    LAS float* scr = (LAS float*)(F.lds + RING_OFF + F.wave * 8704);
    const int gw = F.bid * NWAVES + F.wave, NGW = F.G * NWAVES;
    constexpr int I_IN = 16 * 96, I_OUT = 16 * 32, I_W1 = 16 * 64, I_W2 = 16 * 32;
    constexpr int NITEMS = I_IN + I_OUT + NEXP * I_W1 + NEXP * I_W2;
    for (int it = gw; it < NITEMS; it += NGW) {
        int r = it;
        if (r < I_IN) { p0_transpose_item(a.in[3], 1024, 3072, WIN, scr, r, lane_id()); continue; } r -= I_IN;
        if (r < I_OUT) { p0_transpose_item(a.in[10], 1024, 1024, WOUT, scr, r, lane_id()); continue; } r -= I_OUT;
        if (r < NEXP * I_W1) { const int e = r / I_W1; p0_transpose_item_fp8(a.in[15] + (size_t)e * 1024 * 2048, 1024, 2048, W1T + (size_t)e * 1024 * 2048, scr, r % I_W1, lane_id(), 1024.0f); continue; } r -= NEXP * I_W1;
        { const int e = r / I_W2; p0_transpose_item_fp8(a.in[17] + (size_t)e * 1024 * 1024, 1024, 1024, W2T + (size_t)e * 1024 * 1024, scr, r % I_W2, lane_id(), 2048.0f); }
    }
    { u16* RW = (u16*)(ws + WS_RWT); const float* rw = a.in[13];
      for (int idx = F.bid * NTHR + F.tid(); idx < 32768; idx += F.G * NTHR) { const int e = idx >> 10, k = idx & 1023; const float v = rw[k * 32 + e]; const u16 hi = f2bf(v); RW[idx] = hi; RW[32768 + idx] = f2bf(v - bf2f(hi)); } }
    for (int m = gw; m < NTOK; m += NGW) ln_row_in(a.in[0] + (size_t)m * DM, a.in[1], a.in[2], H0 + (size_t)m * DM, lane_id());
}

__device__ __forceinline__ void p4_router(const Frame& F, const Args& a) {
    unsigned char* ws = a.ws;
    const u16* U = (const u16*)(ws + WS_U); u16* H1 = (u16*)(ws + WS_H1); int* LIST = (int*)(ws + WS_LIST); float* GATE = (float*)(ws + WS_GATE); int* CNT = (int*)(F.ctl + CW_CNT);
    const float* g1 = a.in[11]; const float* b1 = a.in[12]; const float* rb = a.in[14];
    const u32x4* RWT = (const u32x4*)(ws + WS_RWT);
    LAS int* lcnt = (LAS int*)(F.lds + TAB_OFF); LAS int* lbase = lcnt + 32; LAS int* ent_e = lcnt + 64; LAS int* ent_p = ent_e + 512;
    const int lane = lane_id(), tok = lane & 15, kg = lane >> 4;
    for (int i = F.tid(); i < 8192; i += NTHR) { const int img = i >> 12, e = (i >> 7) & 31, c = i & 127; *(LAS u32x4*)(F.lds + RING_OFF + img * 65536 + e * 2048 + 16 * (c ^ (e & 15))) = RWT[i]; }
    for (int batch = F.bid; batch < NTOK / 128; batch += F.G) {
        __syncthreads();
        if (F.tid() < 32) lcnt[F.tid()] = 0;
        __syncthreads();
        const int tl = F.wave * 16 + tok, t = batch * 128 + tl;
        const u32x4* ur = (const u32x4*)(U + (size_t)t * DM) + kg;
        float s1 = 0.f;
#pragma unroll 8
        for (int s = 0; s < 32; ++s) { const u32x4 w = ur[4 * s];
            s1 += (__uint_as_float(w.x << 16) + __uint_as_float(w.x & 0xffff0000u)) + (__uint_as_float(w.y << 16) + __uint_as_float(w.y & 0xffff0000u))
                + (__uint_as_float(w.z << 16) + __uint_as_float(w.z & 0xffff0000u)) + (__uint_as_float(w.w << 16) + __uint_as_float(w.w & 0xffff0000u)); }
        s1 += __shfl_xor(s1, 16); s1 += __shfl_xor(s1, 32);
        const float mean = s1 * (1.f / DM);
        float s2 = 0.f;
#pragma unroll 8
        for (int s = 0; s < 32; ++s) { const u32x4 w = ur[4 * s];
            const float d0 = __uint_as_float(w.x << 16) - mean, d1 = __uint_as_float(w.x & 0xffff0000u) - mean, d2 = __uint_as_float(w.y << 16) - mean, d3 = __uint_as_float(w.y & 0xffff0000u) - mean;
            const float d4 = __uint_as_float(w.z << 16) - mean, d5 = __uint_as_float(w.z & 0xffff0000u) - mean, d6 = __uint_as_float(w.w << 16) - mean, d7 = __uint_as_float(w.w & 0xffff0000u) - mean;
            s2 += (d0 * d0 + d1 * d1) + (d2 * d2 + d3 * d3) + (d4 * d4 + d5 * d5) + (d6 * d6 + d7 * d7); }
        s2 += __shfl_xor(s2, 16); s2 += __shfl_xor(s2, 32);
        const float rstd = 1.f / sqrtf(s2 * (1.f / DM) + LN_EPS);
        f32x4 acc[2];
        acc[0] = (f32x4){0.f, 0.f, 0.f, 0.f}; acc[1] = (f32x4){0.f, 0.f, 0.f, 0.f};
        u32x4* hr = (u32x4*)(H1 + (size_t)t * DM) + kg;
        u32x2* hq = (u32x2*)(ws + WS_H1Q + (size_t)t * DM) + kg;
        LAS const unsigned char* wimg = F.lds + RING_OFF + tok * 2048;
#pragma unroll 2
        for (int s = 0; s < 32; ++s) {
            const u32x4 w = ur[4 * s];
            const f32x4 ga = *(const f32x4*)(g1 + 32 * s + 8 * kg), gb = *(const f32x4*)(g1 + 32 * s + 8 * kg + 4), ba = *(const f32x4*)(b1 + 32 * s + 8 * kg), bb = *(const f32x4*)(b1 + 32 * s + 8 * kg + 4);
            float h[8];
            h[0] = (__uint_as_float(w.x << 16) - mean) * rstd * ga.x + ba.x; h[1] = (__uint_as_float(w.x & 0xffff0000u) - mean) * rstd * ga.y + ba.y;
            h[2] = (__uint_as_float(w.y << 16) - mean) * rstd * ga.z + ba.z; h[3] = (__uint_as_float(w.y & 0xffff0000u) - mean) * rstd * ga.w + ba.w;
            h[4] = (__uint_as_float(w.z << 16) - mean) * rstd * gb.x + bb.x; h[5] = (__uint_as_float(w.z & 0xffff0000u) - mean) * rstd * gb.y + bb.y;
            h[6] = (__uint_as_float(w.w << 16) - mean) * rstd * gb.z + bb.z; h[7] = (__uint_as_float(w.w & 0xffff0000u) - mean) * rstd * gb.w + bb.w;
            u32x4 hh, hl;
            hh.x = pk2(h[0], h[1]); hh.y = pk2(h[2], h[3]); hh.z = pk2(h[4], h[5]); hh.w = pk2(h[6], h[7]);
            hr[4 * s] = hh;
            { u32x2 q8; int w0 = __builtin_amdgcn_cvt_pk_fp8_f32(h[0] * 8.0f, h[1] * 8.0f, 0, false); w0 = __builtin_amdgcn_cvt_pk_fp8_f32(h[2] * 8.0f, h[3] * 8.0f, w0, true);
              int w1 = __builtin_amdgcn_cvt_pk_fp8_f32(h[4] * 8.0f, h[5] * 8.0f, 0, false); w1 = __builtin_amdgcn_cvt_pk_fp8_f32(h[6] * 8.0f, h[7] * 8.0f, w1, true); q8.x = (unsigned)w0; q8.y = (unsigned)w1; hq[4 * s] = q8; }
            hl.x = pk2(h[0] - __uint_as_float(hh.x << 16), h[1] - __uint_as_float(hh.x & 0xffff0000u)); hl.y = pk2(h[2] - __uint_as_float(hh.y << 16), h[3] - __uint_as_float(hh.y & 0xffff0000u));
            hl.z = pk2(h[4] - __uint_as_float(hh.z << 16), h[5] - __uint_as_float(hh.z & 0xffff0000u)); hl.w = pk2(h[6] - __uint_as_float(hh.w << 16), h[7] - __uint_as_float(hh.w & 0xffff0000u));
            const bf16x8 bh = __builtin_bit_cast(bf16x8, hh), bl = __builtin_bit_cast(bf16x8, hl);
            const unsigned co = 16u * ((unsigned)(4 * s + kg) ^ (unsigned)tok);
#pragma unroll
            for (int eh = 0; eh < 2; ++eh) {
                const bf16x8 wh = *(const LAS bf16x8*)(wimg + eh * 32768 + co), wl = *(const LAS bf16x8*)(wimg + 65536 + eh * 32768 + co);
                acc[eh] = __builtin_amdgcn_mfma_f32_16x16x32_bf16(wh, bh, acc[eh], 0, 0, 0);
                acc[eh] = __builtin_amdgcn_mfma_f32_16x16x32_bf16(wl, bh, acc[eh], 0, 0, 0);
                acc[eh] = __builtin_amdgcn_mfma_f32_16x16x32_bf16(wh, bl, acc[eh], 0, 0, 0);
            }
        }
        float lg[8];
#pragma unroll
        for (int eh = 0; eh < 2; ++eh)
#pragma unroll
            for (int r = 0; r < 4; ++r) lg[eh * 4 + r] = acc[eh][r] + rb[16 * eh + 4 * kg + r];
        unsigned used = 0u; float tv[4]; int ti[4];
#pragma unroll
        for (int k = 0; k < 4; ++k) {
            float best = -INFINITY; int bi = 1 << 20;
#pragma unroll
            for (int j = 0; j < 8; ++j) { const int e = 16 * (j >> 2) + 4 * kg + (j & 3); const bool ok = !((used >> j) & 1u) && (lg[j] > best || (lg[j] == best && e < bi)); best = ok ? lg[j] : best; bi = ok ? e : bi; }
#pragma unroll
            for (int off = 16; off <= 32; off <<= 1) { const float ov = __shfl_xor(best, off); const int oi = __shfl_xor(bi, off); const bool tk = ov > best || (ov == best && oi < bi); best = tk ? ov : best; bi = tk ? oi : bi; }
            tv[k] = best; ti[k] = bi;
#pragma unroll
            for (int j = 0; j < 8; ++j) { const int e = 16 * (j >> 2) + 4 * kg + (j & 3); if (e == bi) used |= 1u << j; }
        }
        const float e1 = __expf(tv[1] - tv[0]), e2 = __expf(tv[2] - tv[0]), e3 = __expf(tv[3] - tv[0]);
        const float inv = 1.f / (1.f + e1 + e2 + e3);
        {
            const int me = kg == 0 ? ti[0] : kg == 1 ? ti[1] : kg == 2 ? ti[2] : ti[3];
            const float mg = (kg == 0 ? 1.f : kg == 1 ? e1 : kg == 2 ? e2 : e3) * inv;
            const int pos = __hip_atomic_fetch_add(lcnt + me, 1, __ATOMIC_RELAXED, __HIP_MEMORY_SCOPE_WORKGROUP);
            ent_e[tl * 4 + kg] = me; ent_p[tl * 4 + kg] = pos; GATE[t * 4 + kg] = mg;
        }
        __syncthreads();
        if (F.tid() < 32) lbase[F.tid()] = atomicAdd(CNT + F.tid(), lcnt[F.tid()]);
        __syncthreads();
        { const int e = ent_e[F.tid()]; LIST[(size_t)e * NTOK + lbase[e] + ent_p[F.tid()]] = (batch * 128 + (F.tid() >> 2)) * 4 + (F.tid() & 3); }
    }
}

__device__ __forceinline__ void p7_final(const Frame& F, const Args& a) {
    const u16* H1 = (const u16*)(a.ws + WS_H1); const u16* YS = (const u16*)(a.ws + WS_YS); const float* g2 = a.in[19]; const float* b2 = a.in[20];
    const int lane = lane_id(), gw = F.bid * NWAVES + F.wave, NGW = F.G * NWAVES;
    for (int t = gw; t < NTOK; t += NGW) {
        float v[16]; float s = 0.f;
#pragma unroll
        for (int j = 0; j < 4; ++j) {
            const u32x2 w = ((const u32x2*)(H1 + (size_t)t * DM) + lane)[64 * j];
            float a0 = DN_ALPHA * __uint_as_float(w.x << 16), a1 = DN_ALPHA * __uint_as_float(w.x & 0xffff0000u), a2 = DN_ALPHA * __uint_as_float(w.y << 16), a3 = DN_ALPHA * __uint_as_float(w.y & 0xffff0000u);
#pragma unroll
            for (int k = 0; k < 4; ++k) {
                const u32x2 y = ((const u32x2*)(YS + ((size_t)t * 4 + k) * DM) + lane)[64 * j];
                a0 += __uint_as_float(y.x << 16); a1 += __uint_as_float(y.x & 0xffff0000u); a2 += __uint_as_float(y.y << 16); a3 += __uint_as_float(y.y & 0xffff0000u);
            }
            v[4 * j] = a0; v[4 * j + 1] = a1; v[4 * j + 2] = a2; v[4 * j + 3] = a3; s += (a0 + a1) + (a2 + a3);
        }
        const float mean = wave_sum(s) * (1.f / DM); float s2 = 0.f;
#pragma unroll
        for (int i = 0; i < 16; ++i) { v[i] -= mean; s2 += v[i] * v[i]; }
        const float rstd = 1.f / sqrtf(wave_sum(s2) * (1.f / DM) + LN_EPS);
        f32x4* o = (f32x4*)(a.out + (size_t)t * DM) + lane;
#pragma unroll
        for (int j = 0; j < 4; ++j) {
            const f32x4 gg = ((const f32x4*)g2)[lane + 64 * j], bb = ((const f32x4*)b2)[lane + 64 * j];
            o[64 * j] = (f32x4){v[4 * j] * rstd * gg.x + bb.x, v[4 * j + 1] * rstd * gg.y + bb.y, v[4 * j + 2] * rstd * gg.z + bb.z, v[4 * j + 3] * rstd * gg.w + bb.w};
        }
    }
}


namespace att {
typedef float f32x16 __attribute__((ext_vector_type(16)));
typedef short s16x4 __attribute__((ext_vector_type(4)));
typedef short v4i16_t __attribute__((ext_vector_type(4)));
constexpr int KV_BUF = 32768, X_OFF = 65536, WSF_OFF = TAB_OFF, TBL_OFF = TAB_OFF + 2048;
constexpr float THR = 6.0f;
__device__ __forceinline__ int crow(int r, int hi) { return (r & 3) + 8 * (r >> 2) + 4 * hi; }
__device__ __forceinline__ unsigned cvtpk(float lo, float hi) { typedef float f2 __attribute__((ext_vector_type(2))); typedef __bf16 b2 __attribute__((ext_vector_type(2))); f2 v = {lo, hi}; b2 b = __builtin_convertvector(v, b2); return __builtin_bit_cast(unsigned, b); }
__device__ __forceinline__ s16x4 vtr(LAS const unsigned char* p) { return __builtin_bit_cast(s16x4, __builtin_amdgcn_ds_read_tr16_b64_v4i16((LAS v4i16_t*)p)); }
__device__ __forceinline__ float swapmax(float m) { auto rr = __builtin_amdgcn_permlane32_swap(__float_as_uint(m), __float_as_uint(m), false, false); return fmaxf(__uint_as_float(rr[0]), __uint_as_float(rr[1])); }
__device__ __forceinline__ float swapsum(float m) { auto rr = __builtin_amdgcn_permlane32_swap(__float_as_uint(m), __float_as_uint(m), false, false); return __uint_as_float(rr[0]) + __uint_as_float(rr[1]); }

template <bool ISA>
__device__ __forceinline__ void attn_unit(const Frame& F, const u16* QKV, u16* O, int b, int hx, int jq, float lam, const float* subg, const float* relb) {
    constexpr int DVB = ISA ? 4 : 2;
    const int lane = lane_id(), w = F.wave, sub = w >> 2, rg = w & 3, r32 = lane & 31, hi = lane >> 5;
    const int q0 = jq * 128, cq = 2 * jq + (rg >> 1);
    const int qpos = q0 + rg * 32 + r32;
    const size_t tok0 = (size_t)b * SEQ;
    const int qcol = (ISA ? hx * 128 : 1536 + hx * 128) + sub * 64;
    const int kcol0 = ISA ? 512 + hx * 128 : 2048 + hx * 128, vcol0 = ISA ? 1024 + hx * 128 : 2560 + hx * 128;
    const int ktop = 2 * jq + 1, kbot = ISA ? 0 : (2 * jq - 8 > 0 ? 2 * jq - 8 : 0);
    const int NTs = ktop - kbot + 1;
    LAS unsigned char* lds = F.lds;
    unsigned soff[2];
#pragma unroll
    for (int i = 0; i < 2; ++i) { const unsigned row = 4u * (8u * i + w) + (lane >> 4); const unsigned f = ((row & 3u) << 2) | ((row >> 2) & 3u); soff[i] = row * (QKVP * 2) + (((unsigned)lane & 15u) ^ f) * 16u; }
    const char* kvbase = (const char*)QKV + (tok0 * QKVP + kcol0) * 2;
    const unsigned ldsw = (unsigned)w * 1024u;
#define ATT_ISSUE(kt, buf) do { const char* kb_ = kvbase + (size_t)(kt) * 64 * QKVP * 2; const char* vb_ = kb_ + (vcol0 - kcol0) * 2; \
        _Pragma("unroll") for (int i_ = 0; i_ < 2; ++i_) { \
            __builtin_amdgcn_global_load_lds((const unsigned*)(kb_ + soff[i_]), (LAS unsigned*)(lds + (buf) * KV_BUF + i_ * 8192 + ldsw), 16, 0, 0); \
            __builtin_amdgcn_global_load_lds((const unsigned*)(vb_ + soff[i_]), (LAS unsigned*)(lds + (buf) * KV_BUF + 16384 + i_ * 8192 + ldsw), 16, 0, 0); } } while (0)
    ATT_ISSUE(ktop, 0);
    if (!ISA) {
        LAS float* tbl = (LAS float*)(lds + TBL_OFF);
        for (int i = F.tid(); i < 1280; i += NTHR) { const int hd = i / 640, idx = i % 640; int rel = idx - 64; rel = rel < -256 ? -256 : (rel > 256 ? 256 : rel); tbl[i] = relb[(2 * hx + hd) * 513 + rel + 256] * LOG2E; }
    }
    bf16x8 qf[4];
    { const u16* qp = QKV + (tok0 + q0 + rg * 32 + r32) * QKVP + qcol + 8 * hi;
#pragma unroll
      for (int s = 0; s < 4; ++s) qf[s] = *(const bf16x8*)(qp + 16 * s); }
    const unsigned fr_ = ((r32 & 3u) << 2) | ((r32 >> 2) & 3u);
    unsigned kad[4];
#pragma unroll
    for (int s = 0; s < 4; ++s) kad[s] = 256u * r32 + 16u * ((8u * sub + 2u * s + hi) ^ fr_);
    const unsigned qd = (lane & 15) >> 2, pd = lane & 3, blk = (lane >> 4) & 1, xlow = 2 * blk + (pd >> 1);
    unsigned vad[DVB][2];
#pragma unroll
    for (int c = 0; c < DVB; ++c)
#pragma unroll
        for (int t = 0; t < 2; ++t) { const unsigned ci = ISA ? (unsigned)c : (unsigned)(2 * sub + c);
            vad[c][t] = 2048u * t + 256u * (4u * hi + qd) + 64u * (ci ^ qd) + 16u * (xlow ^ ((2u * t + hi) & 3u)) + 8u * (pd & 1u); }
    const float sl2 = ISA ? exp2f(-2.0f * (float)(hx + 1)) * LOG2E : 0.f;
    LAS float* wsf = (LAS float*)(lds + WSF_OFF) + w * 64;
    float mrun = -INFINITY, lrun = 0.f;
    f32x16 o[DVB];
#pragma unroll
    for (int c = 0; c < DVB; ++c)
#pragma unroll
        for (int r = 0; r < 16; ++r) o[c][r] = 0.f;

    for (int i = 0; i < NTs; ++i) {
        const int kt = ktop - i, buf = i & 1;
        asm volatile("s_waitcnt vmcnt(0)" ::: "memory");
        __syncthreads();
        if (i + 1 < NTs) ATT_ISSUE(kt - 1, buf ^ 1);
        const bool active = ISA ? (kt <= cq) : (kt <= cq && kt >= cq - 8);
        if (active) {
            LAS const unsigned char* kbuf = lds + buf * KV_BUF; LAS const unsigned char* vbuf = kbuf + 16384;
            f32x16 p0, p1;
#pragma unroll
            for (int r = 0; r < 16; ++r) { p0[r] = 0.f; p1[r] = 0.f; }
#pragma unroll
            for (int s = 0; s < 4; ++s) {
                const bf16x8 k0 = *(const LAS bf16x8*)(kbuf + kad[s]);
                const bf16x8 k1 = *(const LAS bf16x8*)(kbuf + kad[s] + 8192);
                p0 = __builtin_amdgcn_mfma_f32_32x32x16_bf16(k0, qf[s], p0, 0, 0, 0);
                p1 = __builtin_amdgcn_mfma_f32_32x32x16_bf16(k1, qf[s], p1, 0, 0, 0);
            }
            if (ISA) {
                const float dl = (float)(kt * 64 + 4 * hi - qpos);
#pragma unroll
                for (int r = 0; r < 16; ++r) { const float kc = (float)((r & 3) + 8 * (r >> 2)); p0[r] = fmaf(-sl2, fabsf(dl + kc), p0[r]); p1[r] = fmaf(-sl2, fabsf(dl + kc + 32.0f), p1[r]); }
            } else {
                LAS const float* tb = (LAS const float*)(lds + TBL_OFF) + sub * 640 + (qpos + 64 - kt * 64 - 4 * hi - 63);
#pragma unroll
                for (int r = 0; r < 16; ++r) { const int kc = (r & 3) + 8 * (r >> 2); p0[r] += tb[63 - kc]; p1[r] += tb[63 - 32 - kc]; }
            }
            float mx = fmaxf(p0[0], p1[0]);
#pragma unroll
            for (int r = 1; r < 16; ++r) mx = fmaxf(mx, fmaxf(p0[r], p1[r]));
            const float mt = swapmax(mx);
            if (__any(mt > mrun + THR)) {
                const float mnew = fmaxf(mrun, mt), alpha = __builtin_amdgcn_exp2f(mrun - mnew);
                lrun *= alpha; mrun = mnew;
                if (hi == 0) wsf[r32] = alpha;
#pragma unroll
                for (int r = 0; r < 16; ++r) { const float a_ = wsf[crow(r, hi)];
#pragma unroll
                    for (int c = 0; c < DVB; ++c) o[c][r] *= a_; }
            }
            float ps = 0.f;
#pragma unroll
            for (int r = 0; r < 16; ++r) { p0[r] = __builtin_amdgcn_exp2f(p0[r] - mrun); p1[r] = __builtin_amdgcn_exp2f(p1[r] - mrun); ps += p0[r] + p1[r]; }
            lrun += ps;
            u32x4 pw[4];
#pragma unroll
            for (int q = 0; q < 4; ++q) { pw[0][q] = cvtpk(p0[2 * q], p0[2 * q + 1]); pw[1][q] = cvtpk(p0[8 + 2 * q], p0[8 + 2 * q + 1]); pw[2][q] = cvtpk(p1[2 * q], p1[2 * q + 1]); pw[3][q] = cvtpk(p1[8 + 2 * q], p1[8 + 2 * q + 1]); }
#pragma unroll
            for (int c = 0; c < DVB; ++c)
#pragma unroll
                for (int ks = 0; ks < 4; ++ks) {
                    const s16x4 lo = vtr(vbuf + vad[c][0] + 4096 * ks), h4 = vtr(vbuf + vad[c][1] + 4096 * ks);
                    const bf16x8 vf = (bf16x8){lo[0], lo[1], lo[2], lo[3], h4[0], h4[1], h4[2], h4[3]};
                    o[c] = __builtin_amdgcn_mfma_f32_32x32x16_bf16(__builtin_bit_cast(bf16x8, pw[ks]), vf, o[c], 0, 0, 0);
                }
        }
    }
    { const float lt = swapsum(lrun); const float inv = 1.0f / lt;
      if (hi == 0) wsf[r32] = inv;
#pragma unroll
      for (int r = 0; r < 16; ++r) { const float a_ = wsf[crow(r, hi)];
#pragma unroll
          for (int c = 0; c < DVB; ++c) o[c][r] *= a_; } }
    __syncthreads();
    if (ISA) {
        LAS float* X = (LAS float*)(lds + X_OFF) + rg * 4096;
        if (sub == 1) {
#pragma unroll
            for (int c = 0; c < 4; ++c)
#pragma unroll
                for (int r = 0; r < 16; ++r) X[(c * 16 + r) * 64 + lane] = o[c][r];
        }
        __syncthreads();
        if (sub == 0) {
            float ss[16];
#pragma unroll
            for (int r = 0; r < 16; ++r) ss[r] = 0.f;
#pragma unroll
            for (int c = 0; c < 4; ++c)
#pragma unroll
                for (int r = 0; r < 16; ++r) { const float y = o[c][r] - lam * X[(c * 16 + r) * 64 + lane]; o[c][r] = y; ss[r] += y * y; }
#pragma unroll
            for (int r = 0; r < 16; ++r) {
                float v = ss[r];
                v += __shfl_xor(v, 1); v += __shfl_xor(v, 2); v += __shfl_xor(v, 4); v += __shfl_xor(v, 8); v += __shfl_xor(v, 16);
                ss[r] = 0.8f / sqrtf(v * (1.0f / 128.0f) + 1e-5f);
            }
            float gg[4];
#pragma unroll
            for (int c = 0; c < 4; ++c) gg[c] = subg[32 * c + r32];
            LAS u16* stg = (LAS u16*)(lds + X_OFF + rg * 16384);
            asm volatile("s_waitcnt lgkmcnt(0)" ::: "memory");
#pragma unroll
            for (int c = 0; c < 4; ++c)
#pragma unroll
                for (int r = 0; r < 16; ++r) stg[crow(r, hi) * 128 + 32 * c + r32] = f2bf(o[c][r] * ss[r] * gg[c]);
            asm volatile("s_waitcnt lgkmcnt(0)" ::: "memory");
            u16* og = O + (tok0 + q0 + rg * 32) * DM + hx * 128;
#pragma unroll
            for (int i = 0; i < 8; ++i) { const int row = 4 * i + (lane >> 4), ch = lane & 15; const u32x4 v = *(const LAS u32x4*)((LAS const unsigned char*)stg + row * 256 + ch * 16); *(u32x4*)(og + (size_t)row * DM + ch * 8) = v; }
        }
    } else {
        LAS u16* stg = (LAS u16*)(lds + X_OFF + w * 4096);
#pragma unroll
        for (int c = 0; c < 2; ++c)
#pragma unroll
            for (int r = 0; r < 16; ++r) stg[crow(r, hi) * 64 + 32 * c + r32] = f2bf(o[c][r]);
        asm volatile("s_waitcnt lgkmcnt(0)" ::: "memory");
        u16* og = O + (tok0 + q0 + rg * 32) * DM + 512 + (2 * hx + sub) * 64;
#pragma unroll
        for (int i = 0; i < 4; ++i) { const int row = 8 * i + (lane >> 3), ch = lane & 7; const u32x4 v = *(const LAS u32x4*)((LAS const unsigned char*)stg + row * 128 + ch * 16); *(u32x4*)(og + (size_t)row * DM + ch * 8) = v; }
    }
    __syncthreads();
#undef ATT_ISSUE
}

__device__ __forceinline__ void p2_attention(const Frame& F, const Args& a) {
    const u16* QKV = (const u16*)(a.ws + WS_QKV); u16* O = (u16*)(a.ws + WS_O);
    float d1 = 0.f, d2 = 0.f;
    for (int i = 0; i < 64; ++i) { d1 += a.in[4][i] * a.in[5][i]; d2 += a.in[6][i] * a.in[7][i]; }
    const float lam = expf(d1) - expf(d2) + 0.2f;
    const int vcu = (F.G % 8 == 0) ? (F.bid % 8) * (F.G / 8) + F.bid / 8 : F.bid;
    for (int g = vcu; g < 256; g += F.G) {
        const int grp = g >> 3, s = g & 7, b = grp >> 2, hx = grp & 3;
        for (int i = 0; i < 4; ++i) { const int jq = i == 0 ? 31 - s : i == 1 ? 16 + s : i == 2 ? 15 - s : s; attn_unit<true>(F, QKV, O, b, hx, jq, lam, a.in[8], a.in[9]); }
        for (int i = 0; i < 4; ++i) { const int jq = i == 0 ? 31 - s : i == 1 ? 16 + s : i == 2 ? 15 - s : s; attn_unit<false>(F, QKV, O, b, hx, jq, lam, a.in[8], a.in[9]); }
    }
}
}
#ifndef REP_MASK
#define REP_MASK 0
#endif
__global__ void __launch_bounds__(NTHR, 2) mk_fwd(Args args) {
    extern __shared__ __attribute__((aligned(16))) unsigned char lds_raw[];
    Frame F;
    F.lds = (LAS unsigned char*)lds_raw; F.MISC = (volatile LAS unsigned*)(F.lds + MISC_OFF);
    F.wave = __builtin_amdgcn_readfirstlane((int)threadIdx.x >> 6); F.G = gridDim.x; F.bid = blockIdx.x;
    F.ctl = (gu32*)(args.ws + WS_CTL);
    for (int u = F.tid(); u < 256; u += NTHR) ((LAS unsigned*)(F.lds + MISC_OFF))[u] = 0u;
    __syncthreads();
    const int lo = args.ph_lo, hi = args.ph_hi;
    const bool multi = (hi - lo) > 1;
    XcdBarrier bar; bar.bar = (unsigned*)(F.ctl + CW_BAR) + args.li * XCD_BAR_WORDS; bar.x = 0; bar.st = nullptr; bar.wave = F.wave;
    if (multi) bar = xcd_barrier_post((unsigned*)(F.ctl + CW_BAR) + args.li * XCD_BAR_WORDS, F.MISC + 8, F.wave);
#define IN(k) (lo <= (k) && (k) < hi)
#define SEAM(k) do { if (IN(k) && IN((k) + 1)) xcd_barrier(bar); } while (0)
    unsigned char* ws = args.ws;
    if (IN(0)) { p0_prologue(F, args); if (REP_MASK & 1) p0_prologue(F, args); SEAM(0); }
    if (IN(1)) {
        PDense S; S.A = (const u16*)(ws + WS_H0); S.Bt = (const u16*)(ws + WS_WIN); S.out = (u16*)(ws + WS_QKV); S.H0 = nullptr; S.mode = 0; S.ord.init(NTOK, QKVP, F.G, F.bid);
        pg8::gemm_phase(F.lds + RING_OFF, S, F.wave); if (REP_MASK & 2) pg8::gemm_phase(F.lds + RING_OFF, S, F.wave); SEAM(1);
    }
    if (IN(2)) { att::p2_attention(F, args); if (REP_MASK & 4) att::p2_attention(F, args); SEAM(2); }
    if (IN(3)) {
        PDense S; S.A = (const u16*)(ws + WS_O); S.Bt = (const u16*)(ws + WS_WOUT); S.out = (u16*)(ws + WS_U); S.H0 = (const u16*)(ws + WS_H0); S.mode = 1; S.ord.init(NTOK, DM, F.G, F.bid);
        pg8::gemm_phase(F.lds + RING_OFF, S, F.wave); if (REP_MASK & 8) pg8::gemm_phase(F.lds + RING_OFF, S, F.wave); SEAM(3);
    }
    if (IN(4)) { p4_router(F, args); SEAM(4); }
    if (IN(5)) {
        const MoeTab T = moe_tab(F.lds); moe_tables(T, (const int*)(F.ctl + CW_CNT), F.wave);
        PMoe<1> S; S.A = ws + WS_H1Q; S.Bt = ws + WS_W1; S.out = (void*)(ws + WS_ACT); S.list = (const int*)(ws + WS_LIST); S.gate = nullptr; S.bias = args.in[16]; S.T = T; S.c = F.bid; S.ntot = __builtin_amdgcn_readfirstlane(T.tb[NEXP]);
        S.prepare(F.wave);
        pg8::gemm_phase(F.lds + RING_OFF, S, F.wave); if (REP_MASK & 32) pg8::gemm_phase(F.lds + RING_OFF, S, F.wave); SEAM(5);
    }
    if (IN(6)) {
        const MoeTab T = moe_tab(F.lds); moe_tables(T, (const int*)(F.ctl + CW_CNT), F.wave);
        PMoe<0> S; S.A = ws + WS_ACT; S.Bt = ws + WS_W2; S.out = (void*)(ws + WS_YS); S.list = (const int*)(ws + WS_LIST); S.gate = (const float*)(ws + WS_GATE); S.bias = args.in[18]; S.T = T; S.c = F.bid; S.ntot = __builtin_amdgcn_readfirstlane(T.tb[NEXP]);
        S.prepare(F.wave);
        pg8::gemm_phase(F.lds + RING_OFF, S, F.wave); if (REP_MASK & 64) pg8::gemm_phase(F.lds + RING_OFF, S, F.wave); SEAM(6);
    }
    if (IN(7)) { p7_final(F, args); if (REP_MASK & 128) p7_final(F, args); }
#undef IN
#undef SEAM
}

extern "C" void kernel_launch(void* const* d_in, const int* in_sizes, int n_in, void* d_out, int out_size, void* d_ws, size_t ws_size, hipStream_t stream) {
    static int grid = 0;
    if (grid == 0) {
        if (n_in != 21 || in_sizes[0] != NTOK * DM || out_size != NTOK * DM || ws_size < WS_END) { fprintf(stderr, "kernel_launch: unexpected shapes / workspace (%d inputs, ws %zu)\n", n_in, ws_size); grid = -1; return; }
        int dev = 0, cus = 0, per_cu = 0;
        if (hipGetDevice(&dev) != hipSuccess || hipDeviceGetAttribute(&cus, hipDeviceAttributeMultiprocessorCount, dev) != hipSuccess) { grid = -1; return; }
        if (hipFuncSetAttribute((const void*)mk_fwd, hipFuncAttributeMaxDynamicSharedMemorySize, LDS_BYTES) != hipSuccess) { fprintf(stderr, "kernel_launch: hipFuncSetAttribute failed\n"); grid = -1; return; }
        if (hipOccupancyMaxActiveBlocksPerMultiprocessor(&per_cu, (const void*)mk_fwd, NTHR, LDS_BYTES) != hipSuccess || per_cu < 1) { fprintf(stderr, "kernel_launch: occupancy query says %d blocks per CU\n", per_cu); (void)hipGetLastError(); grid = -1; return; }
        if (cus < 256) { fprintf(stderr, "kernel_launch: needs 256 CUs, device has %d\n", cus); grid = -1; return; }
        grid = 256;
    }
    if (grid < 0) return;
    const float* lq1 = (const float*)d_in[4]; const float* lk1 = (const float*)d_in[5]; const float* lq2 = (const float*)d_in[6]; const float* lk2 = (const float*)d_in[7];
    const float* subg = (const float*)d_in[8]; const float* relb = (const float*)d_in[9];
    char* ws = (char*)d_ws;
    u16* QKV = (u16*)(ws + WS_QKV); u16* O = (u16*)(ws + WS_O);
    (void)hipMemsetAsync(ws + WS_CTL, 0, CTL_BYTES, stream);
    Args a{};
    for (int i = 0; i < 21; ++i) a.in[i] = (const float*)d_in[i];
    a.out = (float*)d_out; a.ws = (unsigned char*)d_ws;
    int nl = 0;
    auto run = [&](int lo, int hi) { a.ph_lo = lo; a.ph_hi = hi; a.li = nl++; hipLaunchKernelGGL(mk_fwd, dim3(grid), dim3(NTHR), LDS_BYTES, stream, a); };
    run(0, 8);
}
```

```cpp
#define REP_MASK 0
#include <hip/hip_runtime.h>
#include <cstdint>
#include <cstdio>

typedef unsigned short u16;
typedef short bf16x8 __attribute__((ext_vector_type(8)));
typedef float f32x4 __attribute__((ext_vector_type(4)));
typedef unsigned u32x4 __attribute__((ext_vector_type(4)));
typedef unsigned u32x2 __attribute__((ext_vector_type(2)));
#define LAS __attribute__((address_space(3)))

constexpr int NTOK = 32768, DM = 1024, SEQ = 4096, NBATCH = 8;
constexpr int QKVP = 3072;
constexpr int NEXP = 32;
constexpr float LOG2E = 1.4426950408889634f;
constexpr float QSCALE = 0.125f * LOG2E;
constexpr float DN_ALPHA = 1.189207115002721f;
constexpr float LN_EPS = 1e-5f;

constexpr size_t MiB = 1u << 20;
constexpr size_t WS_CTL = 0, CTL_BYTES = 1 * MiB;
constexpr size_t WS_RWT = 1 * MiB;
constexpr size_t WS_KN = 1 * MiB + 256 * 1024;
constexpr size_t WS_H1Q = 80 * MiB;
constexpr size_t WS_WIN = 2 * MiB, WS_WOUT = 8 * MiB, WS_W1 = 16 * MiB, WS_W2 = 144 * MiB;
constexpr size_t WS_H1 = 208 * MiB, WS_LIST = 272 * MiB, WS_GATE = 276 * MiB;
constexpr size_t WS_H0 = 280 * MiB, WS_QKV = 344 * MiB, WS_O = 536 * MiB, WS_U = 344 * MiB, WS_ACT = 280 * MiB;
constexpr size_t WS_YS = 600 * MiB, WS_END = 856 * MiB;

__device__ __forceinline__ float bf2f(u16 v) { return __uint_as_float((unsigned)v << 16); }
__device__ __forceinline__ u16 f2bf(float f) { unsigned u = __float_as_uint(f); return (u16)((u + 0x7fffu + ((u >> 16) & 1u)) >> 16); }
__device__ __forceinline__ unsigned pk2(float lo, float hi) { return (unsigned)f2bf(lo) | ((unsigned)f2bf(hi) << 16); }
__device__ __forceinline__ float wave_sum(float v) {
#pragma unroll
    for (int o = 1; o < 64; o <<= 1) v += __shfl_xor(v, o);
    return v;
}


#define GAS __attribute__((address_space(1)))
typedef GAS unsigned gu32;
#define RLX_AGENT __ATOMIC_RELAXED, __HIP_MEMORY_SCOPE_AGENT
#define LDS_WAIT() asm volatile("s_waitcnt lgkmcnt(0)" ::: "memory")
#define VM_WAIT() asm volatile("s_waitcnt vmcnt(0)" ::: "memory")

constexpr int NWAVES = 8, NTHR = 512;
__device__ __forceinline__ int lane_id() { int l; asm volatile("v_mbcnt_lo_u32_b32 %0, -1, 0\n\tv_mbcnt_hi_u32_b32 %0, -1, %0" : "=v"(l)); return l; }
constexpr int RING_OFF = 0, RING_BYTES = 131072, TAB_OFF = 131072, TAB_BYTES = 24576, MISC_OFF = TAB_OFF + TAB_BYTES, LDS_BYTES = MISC_OFF + 1024;
constexpr int CW_CNT = 0;
constexpr int CW_Q = 2048;
constexpr int CW_BAR = 4096;

#define XB_TMO      128
#define XB_XCNT(j)  (256  + 64 * (j))
#define XB_XSUB(j)  (1280 + 64 * (j))
#define XB_XGEN(j)  (2304 + 64 * (j))
#define XB_TOP      3328
#define XB_TOPGEN   3392
#define XCD_BAR_WORDS 3456
#define XB_SPIN_CAP (1u << 20)
__device__ __forceinline__ unsigned xb_ld(unsigned* p)              { return __hip_atomic_load(p, __ATOMIC_RELAXED, __HIP_MEMORY_SCOPE_AGENT); }
__device__ __forceinline__ unsigned xb_add(unsigned* p, unsigned v) { return __hip_atomic_fetch_add(p, v, __ATOMIC_RELAXED, __HIP_MEMORY_SCOPE_AGENT); }
__device__ __forceinline__ unsigned xb_xcc_id() { return (unsigned)__builtin_amdgcn_s_getreg((3 << 11) | 20) & 0xFu; }
#define XB_SPIN(cond, bar) do { unsigned _sp = 0; while (cond) { __builtin_amdgcn_s_sleep(1); \
    if ((++_sp & 255u) == 0u) { if (xb_ld(&(bar)[XB_TMO])) break; if (_sp > XB_SPIN_CAP) { atomicAdd(&(bar)[XB_TMO], 1u); break; } } } } while (0)
struct XcdBarrier { unsigned* bar; unsigned x; volatile LAS unsigned* st; int wave; };
__device__ __forceinline__ XcdBarrier xcd_barrier_post(unsigned* bar, volatile LAS unsigned* st, int wave) {
    XcdBarrier b; b.bar = bar; b.x = xb_xcc_id(); b.st = st; b.wave = wave;
    if (wave == 0 && lane_id() == 0) (void)xb_add(&bar[XB_XCNT(b.x)], 1u);
    return b;
}
__device__ __forceinline__ void xcd_barrier_complete(unsigned* bar, unsigned x, unsigned& nloc, unsigned& nx) {
    const unsigned G = gridDim.x * gridDim.y * gridDim.z;
    unsigned sum, cnt, mine, sp = 0u;
    for (;;) {
        sum = 0u; cnt = 0u; mine = 0u;
#pragma unroll
        for (unsigned j = 0; j < 16; ++j) { const unsigned c = xb_ld(&bar[XB_XCNT(j)]); sum += c; cnt += (c > 0u) ? 1u : 0u; mine = (j == x) ? c : mine; }
        if (sum == G) break;
        __builtin_amdgcn_s_sleep(1);
        if ((++sp & 255u) == 0u) { if (xb_ld(&bar[XB_TMO])) break; if (sp > XB_SPIN_CAP) { atomicAdd(&bar[XB_TMO], 1u); break; } }
    }
    nloc = mine > 0u ? mine : 1u; nx = cnt > 0u ? cnt : 1u;
}
__device__ __forceinline__ void xcd_barrier(const XcdBarrier& b) {
    asm volatile("s_waitcnt vmcnt(0)" ::: "memory");
    __syncthreads();
    if (b.wave == 0 && lane_id() == 0) {
        unsigned* bar = b.bar;
        __builtin_amdgcn_s_waitcnt(0);
        unsigned nloc = b.st[0], nx = b.st[1];
        if (nloc == 0u) { xcd_barrier_complete(bar, b.x, nloc, nx); b.st[0] = nloc; b.st[1] = nx; }
        const unsigned old = xb_add(&bar[XB_XSUB(b.x)], 1u);
        const unsigned gen = old / nloc;
        if (old + 1u == (gen + 1u) * nloc) {
            __builtin_amdgcn_fence(__ATOMIC_RELEASE, "agent");
            asm volatile("s_waitcnt vmcnt(0)" ::: "memory");
            const unsigned og = xb_add(&bar[XB_TOP], 1u);
            const unsigned tg = og / nx;
            if (og + 1u == (tg + 1u) * nx) xb_add(&bar[XB_TOPGEN], 1u);
            else XB_SPIN(xb_ld(&bar[XB_TOPGEN]) == tg, bar);
            __builtin_amdgcn_fence(__ATOMIC_ACQUIRE, "agent");
            xb_add(&bar[XB_XGEN(b.x)], 1u);
            asm volatile("s_waitcnt vmcnt(0)" ::: "memory");
        } else {
            XB_SPIN(xb_ld(&bar[XB_XGEN(b.x)]) == gen, bar);
            __builtin_amdgcn_fence(__ATOMIC_ACQUIRE, "agent");
            asm volatile("s_waitcnt vmcnt(0)" ::: "memory");
        }
    }
    __syncthreads();
}

namespace pg8 {
constexpr int BM = 256, BK = 64, HALF = 128, HTB = HALF * BK * 2, NXCD = 8, WGM = 8, KD = 1024, NT = KD / BK;
__host__ __device__ __forceinline__ int lds_byte(int r, int c) { const int st = (r >> 4) * 2 + (c >> 5), rr = r & 15, cc = c & 31, ob = rr * 64 + cc * 2; return st * 1024 + (ob ^ (((ob >> 9) & 1) << 5)); }
__host__ __device__ __forceinline__ void stage_rc(int b, int& R, int& C) { const int st = b / 1024, sb = b % 1024, swz = sb ^ (((sb >> 9) & 1) << 5); R = (st >> 1) * 16 + swz / 64; C = (st & 1) * 32 + (swz % 64) / 2; }
__host__ __device__ __forceinline__ int perm32(int rho) { const int n = rho >> 4, i = rho & 15; return 8 * (i >> 2) + 4 * n + (i & 3); }
__device__ __forceinline__ float clamp8(float x) { return __builtin_amdgcn_fmed3f(x, -448.0f, 448.0f); }
__device__ __forceinline__ unsigned cvt_pk_bf16(float lo, float hi) { unsigned r; asm volatile("v_cvt_pk_bf16_f32 %0, %1, %2" : "=v"(r) : "v"(lo), "v"(hi)); return r; }

typedef int v8i32 __attribute__((ext_vector_type(8)));
struct Unit { int pm, pn, e, idx; };

struct StaticOrder {
    int nM, nN, nwg, G, c;
    __device__ void init(int M, int N, int G_, int c_) { nM = M / BM; nN = N / BM; nwg = nM * nN; G = G_; c = c_; }
    __device__ bool next(int i, Unit& u) const {
        const long L = (long)i * G + c; if (L >= nwg) return false;
        int wgid = (int)L; { const int q = nwg / NXCD, r = nwg % NXCD, xcd = wgid % NXCD, off = wgid / NXCD; wgid = (xcd < r ? xcd * (q + 1) : r * (q + 1) + (xcd - r) * q) + off; }
        const int nig = WGM * nN, gid = wgid / nig, fm = gid * WGM, gsz = (nM - fm) < WGM ? (nM - fm) : WGM;
        u.pm = fm + ((wgid % nig) % gsz); u.pn = (wgid % nig) / gsz; u.e = 0; u.idx = i; return true;
    }
};

template <class P>
__device__ __forceinline__ void gemm_phase(LAS unsigned char* lds, const P& S, int wave) {
    const int wid = wave, lane = lane_id(), tid = wid * 64 + lane, wr = wid >> 2, wc = wid & 3, fr = lane & 15, fq = lane >> 4;
    constexpr int KB = P::FP8 ? 1024 : 2048, nt = KB / 128;
    int Rr[2], Cc[2]; unsigned voffB[2];
#pragma unroll
    for (int i = 0; i < 2; ++i) { int R, C; stage_rc(tid * 16 + i * 8192, R, C); const int Rb = 64 * (R >> 5) + perm32(R & 31); Rr[i] = R; Cc[i] = C; voffB[i] = (unsigned)(Rb * KB + C * 2); }
    constexpr unsigned kstep = (unsigned)(BK * 2);
    constexpr unsigned hstep = 32u * KB;
    const __amdgpu_buffer_rsrc_t rA = __builtin_amdgcn_make_buffer_rsrc((void*)S.a_ptr(), 0, 0x7fffffff, 0x00020000), rB = __builtin_amdgcn_make_buffer_rsrc((void*)S.b_ptr(), 0, 0x7fffffff, 0x00020000);
    const unsigned ldsw = (unsigned)wid * 1024u;
    const int aoff = lds_byte(wr * 64 + fr, fq * 8), boff = lds_byte(wc * 32 + fr, fq * 8);
#define PG8_SA(b, h) (((b) * 2 + (h)) * HTB)
#define PG8_SB(b, h) ((4 + (b) * 2 + (h)) * HTB)
#define PG8_STAGE(bufoff, rs, sbase, voff) do { _Pragma("unroll") for (int _i = 0; _i < 2; ++_i) \
        __builtin_amdgcn_raw_ptr_buffer_load_lds(rs, (LAS unsigned*)(lds + (bufoff) + ldsw + _i * 8192), 16, (int)(voff)[_i], (int)(sbase), 0, 0); } while (0)
#define PG8_STAGE_A(bufoff, sbase, un, h) do { _Pragma("unroll") for (int _i = 0; _i < 2; ++_i) \
        __builtin_amdgcn_raw_ptr_buffer_load_lds(rA, (LAS unsigned*)(lds + (bufoff) + ldsw + _i * 8192), 16, (int)S.a_off1(un, h, Rr[_i], Cc[_i]), (int)(sbase), 0, 0); } while (0)
#define PG8_LDA(dst, b, h) do { _Pragma("unroll") for (int m = 0; m < 4; ++m) _Pragma("unroll") for (int k = 0; k < 2; ++k) dst[m][k] = *(const LAS bf16x8*)(lds + PG8_SA(b, h) + aoff + m * 2048 + k * 1024); } while (0)
#define PG8_LDB(dst, b, h) do { _Pragma("unroll") for (int n = 0; n < 2; ++n) _Pragma("unroll") for (int k = 0; k < 2; ++k) dst[n][k] = *(const LAS bf16x8*)(lds + PG8_SB(b, h) + boff + n * 2048 + k * 1024); } while (0)
#define PG8_CAT(x) __builtin_bit_cast(v8i32, __builtin_shufflevector((x)[0], (x)[1], 0, 1, 2, 3, 4, 5, 6, 7, 8, 9, 10, 11, 12, 13, 14, 15))
#define PG8_MMA(ai, bj, At, Bt) do { __builtin_amdgcn_sched_barrier(0); __builtin_amdgcn_s_setprio(1); \
        if constexpr (P::FP8) { _Pragma("unroll") for (int m = 0; m < 4; ++m) _Pragma("unroll") for (int n = 0; n < 2; ++n) \
            acc[ai][bj][m][n] = __builtin_amdgcn_mfma_scale_f32_16x16x128_f8f6f4(PG8_CAT(Bt[n]), PG8_CAT(At[m]), acc[ai][bj][m][n], 0, 0, 0, P::SCALE_B, 0, P::SCALE_A); } \
        else { _Pragma("unroll") for (int m = 0; m < 4; ++m) _Pragma("unroll") for (int n = 0; n < 2; ++n) _Pragma("unroll") for (int k = 0; k < 2; ++k) \
            acc[ai][bj][m][n] = __builtin_amdgcn_mfma_f32_16x16x32_bf16(Bt[n][k], At[m][k], acc[ai][bj][m][n], 0, 0, 0); } \
        __builtin_amdgcn_s_setprio(0); __builtin_amdgcn_sched_barrier(0); } while (0)
#define PG8_WAIT_V(n) asm volatile("s_waitcnt vmcnt(" #n ")" ::: "memory")
#define PG8_WAIT_L(n) asm volatile("s_waitcnt lgkmcnt(" #n ")" ::: "memory")
#define PG8_BAR __builtin_amdgcn_s_barrier()
#define PG8_SCHED __builtin_amdgcn_sched_barrier(0)
    Unit cur, nxt; int ui = 0;
    if (!S.next(0, cur)) return;
    f32x4 acc[2][2][4][2];
#pragma unroll
    for (int a = 0; a < 2; ++a)
#pragma unroll
        for (int b = 0; b < 2; ++b)
#pragma unroll
            for (int m = 0; m < 4; ++m)
#pragma unroll
                for (int n = 0; n < 2; ++n) acc[a][b][m][n] = (f32x4){0.f, 0.f, 0.f, 0.f};
    bf16x8 At[4][2], B0[2][2], B1[2][2];
    unsigned cA = S.a_base(cur), cB = S.b_base(cur);
    PG8_STAGE(PG8_SB(0, 0), rB, cB, voffB); PG8_STAGE(PG8_SB(0, 1), rB, cB + hstep, voffB); PG8_STAGE_A(PG8_SA(0, 0), cA, cur, 0); PG8_STAGE_A(PG8_SA(0, 1), cA, cur, 1);
    if (wr == 1) PG8_BAR;
    PG8_WAIT_V(2); PG8_BAR;
    PG8_STAGE(PG8_SB(1, 0), rB, cB + kstep, voffB); PG8_STAGE_A(PG8_SA(1, 0), cA + kstep, cur, 0); PG8_STAGE(PG8_SB(1, 1), rB, cB + hstep + kstep, voffB);
    PG8_WAIT_V(6); PG8_BAR;
    for (;;) {
        const bool has_next = S.next(ui + 1, nxt);
        const unsigned nA = has_next ? S.a_base(nxt) : cA, nB = has_next ? S.b_base(nxt) : cB;
#pragma unroll 1
        for (int t = 0; t < nt; t += 2) {
            const bool last = (t == nt - 2);
            const unsigned a1 = cA + (unsigned)(t + 1) * kstep;
            const unsigned a2 = last ? nA : cA + (unsigned)(t + 2) * kstep, b2 = last ? nB : cB + (unsigned)(t + 2) * kstep;
            const unsigned a3 = a2 + kstep, b3 = b2 + kstep;
            Unit un2; { const bool nx_ = last && has_next; un2.pm = nx_ ? nxt.pm : cur.pm; un2.pn = nx_ ? nxt.pn : cur.pn; un2.e = nx_ ? nxt.e : cur.e; un2.idx = nx_ ? nxt.idx : cur.idx; }
            PG8_LDB(B0, 0, 0); PG8_LDB(B1, 0, 1); PG8_SCHED; PG8_LDA(At, 0, 0); PG8_STAGE_A(PG8_SA(1, 1), a1, cur, 1);
            PG8_WAIT_V(8); PG8_WAIT_L(0); PG8_BAR; PG8_MMA(0, 0, At, B0); PG8_MMA(0, 1, At, B1); PG8_BAR; PG8_SCHED;
            PG8_LDA(At, 0, 1); PG8_STAGE(PG8_SB(0, 0), rB, b2, voffB); PG8_STAGE(PG8_SB(0, 1), rB, b2 + hstep, voffB); PG8_STAGE_A(PG8_SA(0, 0), a2, un2, 0);
            PG8_WAIT_V(8); PG8_WAIT_L(0); PG8_BAR; PG8_MMA(1, 0, At, B0); PG8_MMA(1, 1, At, B1); PG8_BAR; PG8_SCHED;
            PG8_LDB(B0, 1, 0); PG8_LDB(B1, 1, 1); PG8_SCHED; PG8_LDA(At, 1, 0); PG8_STAGE_A(PG8_SA(0, 1), a2, un2, 1);
            PG8_WAIT_V(8); PG8_WAIT_L(0); PG8_BAR; PG8_MMA(0, 0, At, B0); PG8_MMA(0, 1, At, B1); PG8_BAR; PG8_SCHED;
            PG8_LDA(At, 1, 1); PG8_STAGE(PG8_SB(1, 0), rB, b3, voffB); PG8_STAGE(PG8_SB(1, 1), rB, b3 + hstep, voffB); PG8_STAGE_A(PG8_SA(1, 0), a3, un2, 0);
            PG8_WAIT_V(8); PG8_WAIT_L(0); PG8_BAR; PG8_MMA(1, 0, At, B0); PG8_MMA(1, 1, At, B1); PG8_BAR; PG8_SCHED;
        }
        if (wr == 0) PG8_BAR;
        { const int le_ = lane_id(); S.epi(acc, cur, wr, wc, le_ & 15, le_ >> 4); }
        if (!has_next) break;
#pragma unroll
        for (int a = 0; a < 2; ++a)
#pragma unroll
            for (int b = 0; b < 2; ++b)
#pragma unroll
                for (int m = 0; m < 4; ++m)
#pragma unroll
                    for (int n = 0; n < 2; ++n) acc[a][b][m][n] = (f32x4){0.f, 0.f, 0.f, 0.f};
        cur = nxt; cA = nA; cB = nB; ++ui;
        if (wr == 1) PG8_BAR;
    }
    PG8_WAIT_V(0);
    PG8_BAR;
#undef PG8_SA
#undef PG8_SB
#undef PG8_STAGE
#undef PG8_STAGE_A
#undef PG8_LDA
#undef PG8_LDB
#undef PG8_MMA
#undef PG8_CAT
#undef PG8_WAIT_V
#undef PG8_WAIT_L
#undef PG8_BAR
#undef PG8_SCHED
}
}

__device__ __forceinline__ u32x4 ror8(u32x4 v) { u32x4 r;
#pragma unroll
    for (int q = 0; q < 4; ++q) r[q] = (unsigned)__builtin_amdgcn_update_dpp(0, (int)v[q], 0x128, 0xf, 0xf, true);
    return r; }
struct PDense {
    static constexpr bool PERM = true, FP8 = false; static constexpr int SCALE_A = 0, SCALE_B = 0;
    const u16* A; const u16* Bt; u16* out; const u16* H0; float* KN; int mode; pg8::StaticOrder ord;
    __device__ __forceinline__ bool next(int i, pg8::Unit& u) const { return ord.next(i, u); }
    __device__ __forceinline__ const void* a_ptr() const { return A; }
    __device__ __forceinline__ const void* b_ptr() const { return Bt; }
    __device__ __forceinline__ unsigned a_base(const pg8::Unit& u) const { return (unsigned)u.pm * 256u * 2048u; }
    __device__ __forceinline__ unsigned b_base(const pg8::Unit& u) const { return (unsigned)u.pn * 256u * 2048u; }
    __device__ __forceinline__ unsigned a_off1(const pg8::Unit&, int h, int R, int C) const { return (unsigned)((h * 128 + R) * 1024 + C) * 2u; }
    __device__ __forceinline__ void epi(const f32x4 (&acc)[2][2][4][2], const pg8::Unit& u, int wr, int wc, int fr, int fq) const {
        const int ldc = mode == 0 ? QKVP : DM;
        const float sc = (mode == 0 && (u.pn < 2 || u.pn == 6 || u.pn == 7)) ? QSCALE : 1.0f;
        const int hh = fr >> 3, frl = fr & 7;
        const int rowb = u.pm * 256 + wr * 64, colo = u.pn * 256 + wc * 64 + 8 * fq;
        const bool knorm = (mode == 0) && (u.pn == 2 || u.pn == 3);
#pragma unroll
        for (int ai = 0; ai < 2; ++ai) {
            float cmx = 0.f;
#pragma unroll
            for (int m = 0; m < 4; ++m) {
                if (knorm) { float nr = 0.f;
#pragma unroll
                    for (int bj = 0; bj < 2; ++bj) { const f32x4 x0 = acc[ai][bj][m][0], x1 = acc[ai][bj][m][1]; nr += (x0[0] * x0[0] + x0[1] * x0[1]) + (x0[2] * x0[2] + x0[3] * x0[3]) + (x1[0] * x1[0] + x1[1] * x1[1]) + (x1[2] * x1[2] + x1[3] * x1[3]); }
                    nr += __shfl_xor(nr, 16); nr += __shfl_xor(nr, 32);
#pragma unroll
                    for (int o_ = 1; o_ < 16; o_ <<= 1) nr = fmaxf(nr, __shfl_xor(nr, o_));
                    cmx = fmaxf(cmx, nr); }
                u32x4 W[2];
#pragma unroll
                for (int bj = 0; bj < 2; ++bj) {
                    f32x4 v0 = acc[ai][bj][m][0] * sc, v1 = acc[ai][bj][m][1] * sc;
                    if (mode == 1) {
                        const u32x4 h = *(const u32x4*)(H0 + (size_t)(rowb + ai * 128 + m * 16 + fr) * DM + colo + 32 * bj);
                        v0[0] += DN_ALPHA * __uint_as_float(h.x << 16); v0[1] += DN_ALPHA * __uint_as_float(h.x & 0xffff0000u); v0[2] += DN_ALPHA * __uint_as_float(h.y << 16); v0[3] += DN_ALPHA * __uint_as_float(h.y & 0xffff0000u);
                        v1[0] += DN_ALPHA * __uint_as_float(h.z << 16); v1[1] += DN_ALPHA * __uint_as_float(h.z & 0xffff0000u); v1[2] += DN_ALPHA * __uint_as_float(h.w << 16); v1[3] += DN_ALPHA * __uint_as_float(h.w & 0xffff0000u);
                    }
                    W[bj].x = pg8::cvt_pk_bf16(v0[0], v0[1]); W[bj].y = pg8::cvt_pk_bf16(v0[2], v0[3]); W[bj].z = pg8::cvt_pk_bf16(v1[0], v1[1]); W[bj].w = pg8::cvt_pk_bf16(v1[2], v1[3]);
                }
                const u32x4 rcv = ror8(hh ? W[0] : W[1]);
                const u32x4 s1 = hh ? rcv : W[0], s2 = hh ? W[1] : rcv;
                u16* p1 = out + (size_t)(rowb + ai * 128 + m * 16 + frl) * ldc + colo + 32 * hh;
                *(u32x4*)p1 = s1; *(u32x4*)(p1 + (size_t)8 * ldc) = s2;
            }
            if (knorm && fr == 0 && fq == 0) KN[(size_t)(u.pm * 4 + ai * 2 + wr) * 8 + (u.pn - 2) * 4 + wc] = cmx;
        }
    }
};

struct MoeTab { LAS int* tb; LAS int* cn; LAS int* rowoff; };
__device__ __forceinline__ MoeTab moe_tab(LAS unsigned char* lds) { MoeTab t; t.rowoff = (LAS int*)(lds + TAB_OFF); t.tb = (LAS int*)(lds + TAB_OFF + 20480); t.cn = t.tb + 40; return t; }
__device__ __forceinline__ void moe_tables(const MoeTab& T, const int* cnt, int wave) {
    if (wave == 0 && lane_id() == 0) { int s = 0; for (int e = 0; e < NEXP; ++e) { const int c = __hip_atomic_load(cnt + e, RLX_AGENT); T.cn[e] = c; T.tb[e] = s; s += (c + 255) >> 8; } T.tb[NEXP] = s; }
    __syncthreads();
}
__device__ __forceinline__ int moe_find_e(const MoeTab& T, int RT) { int e = 0; while (e < NEXP - 1 && RT >= T.tb[e + 1]) ++e; return e; }

template <int UP>
struct PMoe {
    static constexpr bool PERM = true, FP8 = true; static constexpr int SCALE_A = UP ? 0x7c7c7c7c : 0x7d7d7d7d, SCALE_B = UP ? 0x75757575 : 0x74747474;
    static constexpr int NPN = UP ? 8 : 4, RPG = UP ? 4 : 8;
    const unsigned char* A; const unsigned char* Bt; void* out; const int* list; const float* gate; const float* bias; MoeTab T; int c, ntot;
    __device__ __forceinline__ bool next(int i, pg8::Unit& u) const {
        const int x = c & 7, s = c >> 3; const int RT = (i * 8 + x) * RPG + (s % RPG);
        if (RT >= ntot) return false;
        u.pm = RT; u.pn = s / RPG; u.e = moe_find_e(T, RT); u.idx = i; return true;
    }
    __device__ __forceinline__ const void* a_ptr() const { return A; }
    __device__ __forceinline__ const void* b_ptr() const { return Bt; }
    __device__ __forceinline__ unsigned a_base(const pg8::Unit& u) const { return UP ? 0u : (unsigned)u.pm * 256u * 1024u; }
    __device__ __forceinline__ unsigned b_base(const pg8::Unit& u) const { return ((unsigned)u.e * (UP ? 2048u : 1024u) + (unsigned)u.pn * 256u) * 1024u; }
    __device__ __forceinline__ unsigned a_off1(const pg8::Unit& u, int h, int R, int C) const { return UP ? (unsigned)T.rowoff[u.idx * 256 + h * 128 + R] + (unsigned)C * 2u : (unsigned)((h * 128 + R) * 1024 + C * 2); }
    __device__ __forceinline__ void prepare(int wave) const {
        const int tidx = wave * 64 + lane_id();
        pg8::Unit u;
        if (UP) {
            for (int i = 0; next(i, u); ++i) {
                if (tidx < 256) { const int r = (u.pm - T.tb[u.e]) * 256 + tidx; const int ent = list[(size_t)u.e * NTOK + (r < T.cn[u.e] ? r : 0)]; T.rowoff[i * 256 + tidx] = (ent >> 2) * 1024; }
            }
        } else {
            for (int i = 0; next(i, u); ++i) {
                if (tidx < 256) { const int r = (u.pm - T.tb[u.e]) * 256 + tidx; int ent = -1; float g = 0.f;
                    if (r < T.cn[u.e]) { ent = list[(size_t)u.e * NTOK + r]; g = gate[ent]; }
                    T.rowoff[i * 512 + tidx] = ent; ((LAS float*)T.rowoff)[i * 512 + 256 + tidx] = g; }
            }
        }
        __syncthreads();
    }
    __device__ __forceinline__ void epi(const f32x4 (&acc)[2][2][4][2], const pg8::Unit& u, int wr, int wc, int fr, int fq) const {
        const int colo = u.pn * 256 + wc * 64 + 8 * fq;
        if (UP) {
            const float* bp = bias + (size_t)u.e * 2048 + colo;
            f32x4 bv[2][2];
#pragma unroll
            for (int bj = 0; bj < 2; ++bj) { bv[bj][0] = *(const f32x4*)(bp + bj * 32); bv[bj][1] = *(const f32x4*)(bp + bj * 32 + 4); }
#pragma unroll
            for (int ai = 0; ai < 2; ++ai)
#pragma unroll
                for (int m = 0; m < 4; ++m) {
                    unsigned char* rowp = (unsigned char*)out + (size_t)(u.pm * 256 + wr * 64 + fr + ai * 128 + m * 16) * 1024 + (colo >> 1);
#pragma unroll
                    for (int bj = 0; bj < 2; ++bj) {
                        const f32x4 v0 = acc[ai][bj][m][0] + bv[bj][0], v1 = acc[ai][bj][m][1] + bv[bj][1];
                        float a[4];
#pragma unroll
                        for (int p = 0; p < 4; ++p) {
                            const float glu = p < 2 ? v0[2 * p] : v1[2 * p - 4], lin = p < 2 ? v0[2 * p + 1] : v1[2 * p - 3];
                            const float xg = fminf(glu, 7.0f), xl = fminf(fmaxf(lin, -7.0f), 7.0f);
                            a[p] = xg * __builtin_amdgcn_rcpf(1.0f + __builtin_amdgcn_exp2f(-1.702f * LOG2E * xg)) * (xl + 1.0f);
                        }
                        int w = __builtin_amdgcn_cvt_pk_fp8_f32(pg8::clamp8(a[0] * 4.0f), pg8::clamp8(a[1] * 4.0f), 0, false); w = __builtin_amdgcn_cvt_pk_fp8_f32(pg8::clamp8(a[2] * 4.0f), pg8::clamp8(a[3] * 4.0f), w, true);
                        *(int*)(rowp + bj * 16) = w;
                    }
                }
        } else {
            const float* bp = bias + (size_t)u.e * 1024 + colo;
            f32x4 bv[2][2];
#pragma unroll
            for (int bj = 0; bj < 2; ++bj) { bv[bj][0] = *(const f32x4*)(bp + bj * 32); bv[bj][1] = *(const f32x4*)(bp + bj * 32 + 4); }
            const int hh = fr >> 3, frl = fr & 7;
#pragma unroll
            for (int ai = 0; ai < 2; ++ai)
#pragma unroll
                for (int m = 0; m < 4; ++m) {
                    const int rlb = wr * 64 + ai * 128 + m * 16;
                    const float gt = ((LAS const float*)T.rowoff)[u.idx * 512 + 256 + rlb + fr];
                    const int e1 = T.rowoff[u.idx * 512 + rlb + frl], e2 = T.rowoff[u.idx * 512 + rlb + frl + 8];
                    u32x2 W[2];
#pragma unroll
                    for (int bj = 0; bj < 2; ++bj) {
                        const f32x4 v0 = (acc[ai][bj][m][0] + bv[bj][0]) * (gt * 64.0f), v1 = (acc[ai][bj][m][1] + bv[bj][1]) * (gt * 64.0f);
                        int w0 = __builtin_amdgcn_cvt_pk_fp8_f32(pg8::clamp8(v0[0]), pg8::clamp8(v0[1]), 0, false); w0 = __builtin_amdgcn_cvt_pk_fp8_f32(pg8::clamp8(v0[2]), pg8::clamp8(v0[3]), w0, true);
                        int w1 = __builtin_amdgcn_cvt_pk_fp8_f32(pg8::clamp8(v1[0]), pg8::clamp8(v1[1]), 0, false); w1 = __builtin_amdgcn_cvt_pk_fp8_f32(pg8::clamp8(v1[2]), pg8::clamp8(v1[3]), w1, true);
                        W[bj].x = (unsigned)w0; W[bj].y = (unsigned)w1;
                    }
                    u32x2 snd = hh ? W[0] : W[1], rcv;
                    rcv.x = (unsigned)__builtin_amdgcn_update_dpp(0, (int)snd.x, 0x128, 0xf, 0xf, true); rcv.y = (unsigned)__builtin_amdgcn_update_dpp(0, (int)snd.y, 0x128, 0xf, 0xf, true);
                    const u32x2 s1 = hh ? rcv : W[0], s2 = hh ? W[1] : rcv;
                    if (e1 >= 0) *(u32x2*)((unsigned char*)out + (size_t)e1 * 1024 + colo + 32 * hh) = s1;
                    if (e2 >= 0) *(u32x2*)((unsigned char*)out + (size_t)e2 * 1024 + colo + 32 * hh) = s2;
                }
        }
    }
};

struct Frame {
    LAS unsigned char* lds; volatile LAS unsigned* MISC; gu32* ctl; int wave, G, bid;
    __device__ __forceinline__ int tid() const { return wave * 64 + lane_id(); }
};
__device__ __forceinline__ void p0_transpose_item(const float* W, int K, int N, u16* WT, LAS float* scr, int item, int lane) {
    const int nblk = N / 32, kb = item / nblk, nb = item % nblk, k0 = 64 * kb, n0 = 32 * nb;
    f32x4 v[8];
#pragma unroll
    for (int it = 0; it < 8; ++it) v[it] = *(const f32x4*)(W + (size_t)(k0 + (lane >> 3) + 8 * it) * N + n0 + (lane & 7) * 4);
#pragma unroll
    for (int it = 0; it < 8; ++it) { const int k = (lane >> 3) + 8 * it, n4 = (lane & 7) * 4; scr[(n4 + 0) * 68 + k] = v[it].x; scr[(n4 + 1) * 68 + k] = v[it].y; scr[(n4 + 2) * 68 + k] = v[it].z; scr[(n4 + 3) * 68 + k] = v[it].w; }
    LDS_WAIT(); asm volatile("" ::: "memory");
#pragma unroll
    for (int it = 0; it < 4; ++it) {
        const int n = (lane >> 3) + 8 * it, c = lane & 7; const LAS float* s = scr + n * 68 + 8 * c;
        const f32x4 a = *(const LAS f32x4*)s, b = *(const LAS f32x4*)(s + 4);
        u32x4 o; o.x = pk2(a.x, a.y); o.y = pk2(a.z, a.w); o.z = pk2(b.x, b.y); o.w = pk2(b.z, b.w);
        *(u32x4*)(WT + (size_t)(n0 + n) * K + k0 + 8 * c) = o;
    }
    LDS_WAIT(); asm volatile("" ::: "memory");
}
__device__ __forceinline__ void p0_transpose_item_fp8(const float* W, int K, int N, unsigned char* WT, LAS float* scr, int item, int lane, float scale) {
    const int nblk = N / 32, kb = item / nblk, nb = item % nblk, k0 = 64 * kb, n0 = 32 * nb;
    f32x4 v[8];
#pragma unroll
    for (int it = 0; it < 8; ++it) v[it] = *(const f32x4*)(W + (size_t)(k0 + (lane >> 3) + 8 * it) * N + n0 + (lane & 7) * 4);
#pragma unroll
    for (int it = 0; it < 8; ++it) { const int k = (lane >> 3) + 8 * it, n4 = (lane & 7) * 4; scr[(n4 + 0) * 68 + k] = v[it].x; scr[(n4 + 1) * 68 + k] = v[it].y; scr[(n4 + 2) * 68 + k] = v[it].z; scr[(n4 + 3) * 68 + k] = v[it].w; }
    LDS_WAIT(); asm volatile("" ::: "memory");
#pragma unroll
    for (int it = 0; it < 2; ++it) {
        const int n = (lane >> 2) + 16 * it, c = lane & 3; const LAS float* s = scr + n * 68 + 16 * c;
        u32x4 o;
#pragma unroll
        for (int q = 0; q < 4; ++q) { f32x4 a = *(const LAS f32x4*)(s + 4 * q) * scale;
            a.x = fminf(fmaxf(a.x, -448.f), 448.f); a.y = fminf(fmaxf(a.y, -448.f), 448.f); a.z = fminf(fmaxf(a.z, -448.f), 448.f); a.w = fminf(fmaxf(a.w, -448.f), 448.f);
            int w = __builtin_amdgcn_cvt_pk_fp8_f32(a.x, a.y, 0, false); w = __builtin_amdgcn_cvt_pk_fp8_f32(a.z, a.w, w, true); o[q] = (unsigned)w; }
        *(u32x4*)(WT + (size_t)(n0 + n) * K + k0 + 16 * c) = o;
    }
    LDS_WAIT(); asm volatile("" ::: "memory");
}
__device__ __forceinline__ void ln_row_in(const float* xrow, const float* g, const float* b, u16* orow, int lane) {
    const f32x4* xr = (const f32x4*)xrow + lane;
    f32x4 v[4]; float s = 0.f;
#pragma unroll
    for (int j = 0; j < 4; ++j) { v[j] = xr[64 * j]; s += (v[j].x + v[j].y) + (v[j].z + v[j].w); }
    const float mean = wave_sum(s) * (1.f / DM); float s2 = 0.f;
#pragma unroll
    for (int j = 0; j < 4; ++j) { v[j] = v[j] - mean; s2 += (v[j].x * v[j].x + v[j].y * v[j].y) + (v[j].z * v[j].z + v[j].w * v[j].w); }
    const float rstd = 1.f / sqrtf(wave_sum(s2) * (1.f / DM) + LN_EPS);
    u32x2* o8 = (u32x2*)orow + lane;
#pragma unroll
    for (int j = 0; j < 4; ++j) {
        const f32x4 gg = ((const f32x4*)g)[lane + 64 * j], bb = ((const f32x4*)b)[lane + 64 * j];
        u32x2 w; w.x = pk2(v[j].x * rstd * gg.x + bb.x, v[j].y * rstd * gg.y + bb.y); w.y = pk2(v[j].z * rstd * gg.z + bb.z, v[j].w * rstd * gg.w + bb.w);
        o8[64 * j] = w;
    }
}

struct Args { const float* in[21]; float* out; unsigned char* ws; int ph_lo, ph_hi, li, pad; };

__device__ __forceinline__ void p0_prologue(const Frame& F, const Args& a) {
    unsigned char* ws = a.ws;
    u16* WIN = (u16*)(ws + WS_WIN); u16* WOUT = (u16*)(ws + WS_WOUT); unsigned char* W1T = ws + WS_W1; unsigned char* W2T = ws + WS_W2; u16* H0 = (u16*)(ws + WS_H0);
    LAS float* scr = (LAS float*)(F.lds + RING_OFF + F.wave * 8704);
    const int gw = F.bid * NWAVES + F.wave, NGW = F.G * NWAVES;
    constexpr int I_IN = 16 * 96, I_OUT = 16 * 32, I_W1 = 16 * 64, I_W2 = 16 * 32;
    constexpr int NITEMS = I_IN + I_OUT + NEXP * I_W1 + NEXP * I_W2;
    for (int it = gw; it < NITEMS; it += NGW) {
        int r = it;
        if (r < I_IN) { p0_transpose_item(a.in[3], 1024, 3072, WIN, scr, r, lane_id()); continue; } r -= I_IN;
        if (r < I_OUT) { p0_transpose_item(a.in[10], 1024, 1024, WOUT, scr, r, lane_id()); continue; } r -= I_OUT;
        if (r < NEXP * I_W1) { const int e = r / I_W1; p0_transpose_item_fp8(a.in[15] + (size_t)e * 1024 * 2048, 1024, 2048, W1T + (size_t)e * 1024 * 2048, scr, r % I_W1, lane_id(), 1024.0f); continue; } r -= NEXP * I_W1;
        { const int e = r / I_W2; p0_transpose_item_fp8(a.in[17] + (size_t)e * 1024 * 1024, 1024, 1024, W2T + (size_t)e * 1024 * 1024, scr, r % I_W2, lane_id(), 2048.0f); }
    }
    { u16* RW = (u16*)(ws + WS_RWT); const float* rw = a.in[13];
      for (int idx = F.bid * NTHR + F.tid(); idx < 32768; idx += F.G * NTHR) { const int e = idx >> 10, k = idx & 1023; const float v = rw[k * 32 + e]; const u16 hi = f2bf(v); RW[idx] = hi; RW[32768 + idx] = f2bf(v - bf2f(hi)); } }
    for (int m = gw; m < NTOK; m += NGW) ln_row_in(a.in[0] + (size_t)m * DM, a.in[1], a.in[2], H0 + (size_t)m * DM, lane_id());
}

__device__ __forceinline__ void p4_router(const Frame& F, const Args& a) {
    unsigned char* ws = a.ws;
    const u16* U = (const u16*)(ws + WS_U); u16* H1 = (u16*)(ws + WS_H1); int* LIST = (int*)(ws + WS_LIST); float* GATE = (float*)(ws + WS_GATE); int* CNT = (int*)(F.ctl + CW_CNT);
    const float* g1 = a.in[11]; const float* b1 = a.in[12]; const float* rb = a.in[14];
    const u32x4* RWT = (const u32x4*)(ws + WS_RWT);
    LAS int* lcnt = (LAS int*)(F.lds + TAB_OFF); LAS int* lbase = lcnt + 32; LAS int* ent_e = lcnt + 64; LAS int* ent_p = ent_e + 512;
    const int lane = lane_id(), tok = lane & 15, kg = lane >> 4;
    for (int i = F.tid(); i < 8192; i += NTHR) { const int img = i >> 12, e = (i >> 7) & 31, c = i & 127; *(LAS u32x4*)(F.lds + RING_OFF + img * 65536 + e * 2048 + 16 * (c ^ (e & 15))) = RWT[i]; }
    for (int batch = F.bid; batch < NTOK / 128; batch += F.G) {
        __syncthreads();
        if (F.tid() < 32) lcnt[F.tid()] = 0;
        __syncthreads();
        const int tl = F.wave * 16 + tok, t = batch * 128 + tl;
        const u32x4* ur = (const u32x4*)(U + (size_t)t * DM) + kg;
        float s1 = 0.f;
#pragma unroll 8
        for (int s = 0; s < 32; ++s) { const u32x4 w = ur[4 * s];
            s1 += (__uint_as_float(w.x << 16) + __uint_as_float(w.x & 0xffff0000u)) + (__uint_as_float(w.y << 16) + __uint_as_float(w.y & 0xffff0000u))
                + (__uint_as_float(w.z << 16) + __uint_as_float(w.z & 0xffff0000u)) + (__uint_as_float(w.w << 16) + __uint_as_float(w.w & 0xffff0000u)); }
        s1 += __shfl_xor(s1, 16); s1 += __shfl_xor(s1, 32);
        const float mean = s1 * (1.f / DM);
        float s2 = 0.f;
#pragma unroll 8
        for (int s = 0; s < 32; ++s) { const u32x4 w = ur[4 * s];
            const float d0 = __uint_as_float(w.x << 16) - mean, d1 = __uint_as_float(w.x & 0xffff0000u) - mean, d2 = __uint_as_float(w.y << 16) - mean, d3 = __uint_as_float(w.y & 0xffff0000u) - mean;
            const float d4 = __uint_as_float(w.z << 16) - mean, d5 = __uint_as_float(w.z & 0xffff0000u) - mean, d6 = __uint_as_float(w.w << 16) - mean, d7 = __uint_as_float(w.w & 0xffff0000u) - mean;
            s2 += (d0 * d0 + d1 * d1) + (d2 * d2 + d3 * d3) + (d4 * d4 + d5 * d5) + (d6 * d6 + d7 * d7); }
        s2 += __shfl_xor(s2, 16); s2 += __shfl_xor(s2, 32);
        const float rstd = 1.f / sqrtf(s2 * (1.f / DM) + LN_EPS);
        f32x4 acc[2];
        acc[0] = (f32x4){0.f, 0.f, 0.f, 0.f}; acc[1] = (f32x4){0.f, 0.f, 0.f, 0.f};
        u32x4* hr = (u32x4*)(H1 + (size_t)t * DM) + kg;
        u32x2* hq = (u32x2*)(ws + WS_H1Q + (size_t)t * DM) + kg;
        LAS const unsigned char* wimg = F.lds + RING_OFF + tok * 2048;
#pragma unroll 2
        for (int s = 0; s < 32; ++s) {
            const u32x4 w = ur[4 * s];
            const f32x4 ga = *(const f32x4*)(g1 + 32 * s + 8 * kg), gb = *(const f32x4*)(g1 + 32 * s + 8 * kg + 4), ba = *(const f32x4*)(b1 + 32 * s + 8 * kg), bb = *(const f32x4*)(b1 + 32 * s + 8 * kg + 4);
            float h[8];
            h[0] = (__uint_as_float(w.x << 16) - mean) * rstd * ga.x + ba.x; h[1] = (__uint_as_float(w.x & 0xffff0000u) - mean) * rstd * ga.y + ba.y;
            h[2] = (__uint_as_float(w.y << 16) - mean) * rstd * ga.z + ba.z; h[3] = (__uint_as_float(w.y & 0xffff0000u) - mean) * rstd * ga.w + ba.w;
            h[4] = (__uint_as_float(w.z << 16) - mean) * rstd * gb.x + bb.x; h[5] = (__uint_as_float(w.z & 0xffff0000u) - mean) * rstd * gb.y + bb.y;
            h[6] = (__uint_as_float(w.w << 16) - mean) * rstd * gb.z + bb.z; h[7] = (__uint_as_float(w.w & 0xffff0000u) - mean) * rstd * gb.w + bb.w;
            u32x4 hh, hl;
            hh.x = pk2(h[0], h[1]); hh.y = pk2(h[2], h[3]); hh.z = pk2(h[4], h[5]); hh.w = pk2(h[6], h[7]);
            hr[4 * s] = hh;
            { u32x2 q8; int w0 = __builtin_amdgcn_cvt_pk_fp8_f32(pg8::clamp8(h[0] * 8.0f), pg8::clamp8(h[1] * 8.0f), 0, false); w0 = __builtin_amdgcn_cvt_pk_fp8_f32(pg8::clamp8(h[2] * 8.0f), pg8::clamp8(h[3] * 8.0f), w0, true);
              int w1 = __builtin_amdgcn_cvt_pk_fp8_f32(pg8::clamp8(h[4] * 8.0f), pg8::clamp8(h[5] * 8.0f), 0, false); w1 = __builtin_amdgcn_cvt_pk_fp8_f32(pg8::clamp8(h[6] * 8.0f), pg8::clamp8(h[7] * 8.0f), w1, true); q8.x = (unsigned)w0; q8.y = (unsigned)w1; hq[4 * s] = q8; }
            hl.x = pk2(h[0] - __uint_as_float(hh.x << 16), h[1] - __uint_as_float(hh.x & 0xffff0000u)); hl.y = pk2(h[2] - __uint_as_float(hh.y << 16), h[3] - __uint_as_float(hh.y & 0xffff0000u));
            hl.z = pk2(h[4] - __uint_as_float(hh.z << 16), h[5] - __uint_as_float(hh.z & 0xffff0000u)); hl.w = pk2(h[6] - __uint_as_float(hh.w << 16), h[7] - __uint_as_float(hh.w & 0xffff0000u));
            const bf16x8 bh = __builtin_bit_cast(bf16x8, hh), bl = __builtin_bit_cast(bf16x8, hl);
            const unsigned co = 16u * ((unsigned)(4 * s + kg) ^ (unsigned)tok);
#pragma unroll
            for (int eh = 0; eh < 2; ++eh) {
                const bf16x8 wh = *(const LAS bf16x8*)(wimg + eh * 32768 + co), wl = *(const LAS bf16x8*)(wimg + 65536 + eh * 32768 + co);
                acc[eh] = __builtin_amdgcn_mfma_f32_16x16x32_bf16(wh, bh, acc[eh], 0, 0, 0);
                acc[eh] = __builtin_amdgcn_mfma_f32_16x16x32_bf16(wl, bh, acc[eh], 0, 0, 0);
                acc[eh] = __builtin_amdgcn_mfma_f32_16x16x32_bf16(wh, bl, acc[eh], 0, 0, 0);
            }
        }
        float lg[8];
#pragma unroll
        for (int eh = 0; eh < 2; ++eh)
#pragma unroll
            for (int r = 0; r < 4; ++r) lg[eh * 4 + r] = acc[eh][r] + rb[16 * eh + 4 * kg + r];
        unsigned used = 0u; float tv[4]; int ti[4];
#pragma unroll
        for (int k = 0; k < 4; ++k) {
            float best = -INFINITY; int bi = 1 << 20;
#pragma unroll
            for (int j = 0; j < 8; ++j) { const int e = 16 * (j >> 2) + 4 * kg + (j & 3); const bool ok = !((used >> j) & 1u) && (lg[j] > best || (lg[j] == best && e < bi)); best = ok ? lg[j] : best; bi = ok ? e : bi; }
#pragma unroll
            for (int off = 16; off <= 32; off <<= 1) { const float ov = __shfl_xor(best, off); const int oi = __shfl_xor(bi, off); const bool tk = ov > best || (ov == best && oi < bi); best = tk ? ov : best; bi = tk ? oi : bi; }
            tv[k] = best; ti[k] = bi;
#pragma unroll
            for (int j = 0; j < 8; ++j) { const int e = 16 * (j >> 2) + 4 * kg + (j & 3); if (e == bi) used |= 1u << j; }
        }
        const float e1 = __expf(tv[1] - tv[0]), e2 = __expf(tv[2] - tv[0]), e3 = __expf(tv[3] - tv[0]);
        const float inv = 1.f / (1.f + e1 + e2 + e3);
        {
            const int me = kg == 0 ? ti[0] : kg == 1 ? ti[1] : kg == 2 ? ti[2] : ti[3];
            const float mg = (kg == 0 ? 1.f : kg == 1 ? e1 : kg == 2 ? e2 : e3) * inv;
            const int pos = __hip_atomic_fetch_add(lcnt + me, 1, __ATOMIC_RELAXED, __HIP_MEMORY_SCOPE_WORKGROUP);
            ent_e[tl * 4 + kg] = me; ent_p[tl * 4 + kg] = pos; GATE[t * 4 + kg] = mg;
        }
        __syncthreads();
        if (F.tid() < 32) lbase[F.tid()] = atomicAdd(CNT + F.tid(), lcnt[F.tid()]);
        __syncthreads();
        { const int e = ent_e[F.tid()]; LIST[(size_t)e * NTOK + lbase[e] + ent_p[F.tid()]] = (batch * 128 + (F.tid() >> 2)) * 4 + (F.tid() & 3); }
    }
}

__device__ __forceinline__ void p7_final(const Frame& F, const Args& a) {
    const u16* H1 = (const u16*)(a.ws + WS_H1); const unsigned char* YS = a.ws + WS_YS; const float* g2 = a.in[19]; const float* b2 = a.in[20];
    const int lane = lane_id(), gw = F.bid * NWAVES + F.wave, NGW = F.G * NWAVES;
    typedef float f32x2 __attribute__((ext_vector_type(2)));
    for (int t = gw; t < NTOK; t += NGW) {
        float v[16]; float s = 0.f;
        unsigned y[4][4];
#pragma unroll
        for (int k = 0; k < 4; ++k)
#pragma unroll
            for (int j = 0; j < 4; ++j) y[k][j] = ((const unsigned*)(YS + ((size_t)t * 4 + k) * DM) + lane)[64 * j];
#pragma unroll
        for (int j = 0; j < 4; ++j) {
            const u32x2 w = ((const u32x2*)(H1 + (size_t)t * DM) + lane)[64 * j];
            float a0 = 0.f, a1 = 0.f, a2 = 0.f, a3 = 0.f;
#pragma unroll
            for (int k = 0; k < 4; ++k) {
                const f32x2 lo = __builtin_amdgcn_cvt_pk_f32_fp8((int)y[k][j], false), hi = __builtin_amdgcn_cvt_pk_f32_fp8((int)y[k][j], true);
                a0 += lo.x; a1 += lo.y; a2 += hi.x; a3 += hi.y;
            }
            a0 = fmaf(a0, 1.0f / 64.0f, DN_ALPHA * __uint_as_float(w.x << 16)); a1 = fmaf(a1, 1.0f / 64.0f, DN_ALPHA * __uint_as_float(w.x & 0xffff0000u));
            a2 = fmaf(a2, 1.0f / 64.0f, DN_ALPHA * __uint_as_float(w.y << 16)); a3 = fmaf(a3, 1.0f / 64.0f, DN_ALPHA * __uint_as_float(w.y & 0xffff0000u));
            v[4 * j] = a0; v[4 * j + 1] = a1; v[4 * j + 2] = a2; v[4 * j + 3] = a3; s += (a0 + a1) + (a2 + a3);
        }
        const float mean = wave_sum(s) * (1.f / DM); float s2 = 0.f;
#pragma unroll
        for (int i = 0; i < 16; ++i) { v[i] -= mean; s2 += v[i] * v[i]; }
        const float rstd = 1.f / sqrtf(wave_sum(s2) * (1.f / DM) + LN_EPS);
        f32x4* o = (f32x4*)(a.out + (size_t)t * DM) + lane;
#pragma unroll
        for (int j = 0; j < 4; ++j) {
            const f32x4 gg = ((const f32x4*)g2)[lane + 64 * j], bb = ((const f32x4*)b2)[lane + 64 * j];
            o[64 * j] = (f32x4){v[4 * j] * rstd * gg.x + bb.x, v[4 * j + 1] * rstd * gg.y + bb.y, v[4 * j + 2] * rstd * gg.z + bb.z, v[4 * j + 3] * rstd * gg.w + bb.w};
        }
    }
}


namespace att {
typedef float f32x16 __attribute__((ext_vector_type(16)));
typedef short s16x4 __attribute__((ext_vector_type(4)));
typedef short v4i16_t __attribute__((ext_vector_type(4)));
constexpr int KV_BUF = 32768, X_OFF = 65536, WSF_OFF = TAB_OFF, TBL_OFF = TAB_OFF + 2048;
constexpr float THR = 6.0f;
constexpr int SFX_OFF = TAB_OFF + 8192, DONE_OFF = TAB_OFF + 8192 + 2048;
__device__ __forceinline__ int crow(int r, int hi) { return (r & 3) + 8 * (r >> 2) + 4 * hi; }
__device__ __forceinline__ unsigned cvtpk(float lo, float hi) { typedef float f2 __attribute__((ext_vector_type(2))); typedef __bf16 b2 __attribute__((ext_vector_type(2))); f2 v = {lo, hi}; b2 b = __builtin_convertvector(v, b2); return __builtin_bit_cast(unsigned, b); }
__device__ __forceinline__ s16x4 vtr(LAS const unsigned char* p) { return __builtin_bit_cast(s16x4, __builtin_amdgcn_ds_read_tr16_b64_v4i16((LAS v4i16_t*)p)); }
__device__ __forceinline__ float swapmax(float m) { auto rr = __builtin_amdgcn_permlane32_swap(__float_as_uint(m), __float_as_uint(m), false, false); return fmaxf(__uint_as_float(rr[0]), __uint_as_float(rr[1])); }
__device__ __forceinline__ float swapsum(float m) { auto rr = __builtin_amdgcn_permlane32_swap(__float_as_uint(m), __float_as_uint(m), false, false); return __uint_as_float(rr[0]) + __uint_as_float(rr[1]); }

template <bool ISA>
__device__ __forceinline__ void attn_unit(const Frame& F, const u16* QKV, u16* O, int b, int hx, int jq, float lam, const float* subg, const float* relb, const float* KN) {
    constexpr int DVB = ISA ? 4 : 2;
    const int lane = lane_id(), w = F.wave, sub = w >> 2, rg = w & 3, r32 = lane & 31, hi = lane >> 5;
    const int q0 = jq * 128, cq = 2 * jq + (rg >> 1);
    const int qpos = q0 + rg * 32 + r32;
    const size_t tok0 = (size_t)b * SEQ;
    const int qcol = (ISA ? hx * 128 : 1536 + hx * 128) + sub * 64;
    const int kcol0 = ISA ? 512 + hx * 128 : 2048 + hx * 128, vcol0 = ISA ? 1024 + hx * 128 : 2560 + hx * 128;
    const int ktop = 2 * jq + 1, kbot = ISA ? 0 : (2 * jq - 8 > 0 ? 2 * jq - 8 : 0);
    const int NTs = ktop - kbot + 1;
    LAS unsigned char* lds = F.lds;
    unsigned soff[2];
#pragma unroll
    for (int i = 0; i < 2; ++i) { const unsigned row = 4u * (8u * i + w) + (lane >> 4); const unsigned f = ((row & 3u) << 2) | ((row >> 2) & 3u); soff[i] = row * (QKVP * 2) + (((unsigned)lane & 15u) ^ f) * 16u; }
    const char* kvbase = (const char*)QKV + (tok0 * QKVP + kcol0) * 2;
    const unsigned ldsw = (unsigned)w * 1024u;
#define ATT_ISSUE(kt, buf) do { const char* kb_ = kvbase + (size_t)(kt) * 64 * QKVP * 2; const char* vb_ = kb_ + (vcol0 - kcol0) * 2; \
        _Pragma("unroll") for (int i_ = 0; i_ < 2; ++i_) { \
            __builtin_amdgcn_global_load_lds((const unsigned*)(kb_ + soff[i_]), (LAS unsigned*)(lds + (buf) * KV_BUF + i_ * 8192 + ldsw), 16, 0, 0); \
            __builtin_amdgcn_global_load_lds((const unsigned*)(vb_ + soff[i_]), (LAS unsigned*)(lds + (buf) * KV_BUF + 16384 + i_ * 8192 + ldsw), 16, 0, 0); } } while (0)
    ATT_ISSUE(ktop, 0);
    if (!ISA) {
        LAS float* tbl = (LAS float*)(lds + TBL_OFF);
        for (int i = F.tid(); i < 1280; i += NTHR) { const int hd = i / 640, idx = i % 640; int rel = idx - 64; rel = rel < -256 ? -256 : (rel > 256 ? 256 : rel); tbl[i] = relb[(2 * hx + hd) * 513 + rel + 256] * LOG2E; }
    }
    bf16x8 qf[4];
    { const u16* qp = QKV + (tok0 + q0 + rg * 32 + r32) * QKVP + qcol + 8 * hi;
#pragma unroll
      for (int s = 0; s < 4; ++s) qf[s] = *(const bf16x8*)(qp + 16 * s); }
    const unsigned fr_ = ((r32 & 3u) << 2) | ((r32 >> 2) & 3u);
    unsigned kad[4];
#pragma unroll
    for (int s = 0; s < 4; ++s) kad[s] = 256u * r32 + 16u * ((8u * sub + 2u * s + hi) ^ fr_);
    const unsigned qd = (lane & 15) >> 2, pd = lane & 3, blk = (lane >> 4) & 1, xlow = 2 * blk + (pd >> 1);
    unsigned vad[DVB][2];
#pragma unroll
    for (int c = 0; c < DVB; ++c)
#pragma unroll
        for (int t = 0; t < 2; ++t) { const unsigned ci = ISA ? (unsigned)c : (unsigned)(2 * sub + c);
            vad[c][t] = 2048u * t + 256u * (4u * hi + qd) + 64u * (ci ^ qd) + 16u * (xlow ^ ((2u * t + hi) & 3u)) + 8u * (pd & 1u); }
    const float sl2 = ISA ? exp2f(-2.0f * (float)(hx + 1)) * LOG2E : 0.f;
    LAS float* wsf = (LAS float*)(lds + WSF_OFF) + w * 64;
    float mrun = -INFINITY, lrun = 0.f;
    LAS float* sfx = (LAS float*)(lds + SFX_OFF) + w * 64;
    LAS int* donecnt = (LAS int*)(lds + DONE_OFF);
    bool wdone = false; float mlow = INFINITY;
    if (ISA) {
        float qq = 0.f;
#pragma unroll
        for (int s = 0; s < 4; ++s)
#pragma unroll
            for (int j = 0; j < 8; ++j) { const float x = bf2f((u16)qf[s][j]); qq = fmaf(x, x, qq); }
        qq = swapsum(qq);
#pragma unroll
        for (int o_ = 1; o_ < 32; o_ <<= 1) qq = fmaxf(qq, __shfl_xor(qq, o_));
        float kn = (lane <= ktop) ? KN[((size_t)b * 64 + lane) * 8 + hx * 2 + sub] : 0.f;
#pragma unroll
        for (int o_ = 1; o_ < 64; o_ <<= 1) { const float t_ = __shfl_up(kn, o_); if (lane >= o_) kn = fmaxf(kn, t_); }
        sfx[lane] = sqrtf(qq * kn) * 1.02f;
        if (w == 0 && lane < 3) donecnt[lane] = 0;
    }
    f32x16 o[DVB];
#pragma unroll
    for (int c = 0; c < DVB; ++c)
#pragma unroll
        for (int r = 0; r < 16; ++r) o[c][r] = 0.f;

    for (int i = 0; i < NTs; ++i) {
        const int kt = ktop - i, buf = i & 1;
        asm volatile("s_waitcnt vmcnt(0)" ::: "memory");
        __syncthreads();
        if (ISA) { if (i > 0 && __builtin_amdgcn_readfirstlane(donecnt[(i - 1) % 3]) == 8) break;
                   if (w == 0 && lane == 0) donecnt[(i + 1) % 3] = 0; }
        if (i + 1 < NTs) ATT_ISSUE(kt - 1, buf ^ 1);
        bool active = ISA ? (kt <= cq) : (kt <= cq && kt >= cq - 8);
        if (ISA && active && !wdone && kt < cq) {
            const float bnd = sfx[kt] + sl2 * (float)(kt * 64 + 63 - (q0 + rg * 32)) - mlow;
            if (bnd < -150.0f) wdone = true;
        }
        if (ISA && wdone) { active = false; if (lane == 0) __hip_atomic_fetch_add(donecnt + (i % 3), 1, __ATOMIC_RELAXED, __HIP_MEMORY_SCOPE_WORKGROUP); }
        if (active) {
            LAS const unsigned char* kbuf = lds + buf * KV_BUF; LAS const unsigned char* vbuf = kbuf + 16384;
            f32x16 p0, p1;
#pragma unroll
            for (int r = 0; r < 16; ++r) { p0[r] = 0.f; p1[r] = 0.f; }
#pragma unroll
            for (int s = 0; s < 4; ++s) {
                const bf16x8 k0 = *(const LAS bf16x8*)(kbuf + kad[s]);
                const bf16x8 k1 = *(const LAS bf16x8*)(kbuf + kad[s] + 8192);
                p0 = __builtin_amdgcn_mfma_f32_32x32x16_bf16(k0, qf[s], p0, 0, 0, 0);
                p1 = __builtin_amdgcn_mfma_f32_32x32x16_bf16(k1, qf[s], p1, 0, 0, 0);
            }
            if (ISA) {
                const float dl = (float)(kt * 64 + 4 * hi - qpos);
#pragma unroll
                for (int r = 0; r < 16; ++r) { const float kc = (float)((r & 3) + 8 * (r >> 2)); p0[r] = fmaf(-sl2, fabsf(dl + kc), p0[r]); p1[r] = fmaf(-sl2, fabsf(dl + kc + 32.0f), p1[r]); }
            } else {
                LAS const float* tb = (LAS const float*)(lds + TBL_OFF) + sub * 640 + (qpos + 64 - kt * 64 - 4 * hi - 63);
#pragma unroll
                for (int r = 0; r < 16; ++r) { const int kc = (r & 3) + 8 * (r >> 2); p0[r] += tb[63 - kc]; p1[r] += tb[63 - 32 - kc]; }
            }
            float mx = fmaxf(p0[0], p1[0]);
#pragma unroll
            for (int r = 1; r < 16; ++r) mx = fmaxf(mx, fmaxf(p0[r], p1[r]));
            const float mt = swapmax(mx);
            if (__any(mt > mrun + THR)) {
                const float mnew = fmaxf(mrun, mt), alpha = __builtin_amdgcn_exp2f(mrun - mnew);
                lrun *= alpha; mrun = mnew;
                if (ISA) { float ml = mrun;
#pragma unroll
                    for (int o_ = 1; o_ < 32; o_ <<= 1) ml = fminf(ml, __shfl_xor(ml, o_));
                    mlow = ml; }
                if (hi == 0) wsf[r32] = alpha;
#pragma unroll
                for (int r = 0; r < 16; ++r) { const float a_ = wsf[crow(r, hi)];
#pragma unroll
                    for (int c = 0; c < DVB; ++c) o[c][r] *= a_; }
            }
            float ps = 0.f;
#pragma unroll
            for (int r = 0; r < 16; ++r) { p0[r] = __builtin_amdgcn_exp2f(p0[r] - mrun); p1[r] = __builtin_amdgcn_exp2f(p1[r] - mrun); ps += p0[r] + p1[r]; }
            lrun += ps;
            u32x4 pw[4];
#pragma unroll
            for (int q = 0; q < 4; ++q) { pw[0][q] = cvtpk(p0[2 * q], p0[2 * q + 1]); pw[1][q] = cvtpk(p0[8 + 2 * q], p0[8 + 2 * q + 1]); pw[2][q] = cvtpk(p1[2 * q], p1[2 * q + 1]); pw[3][q] = cvtpk(p1[8 + 2 * q], p1[8 + 2 * q + 1]); }
#pragma unroll
            for (int c = 0; c < DVB; ++c)
#pragma unroll
                for (int ks = 0; ks < 4; ++ks) {
                    const s16x4 lo = vtr(vbuf + vad[c][0] + 4096 * ks), h4 = vtr(vbuf + vad[c][1] + 4096 * ks);
                    const bf16x8 vf = (bf16x8){lo[0], lo[1], lo[2], lo[3], h4[0], h4[1], h4[2], h4[3]};
                    o[c] = __builtin_amdgcn_mfma_f32_32x32x16_bf16(__builtin_bit_cast(bf16x8, pw[ks]), vf, o[c], 0, 0, 0);
                }
        }
    }
    asm volatile("s_waitcnt vmcnt(0)" ::: "memory");
    { const float lt = swapsum(lrun); const float inv = 1.0f / lt;
      if (hi == 0) wsf[r32] = inv;
#pragma unroll
      for (int r = 0; r < 16; ++r) { const float a_ = wsf[crow(r, hi)];
#pragma unroll
          for (int c = 0; c < DVB; ++c) o[c][r] *= a_; } }
    __syncthreads();
    if (ISA) {
        LAS float* X = (LAS float*)(lds + X_OFF) + rg * 4096;
        if (sub == 1) {
#pragma unroll
            for (int c = 0; c < 4; ++c)
#pragma unroll
                for (int r = 0; r < 16; ++r) X[(c * 16 + r) * 64 + lane] = o[c][r];
        }
        __syncthreads();
        if (sub == 0) {
            float ss[16];
#pragma unroll
            for (int r = 0; r < 16; ++r) ss[r] = 0.f;
#pragma unroll
            for (int c = 0; c < 4; ++c)
#pragma unroll
                for (int r = 0; r < 16; ++r) { const float y = o[c][r] - lam * X[(c * 16 + r) * 64 + lane]; o[c][r] = y; ss[r] += y * y; }
#pragma unroll
            for (int r = 0; r < 16; ++r) {
                float v = ss[r];
                v += __shfl_xor(v, 1); v += __shfl_xor(v, 2); v += __shfl_xor(v, 4); v += __shfl_xor(v, 8); v += __shfl_xor(v, 16);
                ss[r] = 0.8f / sqrtf(v * (1.0f / 128.0f) + 1e-5f);
            }
            float gg[4];
#pragma unroll
            for (int c = 0; c < 4; ++c) gg[c] = subg[32 * c + r32];
            LAS u16* stg = (LAS u16*)(lds + X_OFF + rg * 16384);
            asm volatile("s_waitcnt lgkmcnt(0)" ::: "memory");
#pragma unroll
            for (int c = 0; c < 4; ++c)
#pragma unroll
                for (int r = 0; r < 16; ++r) stg[crow(r, hi) * 128 + 32 * c + r32] = f2bf(o[c][r] * ss[r] * gg[c]);
            asm volatile("s_waitcnt lgkmcnt(0)" ::: "memory");
            u16* og = O + (tok0 + q0 + rg * 32) * DM + hx * 128;
#pragma unroll
            for (int i = 0; i < 8; ++i) { const int row = 4 * i + (lane >> 4), ch = lane & 15; const u32x4 v = *(const LAS u32x4*)((LAS const unsigned char*)stg + row * 256 + ch * 16); *(u32x4*)(og + (size_t)row * DM + ch * 8) = v; }
        }
    } else {
        LAS u16* stg = (LAS u16*)(lds + X_OFF + w * 4096);
#pragma unroll
        for (int c = 0; c < 2; ++c)
#pragma unroll
            for (int r = 0; r < 16; ++r) stg[crow(r, hi) * 64 + 32 * c + r32] = f2bf(o[c][r]);
        asm volatile("s_waitcnt lgkmcnt(0)" ::: "memory");
        u16* og = O + (tok0 + q0 + rg * 32) * DM + 512 + (2 * hx + sub) * 64;
#pragma unroll
        for (int i = 0; i < 4; ++i) { const int row = 8 * i + (lane >> 3), ch = lane & 7; const u32x4 v = *(const LAS u32x4*)((LAS const unsigned char*)stg + row * 128 + ch * 16); *(u32x4*)(og + (size_t)row * DM + ch * 8) = v; }
    }
    __syncthreads();
#undef ATT_ISSUE
}

__device__ __forceinline__ void p2_attention(const Frame& F, const Args& a) {
    const u16* QKV = (const u16*)(a.ws + WS_QKV); u16* O = (u16*)(a.ws + WS_O); const float* KN = (const float*)(a.ws + WS_KN);
    float d1 = 0.f, d2 = 0.f;
    for (int i = 0; i < 64; ++i) { d1 += a.in[4][i] * a.in[5][i]; d2 += a.in[6][i] * a.in[7][i]; }
    const float lam = expf(d1) - expf(d2) + 0.2f;
    int* Q = (int*)(F.ctl + CW_Q) + 64 * (F.bid & 7);
    volatile LAS int* slot = (volatile LAS int*)(F.lds + MISC_OFF + 128);
    const int b = F.bid & 7;
    for (;;) {
        if (F.tid() == 0) *slot = atomicAdd(Q, 1);
        __syncthreads();
        const int idx = __builtin_amdgcn_readfirstlane(*slot);
        __syncthreads();
        if (idx >= 256) break;
        if (idx < 64) attn_unit<true>(F, QKV, O, b, 3 - (idx & 1), 31 - (idx >> 1), lam, a.in[8], a.in[9], KN);
        else if (idx < 96) attn_unit<true>(F, QKV, O, b, 1, 31 - (idx - 64), lam, a.in[8], a.in[9], KN);
        else if (idx < 128) attn_unit<true>(F, QKV, O, b, 0, 31 - (idx - 96), lam, a.in[8], a.in[9], KN);
        else { const int i2 = idx - 128; attn_unit<false>(F, QKV, O, b, i2 & 3, 31 - (i2 >> 2), lam, a.in[8], a.in[9], KN); }
    }
}
}
#ifndef REP_MASK
#define REP_MASK 0
#endif
__global__ void __launch_bounds__(NTHR, 2) mk_fwd(Args args) {
    extern __shared__ __attribute__((aligned(16))) unsigned char lds_raw[];
    Frame F;
    F.lds = (LAS unsigned char*)lds_raw; F.MISC = (volatile LAS unsigned*)(F.lds + MISC_OFF);
    F.wave = __builtin_amdgcn_readfirstlane((int)threadIdx.x >> 6); F.G = gridDim.x; F.bid = blockIdx.x;
    F.ctl = (gu32*)(args.ws + WS_CTL);
    for (int u = F.tid(); u < 256; u += NTHR) ((LAS unsigned*)(F.lds + MISC_OFF))[u] = 0u;
    __syncthreads();
    const int lo = args.ph_lo, hi = args.ph_hi;
    const bool multi = (hi - lo) > 1;
    XcdBarrier bar; bar.bar = (unsigned*)(F.ctl + CW_BAR) + args.li * XCD_BAR_WORDS; bar.x = 0; bar.st = nullptr; bar.wave = F.wave;
    if (multi) bar = xcd_barrier_post((unsigned*)(F.ctl + CW_BAR) + args.li * XCD_BAR_WORDS, F.MISC + 8, F.wave);
#if defined(MEAS_PHASE)
    unsigned long long tp0_ = 0;
#define MEAS_T0() do { tp0_ = __builtin_amdgcn_s_memrealtime(); } while (0)
#define MEAS_T1(k) do { if (MEAS_PHASE == (k) && F.wave == 0 && lane_id() == 0) ((volatile LAS unsigned*)(F.lds + MISC_OFF))[16] += (unsigned)(__builtin_amdgcn_s_memrealtime() - tp0_); } while (0)
#else
#define MEAS_T0() do {} while (0)
#define MEAS_T1(k) do {} while (0)
#endif
#define IN(k) (lo <= (k) && (k) < hi)
#define SEAM(k) do { if (IN(k) && IN((k) + 1)) xcd_barrier(bar); } while (0)
    unsigned char* ws = args.ws;
    if (IN(0)) { MEAS_T0(); p0_prologue(F, args); if (REP_MASK & 1) p0_prologue(F, args); MEAS_T1(0); SEAM(0); }
    if (IN(1)) {
        MEAS_T0();
        PDense S; S.A = (const u16*)(ws + WS_H0); S.Bt = (const u16*)(ws + WS_WIN); S.out = (u16*)(ws + WS_QKV); S.H0 = nullptr; S.KN = (float*)(ws + WS_KN); S.mode = 0; S.ord.init(NTOK, QKVP, F.G, F.bid);
        pg8::gemm_phase(F.lds + RING_OFF, S, F.wave); if (REP_MASK & 2) pg8::gemm_phase(F.lds + RING_OFF, S, F.wave); MEAS_T1(1); SEAM(1);
    }
    if (IN(2)) {
        MEAS_T0(); att::p2_attention(F, args); MEAS_T1(2);
        SEAM(2); }
    if (IN(3)) {
        MEAS_T0();
        PDense S; S.A = (const u16*)(ws + WS_O); S.Bt = (const u16*)(ws + WS_WOUT); S.out = (u16*)(ws + WS_U); S.H0 = (const u16*)(ws + WS_H0); S.KN = nullptr; S.mode = 1; S.ord.init(NTOK, DM, F.G, F.bid);
        pg8::gemm_phase(F.lds + RING_OFF, S, F.wave); if (REP_MASK & 8) pg8::gemm_phase(F.lds + RING_OFF, S, F.wave); MEAS_T1(3); SEAM(3);
    }
    if (IN(4)) { MEAS_T0(); p4_router(F, args); MEAS_T1(4); SEAM(4); }
    if (IN(5)) {
        MEAS_T0();
        const MoeTab T = moe_tab(F.lds); moe_tables(T, (const int*)(F.ctl + CW_CNT), F.wave);
        PMoe<1> S; S.A = ws + WS_H1Q; S.Bt = ws + WS_W1; S.out = (void*)(ws + WS_ACT); S.list = (const int*)(ws + WS_LIST); S.gate = nullptr; S.bias = args.in[16]; S.T = T; S.c = F.bid; S.ntot = __builtin_amdgcn_readfirstlane(T.tb[NEXP]);
        S.prepare(F.wave);
        pg8::gemm_phase(F.lds + RING_OFF, S, F.wave); if (REP_MASK & 32) pg8::gemm_phase(F.lds + RING_OFF, S, F.wave); MEAS_T1(5); SEAM(5);
    }
    if (IN(6)) {
        MEAS_T0();
        const MoeTab T = moe_tab(F.lds); moe_tables(T, (const int*)(F.ctl + CW_CNT), F.wave);
        PMoe<0> S; S.A = ws + WS_ACT; S.Bt = ws + WS_W2; S.out = (void*)(ws + WS_YS); S.list = (const int*)(ws + WS_LIST); S.gate = (const float*)(ws + WS_GATE); S.bias = args.in[18]; S.T = T; S.c = F.bid; S.ntot = __builtin_amdgcn_readfirstlane(T.tb[NEXP]);
        S.prepare(F.wave);
        pg8::gemm_phase(F.lds + RING_OFF, S, F.wave); if (REP_MASK & 64) pg8::gemm_phase(F.lds + RING_OFF, S, F.wave); MEAS_T1(6); SEAM(6);
    }
    if (IN(7)) { MEAS_T0(); p7_final(F, args); if (REP_MASK & 128) p7_final(F, args); MEAS_T1(7); }
#if defined(MEAS_PHASE)
    { __syncthreads(); const unsigned acc_ = ((volatile LAS unsigned*)(F.lds + MISC_OFF))[16]; const unsigned long long t0_ = __builtin_amdgcn_s_memrealtime();
      while (__builtin_amdgcn_s_memrealtime() - t0_ < (unsigned long long)acc_ * MEAS_MUL) __builtin_amdgcn_s_sleep(16); }
#endif
#undef IN
#undef SEAM
}

extern "C" void kernel_launch(void* const* d_in, const int* in_sizes, int n_in, void* d_out, int out_size, void* d_ws, size_t ws_size, hipStream_t stream) {
    static int grid = 0;
    if (grid == 0) {
        if (n_in != 21 || in_sizes[0] != NTOK * DM || out_size != NTOK * DM || ws_size < WS_END) { fprintf(stderr, "kernel_launch: unexpected shapes / workspace (%d inputs, ws %zu)\n", n_in, ws_size); grid = -1; return; }
        int dev = 0, cus = 0, per_cu = 0;
        if (hipGetDevice(&dev) != hipSuccess || hipDeviceGetAttribute(&cus, hipDeviceAttributeMultiprocessorCount, dev) != hipSuccess) { grid = -1; return; }
        if (hipFuncSetAttribute((const void*)mk_fwd, hipFuncAttributeMaxDynamicSharedMemorySize, LDS_BYTES) != hipSuccess) { fprintf(stderr, "kernel_launch: hipFuncSetAttribute failed\n"); grid = -1; return; }
        if (hipOccupancyMaxActiveBlocksPerMultiprocessor(&per_cu, (const void*)mk_fwd, NTHR, LDS_BYTES) != hipSuccess || per_cu < 1) { fprintf(stderr, "kernel_launch: occupancy query says %d blocks per CU\n", per_cu); (void)hipGetLastError(); grid = -1; return; }
        if (cus < 256) { fprintf(stderr, "kernel_launch: needs 256 CUs, device has %d\n", cus); grid = -1; return; }
        grid = 256;
    }
    if (grid < 0) return;
    const float* lq1 = (const float*)d_in[4]; const float* lk1 = (const float*)d_in[5]; const float* lq2 = (const float*)d_in[6]; const float* lk2 = (const float*)d_in[7];
    const float* subg = (const float*)d_in[8]; const float* relb = (const float*)d_in[9];
    char* ws = (char*)d_ws;
    u16* QKV = (u16*)(ws + WS_QKV); u16* O = (u16*)(ws + WS_O);
    (void)hipMemsetAsync(ws + WS_CTL, 0, CTL_BYTES, stream);
    Args a{};
    for (int i = 0; i < 21; ++i) a.in[i] = (const float*)d_in[i];
    a.out = (float*)d_out; a.ws = (unsigned char*)d_ws;
    int nl = 0;
    auto run = [&](int lo, int hi) { a.ph_lo = lo; a.ph_hi = hi; a.li = nl++; hipLaunchKernelGGL(mk_fwd, dim3(grid), dim3(NTHR), LDS_BYTES, stream, a); };
    run(0, 8);
}
```

```cpp
#define REP_MASK 0
#include <hip/hip_runtime.h>
#include <cstdint>
#include <cstdio>

typedef unsigned short u16;
typedef short bf16x8 __attribute__((ext_vector_type(8)));
typedef float f32x4 __attribute__((ext_vector_type(4)));
typedef unsigned u32x4 __attribute__((ext_vector_type(4)));
typedef unsigned u32x2 __attribute__((ext_vector_type(2)));
#define LAS __attribute__((address_space(3)))

constexpr int NTOK = 32768, DM = 1024, SEQ = 4096, NBATCH = 8;
constexpr int QKVP = 3072;
constexpr int NEXP = 32;
constexpr float LOG2E = 1.4426950408889634f;
constexpr float QSCALE = 0.125f * LOG2E;
constexpr float DN_ALPHA = 1.189207115002721f;
constexpr float LN_EPS = 1e-5f;

constexpr size_t MiB = 1u << 20;
constexpr size_t WS_CTL = 0, CTL_BYTES = 1 * MiB;
constexpr size_t WS_RWT = 1 * MiB;
constexpr size_t WS_KN = 1 * MiB + 256 * 1024;
constexpr size_t WS_H1Q = 80 * MiB;
constexpr size_t WS_WIN = 2 * MiB, WS_WOUT = 8 * MiB, WS_W1 = 16 * MiB, WS_W2 = 144 * MiB;
constexpr size_t WS_H1 = 208 * MiB, WS_LIST = 272 * MiB, WS_GATE = 276 * MiB;
constexpr size_t WS_H0 = 280 * MiB, WS_QKV = 344 * MiB, WS_O = 536 * MiB, WS_U = 344 * MiB, WS_ACT = 280 * MiB;
constexpr size_t WS_YS = 600 * MiB, WS_END = 856 * MiB;

__device__ __forceinline__ float bf2f(u16 v) { return __uint_as_float((unsigned)v << 16); }
__device__ __forceinline__ u16 f2bf(float f) { unsigned u = __float_as_uint(f); return (u16)((u + 0x7fffu + ((u >> 16) & 1u)) >> 16); }
__device__ __forceinline__ unsigned pk2(float lo, float hi) { typedef float f2_ __attribute__((ext_vector_type(2))); typedef __bf16 b2_ __attribute__((ext_vector_type(2))); f2_ v = {lo, hi}; b2_ r = __builtin_convertvector(v, b2_); return __builtin_bit_cast(unsigned, r); }
__device__ __forceinline__ float wave_sum(float v) {
#pragma unroll
    for (int o = 1; o < 64; o <<= 1) v += __shfl_xor(v, o);
    return v;
}


#define GAS __attribute__((address_space(1)))
typedef GAS unsigned gu32;
#define RLX_AGENT __ATOMIC_RELAXED, __HIP_MEMORY_SCOPE_AGENT
#define LDS_WAIT() asm volatile("s_waitcnt lgkmcnt(0)" ::: "memory")
#define VM_WAIT() asm volatile("s_waitcnt vmcnt(0)" ::: "memory")

constexpr int NWAVES = 8, NTHR = 512;
__device__ __forceinline__ int lane_id() { int l; asm volatile("v_mbcnt_lo_u32_b32 %0, -1, 0\n\tv_mbcnt_hi_u32_b32 %0, -1, %0" : "=v"(l)); return l; }
constexpr int RING_OFF = 0, RING_BYTES = 131072, TAB_OFF = 131072, TAB_BYTES = 24576, MISC_OFF = TAB_OFF + TAB_BYTES, LDS_BYTES = MISC_OFF + 1024;
constexpr int CW_CNT = 0;
constexpr int CW_Q = 2048;
constexpr int CW_CQ = 2048 + 64 * 8;
constexpr int CW_BAR = 4096;

#define XB_TMO      128
#define XB_XCNT(j)  (256  + 64 * (j))
#define XB_XSUB(j)  (1280 + 64 * (j))
#define XB_XGEN(j)  (2304 + 64 * (j))
#define XB_TOP      3328
#define XB_TOPGEN   3392
#define XCD_BAR_WORDS 3456
#define XB_SPIN_CAP (1u << 20)
__device__ __forceinline__ unsigned xb_ld(unsigned* p)              { return __hip_atomic_load(p, __ATOMIC_RELAXED, __HIP_MEMORY_SCOPE_AGENT); }
__device__ __forceinline__ unsigned xb_add(unsigned* p, unsigned v) { return __hip_atomic_fetch_add(p, v, __ATOMIC_RELAXED, __HIP_MEMORY_SCOPE_AGENT); }
__device__ __forceinline__ unsigned xb_xcc_id() { return (unsigned)__builtin_amdgcn_s_getreg((3 << 11) | 20) & 0xFu; }
#define XB_SPIN(cond, bar) do { unsigned _sp = 0; while (cond) { __builtin_amdgcn_s_sleep(1); \
    if ((++_sp & 255u) == 0u) { if (xb_ld(&(bar)[XB_TMO])) break; if (_sp > XB_SPIN_CAP) { atomicAdd(&(bar)[XB_TMO], 1u); break; } } } } while (0)
struct XcdBarrier { unsigned* bar; unsigned x; volatile LAS unsigned* st; int wave; };
__device__ __forceinline__ XcdBarrier xcd_barrier_post(unsigned* bar, volatile LAS unsigned* st, int wave) {
    XcdBarrier b; b.bar = bar; b.x = xb_xcc_id(); b.st = st; b.wave = wave;
    if (wave == 0 && lane_id() == 0) (void)xb_add(&bar[XB_XCNT(b.x)], 1u);
    return b;
}
__device__ __forceinline__ void xcd_barrier_complete(unsigned* bar, unsigned x, unsigned& nloc, unsigned& nx) {
    const unsigned G = gridDim.x * gridDim.y * gridDim.z;
    unsigned sum, cnt, mine, sp = 0u;
    for (;;) {
        sum = 0u; cnt = 0u; mine = 0u;
#pragma unroll
        for (unsigned j = 0; j < 16; ++j) { const unsigned c = xb_ld(&bar[XB_XCNT(j)]); sum += c; cnt += (c > 0u) ? 1u : 0u; mine = (j == x) ? c : mine; }
        if (sum == G) break;
        __builtin_amdgcn_s_sleep(1);
        if ((++sp & 255u) == 0u) { if (xb_ld(&bar[XB_TMO])) break; if (sp > XB_SPIN_CAP) { atomicAdd(&bar[XB_TMO], 1u); break; } }
    }
    nloc = mine > 0u ? mine : 1u; nx = cnt > 0u ? cnt : 1u;
}
__device__ __forceinline__ void xcd_barrier(const XcdBarrier& b) {
    asm volatile("s_waitcnt vmcnt(0)" ::: "memory");
    __syncthreads();
    if (b.wave == 0 && lane_id() == 0) {
        unsigned* bar = b.bar;
        __builtin_amdgcn_s_waitcnt(0);
        unsigned nloc = b.st[0], nx = b.st[1];
        if (nloc == 0u) { xcd_barrier_complete(bar, b.x, nloc, nx); b.st[0] = nloc; b.st[1] = nx; }
        const unsigned old = xb_add(&bar[XB_XSUB(b.x)], 1u);
        const unsigned gen = old / nloc;
        if (old + 1u == (gen + 1u) * nloc) {
            __builtin_amdgcn_fence(__ATOMIC_RELEASE, "agent");
            asm volatile("s_waitcnt vmcnt(0)" ::: "memory");
            const unsigned og = xb_add(&bar[XB_TOP], 1u);
            const unsigned tg = og / nx;
            if (og + 1u == (tg + 1u) * nx) xb_add(&bar[XB_TOPGEN], 1u);
            else XB_SPIN(xb_ld(&bar[XB_TOPGEN]) == tg, bar);
            __builtin_amdgcn_fence(__ATOMIC_ACQUIRE, "agent");
            xb_add(&bar[XB_XGEN(b.x)], 1u);
            asm volatile("s_waitcnt vmcnt(0)" ::: "memory");
        } else {
            XB_SPIN(xb_ld(&bar[XB_XGEN(b.x)]) == gen, bar);
            __builtin_amdgcn_fence(__ATOMIC_ACQUIRE, "agent");
            asm volatile("s_waitcnt vmcnt(0)" ::: "memory");
        }
    }
    __syncthreads();
}

namespace pg8 {
constexpr int BM = 256, BK = 64, HALF = 128, HTB = HALF * BK * 2, NXCD = 8, WGM = 8, KD = 1024, NT = KD / BK;
__host__ __device__ __forceinline__ int lds_byte(int r, int c) { const int st = (r >> 4) * 2 + (c >> 5), rr = r & 15, cc = c & 31, ob = rr * 64 + cc * 2; return st * 1024 + (ob ^ (((ob >> 9) & 1) << 5)); }
__host__ __device__ __forceinline__ void stage_rc(int b, int& R, int& C) { const int st = b / 1024, sb = b % 1024, swz = sb ^ (((sb >> 9) & 1) << 5); R = (st >> 1) * 16 + swz / 64; C = (st & 1) * 32 + (swz % 64) / 2; }
__host__ __device__ __forceinline__ int perm32(int rho) { const int n = rho >> 4, i = rho & 15; return 8 * (i >> 2) + 4 * n + (i & 3); }
__device__ __forceinline__ float clamp8(float x) { return __builtin_amdgcn_fmed3f(x, -448.0f, 448.0f); }
__device__ __forceinline__ unsigned cvt_pk_bf16(float lo, float hi) { unsigned r; asm volatile("v_cvt_pk_bf16_f32 %0, %1, %2" : "=v"(r) : "v"(lo), "v"(hi)); return r; }

typedef int v8i32 __attribute__((ext_vector_type(8)));
struct Unit { int pm, pn, e, idx; };

struct StaticOrder {
    int nM, nN, nwg, G, c;
    __device__ void init(int M, int N, int G_, int c_) { nM = M / BM; nN = N / BM; nwg = nM * nN; G = G_; c = c_; }
    __device__ bool next(int i, Unit& u) const {
        const long L = (long)i * G + c; if (L >= nwg) return false;
        int wgid = (int)L; { const int q = nwg / NXCD, r = nwg % NXCD, xcd = wgid % NXCD, off = wgid / NXCD; wgid = (xcd < r ? xcd * (q + 1) : r * (q + 1) + (xcd - r) * q) + off; }
        const int nig = WGM * nN, gid = wgid / nig, fm = gid * WGM, gsz = (nM - fm) < WGM ? (nM - fm) : WGM;
        u.pm = fm + ((wgid % nig) % gsz); u.pn = (wgid % nig) / gsz; u.e = 0; u.idx = i; return true;
    }
};

template <class P>
__device__ __forceinline__ void gemm_phase(LAS unsigned char* lds, const P& S, int wave) {
    const int wid = wave, lane = lane_id(), tid = wid * 64 + lane, wr = wid >> 2, wc = wid & 3, fr = lane & 15, fq = lane >> 4;
    constexpr int KB = P::FP8 ? 1024 : 2048, nt = KB / 128;
    int Rr[2], Cc[2]; unsigned voffB[2];
#pragma unroll
    for (int i = 0; i < 2; ++i) { int R, C; stage_rc(tid * 16 + i * 8192, R, C); const int Rb = 64 * (R >> 5) + perm32(R & 31); Rr[i] = R; Cc[i] = C; voffB[i] = (unsigned)(Rb * KB + C * 2); }
    constexpr unsigned kstep = (unsigned)(BK * 2);
    constexpr unsigned hstep = 32u * KB;
    const __amdgpu_buffer_rsrc_t rA = __builtin_amdgcn_make_buffer_rsrc((void*)S.a_ptr(), 0, 0x7fffffff, 0x00020000), rB = __builtin_amdgcn_make_buffer_rsrc((void*)S.b_ptr(), 0, 0x7fffffff, 0x00020000);
    const unsigned ldsw = (unsigned)wid * 1024u;
    const int aoff = lds_byte(wr * 64 + fr, fq * 8), boff = lds_byte(wc * 32 + fr, fq * 8);
#define PG8_SA(b, h) (((b) * 2 + (h)) * HTB)
#define PG8_SB(b, h) ((4 + (b) * 2 + (h)) * HTB)
#define PG8_STAGE(bufoff, rs, sbase, voff) do { _Pragma("unroll") for (int _i = 0; _i < 2; ++_i) \
        __builtin_amdgcn_raw_ptr_buffer_load_lds(rs, (LAS unsigned*)(lds + (bufoff) + ldsw + _i * 8192), 16, (int)(voff)[_i], (int)(sbase), 0, 0); } while (0)
#define PG8_STAGE_A(bufoff, sbase, un, h) do { _Pragma("unroll") for (int _i = 0; _i < 2; ++_i) \
        __builtin_amdgcn_raw_ptr_buffer_load_lds(rA, (LAS unsigned*)(lds + (bufoff) + ldsw + _i * 8192), 16, (int)S.a_off1(un, h, Rr[_i], Cc[_i]), (int)(sbase), 0, 0); } while (0)
#define PG8_LDA(dst, b, h) do { _Pragma("unroll") for (int m = 0; m < 4; ++m) _Pragma("unroll") for (int k = 0; k < 2; ++k) dst[m][k] = *(const LAS bf16x8*)(lds + PG8_SA(b, h) + aoff + m * 2048 + k * 1024); } while (0)
#define PG8_LDB(dst, b, h) do { _Pragma("unroll") for (int n = 0; n < 2; ++n) _Pragma("unroll") for (int k = 0; k < 2; ++k) dst[n][k] = *(const LAS bf16x8*)(lds + PG8_SB(b, h) + boff + n * 2048 + k * 1024); } while (0)
#define PG8_CAT(x) __builtin_bit_cast(v8i32, __builtin_shufflevector((x)[0], (x)[1], 0, 1, 2, 3, 4, 5, 6, 7, 8, 9, 10, 11, 12, 13, 14, 15))
#define PG8_MMA(ai, bj, At, Bt) do { __builtin_amdgcn_sched_barrier(0); __builtin_amdgcn_s_setprio(1); \
        if constexpr (P::FP8) { _Pragma("unroll") for (int m = 0; m < 4; ++m) _Pragma("unroll") for (int n = 0; n < 2; ++n) \
            acc[ai][bj][m][n] = __builtin_amdgcn_mfma_scale_f32_16x16x128_f8f6f4(PG8_CAT(Bt[n]), PG8_CAT(At[m]), acc[ai][bj][m][n], 0, 0, 0, P::SCALE_B, 0, P::SCALE_A); } \
        else { _Pragma("unroll") for (int m = 0; m < 4; ++m) _Pragma("unroll") for (int n = 0; n < 2; ++n) _Pragma("unroll") for (int k = 0; k < 2; ++k) \
            acc[ai][bj][m][n] = __builtin_amdgcn_mfma_f32_16x16x32_bf16(Bt[n][k], At[m][k], acc[ai][bj][m][n], 0, 0, 0); } \
        __builtin_amdgcn_s_setprio(0); __builtin_amdgcn_sched_barrier(0); } while (0)
#define PG8_WAIT_V(n) asm volatile("s_waitcnt vmcnt(" #n ")" ::: "memory")
#define PG8_WAIT_L(n) asm volatile("s_waitcnt lgkmcnt(" #n ")" ::: "memory")
#define PG8_BAR __builtin_amdgcn_s_barrier()
#define PG8_SCHED __builtin_amdgcn_sched_barrier(0)
    Unit cur, nxt; int ui = 0;
    if (!S.next(0, cur)) return;
    f32x4 acc[2][2][4][2];
#pragma unroll
    for (int a = 0; a < 2; ++a)
#pragma unroll
        for (int b = 0; b < 2; ++b)
#pragma unroll
            for (int m = 0; m < 4; ++m)
#pragma unroll
                for (int n = 0; n < 2; ++n) acc[a][b][m][n] = (f32x4){0.f, 0.f, 0.f, 0.f};
    bf16x8 At[4][2], B0[2][2], B1[2][2];
    unsigned cA = S.a_base(cur), cB = S.b_base(cur);
    PG8_STAGE(PG8_SB(0, 0), rB, cB, voffB); PG8_STAGE(PG8_SB(0, 1), rB, cB + hstep, voffB); PG8_STAGE_A(PG8_SA(0, 0), cA, cur, 0); PG8_STAGE_A(PG8_SA(0, 1), cA, cur, 1);
    if (wr == 1) PG8_BAR;
    PG8_WAIT_V(2); PG8_BAR;
    PG8_STAGE(PG8_SB(1, 0), rB, cB + kstep, voffB); PG8_STAGE_A(PG8_SA(1, 0), cA + kstep, cur, 0); PG8_STAGE(PG8_SB(1, 1), rB, cB + hstep + kstep, voffB);
    PG8_WAIT_V(6); PG8_BAR;
    for (;;) {
        const bool has_next = S.next(ui + 1, nxt);
        const unsigned nA = has_next ? S.a_base(nxt) : cA, nB = has_next ? S.b_base(nxt) : cB;
#pragma unroll 1
        for (int t = 0; t < nt; t += 2) {
            const bool last = (t == nt - 2);
            const unsigned a1 = cA + (unsigned)(t + 1) * kstep;
            const unsigned a2 = last ? nA : cA + (unsigned)(t + 2) * kstep, b2 = last ? nB : cB + (unsigned)(t + 2) * kstep;
            const unsigned a3 = a2 + kstep, b3 = b2 + kstep;
            Unit un2; { const bool nx_ = last && has_next; un2.pm = nx_ ? nxt.pm : cur.pm; un2.pn = nx_ ? nxt.pn : cur.pn; un2.e = nx_ ? nxt.e : cur.e; un2.idx = nx_ ? nxt.idx : cur.idx; }
            PG8_LDB(B0, 0, 0); PG8_LDB(B1, 0, 1); PG8_SCHED; PG8_LDA(At, 0, 0); PG8_STAGE_A(PG8_SA(1, 1), a1, cur, 1);
            PG8_WAIT_V(8); PG8_WAIT_L(0); PG8_BAR; PG8_MMA(0, 0, At, B0); PG8_MMA(0, 1, At, B1); PG8_BAR; PG8_SCHED;
            PG8_LDA(At, 0, 1); PG8_STAGE(PG8_SB(0, 0), rB, b2, voffB); PG8_STAGE(PG8_SB(0, 1), rB, b2 + hstep, voffB); PG8_STAGE_A(PG8_SA(0, 0), a2, un2, 0);
            PG8_WAIT_V(8); PG8_WAIT_L(0); PG8_BAR; PG8_MMA(1, 0, At, B0); PG8_MMA(1, 1, At, B1); PG8_BAR; PG8_SCHED;
            PG8_LDB(B0, 1, 0); PG8_LDB(B1, 1, 1); PG8_SCHED; PG8_LDA(At, 1, 0); PG8_STAGE_A(PG8_SA(0, 1), a2, un2, 1);
            PG8_WAIT_V(8); PG8_WAIT_L(0); PG8_BAR; PG8_MMA(0, 0, At, B0); PG8_MMA(0, 1, At, B1); PG8_BAR; PG8_SCHED;
            PG8_LDA(At, 1, 1); PG8_STAGE(PG8_SB(1, 0), rB, b3, voffB); PG8_STAGE(PG8_SB(1, 1), rB, b3 + hstep, voffB); PG8_STAGE_A(PG8_SA(1, 0), a3, un2, 0);
            PG8_WAIT_V(8); PG8_WAIT_L(0); PG8_BAR; PG8_MMA(1, 0, At, B0); PG8_MMA(1, 1, At, B1); PG8_BAR; PG8_SCHED;
        }
        if (wr == 0) PG8_BAR;
        { const int le_ = lane_id(); S.epi(acc, cur, wr, wc, le_ & 15, le_ >> 4); }
        if (!has_next) break;
#pragma unroll
        for (int a = 0; a < 2; ++a)
#pragma unroll
            for (int b = 0; b < 2; ++b)
#pragma unroll
                for (int m = 0; m < 4; ++m)
#pragma unroll
                    for (int n = 0; n < 2; ++n) acc[a][b][m][n] = (f32x4){0.f, 0.f, 0.f, 0.f};
        cur = nxt; cA = nA; cB = nB; ++ui;
        if (wr == 1) PG8_BAR;
    }
    PG8_WAIT_V(0);
    PG8_BAR;
#undef PG8_SA
#undef PG8_SB
#undef PG8_STAGE
#undef PG8_STAGE_A
#undef PG8_LDA
#undef PG8_LDB
#undef PG8_MMA
#undef PG8_CAT
#undef PG8_WAIT_V
#undef PG8_WAIT_L
#undef PG8_BAR
#undef PG8_SCHED
}
}

__device__ __forceinline__ u32x4 ror8(u32x4 v) { u32x4 r;
#pragma unroll
    for (int q = 0; q < 4; ++q) r[q] = (unsigned)__builtin_amdgcn_update_dpp(0, (int)v[q], 0x128, 0xf, 0xf, true);
    return r; }
struct PDense {
    static constexpr bool PERM = true, FP8 = false; static constexpr int SCALE_A = 0, SCALE_B = 0;
    const u16* A; const u16* Bt; u16* out; const u16* H0; float* KN; int mode; pg8::StaticOrder ord;
    __device__ __forceinline__ bool next(int i, pg8::Unit& u) const { return ord.next(i, u); }
    __device__ __forceinline__ const void* a_ptr() const { return A; }
    __device__ __forceinline__ const void* b_ptr() const { return Bt; }
    __device__ __forceinline__ unsigned a_base(const pg8::Unit& u) const { return (unsigned)u.pm * 256u * 2048u; }
    __device__ __forceinline__ unsigned b_base(const pg8::Unit& u) const { return (unsigned)u.pn * 256u * 2048u; }
    __device__ __forceinline__ unsigned a_off1(const pg8::Unit&, int h, int R, int C) const { return (unsigned)((h * 128 + R) * 1024 + C) * 2u; }
    __device__ __forceinline__ void epi(const f32x4 (&acc)[2][2][4][2], const pg8::Unit& u, int wr, int wc, int fr, int fq) const {
        const int ldc = mode == 0 ? QKVP : DM;
        const float sc = (mode == 0 && (u.pn < 2 || u.pn == 6 || u.pn == 7)) ? QSCALE : 1.0f;
        const int hh = fr >> 3, frl = fr & 7;
        const int rowb = u.pm * 256 + wr * 64, colo = u.pn * 256 + wc * 64 + 8 * fq;
        const bool knorm = (mode == 0) && (u.pn == 2 || u.pn == 3);
#pragma unroll
        for (int ai = 0; ai < 2; ++ai) {
            float cmx = 0.f;
#pragma unroll
            for (int m = 0; m < 4; ++m) {
                if (knorm) { float nr = 0.f;
#pragma unroll
                    for (int bj = 0; bj < 2; ++bj) { const f32x4 x0 = acc[ai][bj][m][0], x1 = acc[ai][bj][m][1]; nr += (x0[0] * x0[0] + x0[1] * x0[1]) + (x0[2] * x0[2] + x0[3] * x0[3]) + (x1[0] * x1[0] + x1[1] * x1[1]) + (x1[2] * x1[2] + x1[3] * x1[3]); }
                    nr += __shfl_xor(nr, 16); nr += __shfl_xor(nr, 32);
#pragma unroll
                    for (int o_ = 1; o_ < 16; o_ <<= 1) nr = fmaxf(nr, __shfl_xor(nr, o_));
                    cmx = fmaxf(cmx, nr); }
                u32x4 W[2];
#pragma unroll
                for (int bj = 0; bj < 2; ++bj) {
                    f32x4 v0 = acc[ai][bj][m][0] * sc, v1 = acc[ai][bj][m][1] * sc;
                    if (mode == 1) {
                        const u32x4 h = *(const u32x4*)(H0 + (size_t)(rowb + ai * 128 + m * 16 + fr) * DM + colo + 32 * bj);
                        v0[0] += DN_ALPHA * __uint_as_float(h.x << 16); v0[1] += DN_ALPHA * __uint_as_float(h.x & 0xffff0000u); v0[2] += DN_ALPHA * __uint_as_float(h.y << 16); v0[3] += DN_ALPHA * __uint_as_float(h.y & 0xffff0000u);
                        v1[0] += DN_ALPHA * __uint_as_float(h.z << 16); v1[1] += DN_ALPHA * __uint_as_float(h.z & 0xffff0000u); v1[2] += DN_ALPHA * __uint_as_float(h.w << 16); v1[3] += DN_ALPHA * __uint_as_float(h.w & 0xffff0000u);
                    }
                    W[bj].x = pg8::cvt_pk_bf16(v0[0], v0[1]); W[bj].y = pg8::cvt_pk_bf16(v0[2], v0[3]); W[bj].z = pg8::cvt_pk_bf16(v1[0], v1[1]); W[bj].w = pg8::cvt_pk_bf16(v1[2], v1[3]);
                }
                const u32x4 rcv = ror8(hh ? W[0] : W[1]);
                const u32x4 s1 = hh ? rcv : W[0], s2 = hh ? W[1] : rcv;
                u16* p1 = out + (size_t)(rowb + ai * 128 + m * 16 + frl) * ldc + colo + 32 * hh;
                *(u32x4*)p1 = s1; *(u32x4*)(p1 + (size_t)8 * ldc) = s2;
            }
            if (knorm && fr == 0 && fq == 0) KN[(size_t)(u.pm * 4 + ai * 2 + wr) * 8 + (u.pn - 2) * 4 + wc] = cmx;
        }
    }
};

struct MoeTab { LAS int* tb; LAS int* cn; LAS int* rowoff; };
__device__ __forceinline__ MoeTab moe_tab(LAS unsigned char* lds) { MoeTab t; t.rowoff = (LAS int*)(lds + TAB_OFF); t.tb = (LAS int*)(lds + TAB_OFF + 20480); t.cn = t.tb + 40; return t; }
__device__ __forceinline__ void moe_tables(const MoeTab& T, const int* cnt, int wave) {
    if (wave == 0 && lane_id() == 0) { int s = 0; for (int e = 0; e < NEXP; ++e) { const int c = __hip_atomic_load(cnt + e, RLX_AGENT); T.cn[e] = c; T.tb[e] = s; s += (c + 255) >> 8; } T.tb[NEXP] = s; }
    __syncthreads();
}
__device__ __forceinline__ int moe_find_e(const MoeTab& T, int RT) { int e = 0; while (e < NEXP - 1 && RT >= T.tb[e + 1]) ++e; return e; }

template <int UP>
struct PMoe {
    static constexpr bool PERM = true, FP8 = true; static constexpr int SCALE_A = UP ? 0x7c7c7c7c : 0x7d7d7d7d, SCALE_B = UP ? 0x75757575 : 0x74747474;
    static constexpr int NPN = UP ? 8 : 4, RPG = UP ? 4 : 8;
    const unsigned char* A; const unsigned char* Bt; void* out; const int* list; const float* gate; const float* bias; MoeTab T; int c, ntot;
    __device__ __forceinline__ bool next(int i, pg8::Unit& u) const {
        const int x = c & 7, s = c >> 3; const int RT = (i * 8 + x) * RPG + (s % RPG);
        if (RT >= ntot) return false;
        u.pm = RT; u.pn = s / RPG; u.e = moe_find_e(T, RT); u.idx = i; return true;
    }
    __device__ __forceinline__ const void* a_ptr() const { return A; }
    __device__ __forceinline__ const void* b_ptr() const { return Bt; }
    __device__ __forceinline__ unsigned a_base(const pg8::Unit& u) const { return UP ? 0u : (unsigned)u.pm * 256u * 1024u; }
    __device__ __forceinline__ unsigned b_base(const pg8::Unit& u) const { return ((unsigned)u.e * (UP ? 2048u : 1024u) + (unsigned)u.pn * 256u) * 1024u; }
    __device__ __forceinline__ unsigned a_off1(const pg8::Unit& u, int h, int R, int C) const { return UP ? (unsigned)T.rowoff[u.idx * 256 + h * 128 + R] + (unsigned)C * 2u : (unsigned)((h * 128 + R) * 1024 + C * 2); }
    __device__ __forceinline__ void prepare(int wave) const {
        const int tidx = wave * 64 + lane_id();
        pg8::Unit u;
        if (UP) {
            for (int i = 0; next(i, u); ++i) {
                if (tidx < 256) { const int r = (u.pm - T.tb[u.e]) * 256 + tidx; const int ent = list[(size_t)u.e * NTOK + (r < T.cn[u.e] ? r : 0)]; T.rowoff[i * 256 + tidx] = (ent >> 2) * 1024; }
            }
        } else {
            for (int i = 0; next(i, u); ++i) {
                if (tidx < 256) { const int r = (u.pm - T.tb[u.e]) * 256 + tidx; int ent = -1; float g = 0.f;
                    if (r < T.cn[u.e]) { ent = list[(size_t)u.e * NTOK + r]; g = gate[ent]; }
                    T.rowoff[i * 512 + tidx] = ent; ((LAS float*)T.rowoff)[i * 512 + 256 + tidx] = g; }
            }
        }
        __syncthreads();
    }
    __device__ __forceinline__ void epi(const f32x4 (&acc)[2][2][4][2], const pg8::Unit& u, int wr, int wc, int fr, int fq) const {
        const int colo = u.pn * 256 + wc * 64 + 8 * fq;
        if (UP) {
            const float* bp = bias + (size_t)u.e * 2048 + colo;
            f32x4 bv[2][2];
#pragma unroll
            for (int bj = 0; bj < 2; ++bj) { bv[bj][0] = *(const f32x4*)(bp + bj * 32); bv[bj][1] = *(const f32x4*)(bp + bj * 32 + 4); }
#pragma unroll
            for (int ai = 0; ai < 2; ++ai)
#pragma unroll
                for (int m = 0; m < 4; ++m) {
                    unsigned char* rowp = (unsigned char*)out + (size_t)(u.pm * 256 + wr * 64 + fr + ai * 128 + m * 16) * 1024 + (colo >> 1);
#pragma unroll
                    for (int bj = 0; bj < 2; ++bj) {
                        const f32x4 v0 = acc[ai][bj][m][0] + bv[bj][0], v1 = acc[ai][bj][m][1] + bv[bj][1];
                        float a[4];
#pragma unroll
                        for (int p = 0; p < 4; ++p) {
                            const float glu = p < 2 ? v0[2 * p] : v1[2 * p - 4], lin = p < 2 ? v0[2 * p + 1] : v1[2 * p - 3];
                            const float xg = fminf(glu, 7.0f), xl = fminf(fmaxf(lin, -7.0f), 7.0f);
                            a[p] = xg * __builtin_amdgcn_rcpf(1.0f + __builtin_amdgcn_exp2f(-1.702f * LOG2E * xg)) * (xl + 1.0f);
                        }
                        int w = __builtin_amdgcn_cvt_pk_fp8_f32(pg8::clamp8(a[0] * 4.0f), pg8::clamp8(a[1] * 4.0f), 0, false); w = __builtin_amdgcn_cvt_pk_fp8_f32(pg8::clamp8(a[2] * 4.0f), pg8::clamp8(a[3] * 4.0f), w, true);
                        *(int*)(rowp + bj * 16) = w;
                    }
                }
        } else {
            const float* bp = bias + (size_t)u.e * 1024 + colo;
            f32x4 bv[2][2];
#pragma unroll
            for (int bj = 0; bj < 2; ++bj) { bv[bj][0] = *(const f32x4*)(bp + bj * 32); bv[bj][1] = *(const f32x4*)(bp + bj * 32 + 4); }
            const int hh = fr >> 3, frl = fr & 7;
#pragma unroll
            for (int ai = 0; ai < 2; ++ai)
#pragma unroll
                for (int m = 0; m < 4; ++m) {
                    const int rlb = wr * 64 + ai * 128 + m * 16;
                    const float gt = ((LAS const float*)T.rowoff)[u.idx * 512 + 256 + rlb + fr];
                    const int e1 = T.rowoff[u.idx * 512 + rlb + frl], e2 = T.rowoff[u.idx * 512 + rlb + frl + 8];
                    u32x2 W[2];
#pragma unroll
                    for (int bj = 0; bj < 2; ++bj) {
                        const f32x4 v0 = (acc[ai][bj][m][0] + bv[bj][0]) * (gt * 64.0f), v1 = (acc[ai][bj][m][1] + bv[bj][1]) * (gt * 64.0f);
                        int w0 = __builtin_amdgcn_cvt_pk_fp8_f32(pg8::clamp8(v0[0]), pg8::clamp8(v0[1]), 0, false); w0 = __builtin_amdgcn_cvt_pk_fp8_f32(pg8::clamp8(v0[2]), pg8::clamp8(v0[3]), w0, true);
                        int w1 = __builtin_amdgcn_cvt_pk_fp8_f32(pg8::clamp8(v1[0]), pg8::clamp8(v1[1]), 0, false); w1 = __builtin_amdgcn_cvt_pk_fp8_f32(pg8::clamp8(v1[2]), pg8::clamp8(v1[3]), w1, true);
                        W[bj].x = (unsigned)w0; W[bj].y = (unsigned)w1;
                    }
                    u32x2 snd = hh ? W[0] : W[1], rcv;
                    rcv.x = (unsigned)__builtin_amdgcn_update_dpp(0, (int)snd.x, 0x128, 0xf, 0xf, true); rcv.y = (unsigned)__builtin_amdgcn_update_dpp(0, (int)snd.y, 0x128, 0xf, 0xf, true);
                    const u32x2 s1 = hh ? rcv : W[0], s2 = hh ? W[1] : rcv;
                    if (e1 >= 0) *(u32x2*)((unsigned char*)out + (size_t)e1 * 1024 + colo + 32 * hh) = s1;
                    if (e2 >= 0) *(u32x2*)((unsigned char*)out + (size_t)e2 * 1024 + colo + 32 * hh) = s2;
                }
        }
    }
};

struct Frame {
    LAS unsigned char* lds; volatile LAS unsigned* MISC; gu32* ctl; int wave, G, bid;
    __device__ __forceinline__ int tid() const { return wave * 64 + lane_id(); }
};
__device__ __forceinline__ void p0_transpose_item(const float* W, int K, int N, u16* WT, LAS float* scr, int item, int lane) {
    const int nblk = N / 32, kb = item / nblk, nb = item % nblk, k0 = 64 * kb, n0 = 32 * nb;
    f32x4 v[8];
#pragma unroll
    for (int it = 0; it < 8; ++it) v[it] = *(const f32x4*)(W + (size_t)(k0 + (lane >> 3) + 8 * it) * N + n0 + (lane & 7) * 4);
#pragma unroll
    for (int it = 0; it < 8; ++it) { const int k = (lane >> 3) + 8 * it, n4 = (lane & 7) * 4; scr[(n4 + 0) * 68 + k] = v[it].x; scr[(n4 + 1) * 68 + k] = v[it].y; scr[(n4 + 2) * 68 + k] = v[it].z; scr[(n4 + 3) * 68 + k] = v[it].w; }
    LDS_WAIT(); asm volatile("" ::: "memory");
#pragma unroll
    for (int it = 0; it < 4; ++it) {
        const int n = (lane >> 3) + 8 * it, c = lane & 7; const LAS float* s = scr + n * 68 + 8 * c;
        const f32x4 a = *(const LAS f32x4*)s, b = *(const LAS f32x4*)(s + 4);
        u32x4 o; o.x = pk2(a.x, a.y); o.y = pk2(a.z, a.w); o.z = pk2(b.x, b.y); o.w = pk2(b.z, b.w);
        *(u32x4*)(WT + (size_t)(n0 + n) * K + k0 + 8 * c) = o;
    }
    LDS_WAIT(); asm volatile("" ::: "memory");
}
__device__ __forceinline__ void p0_transpose_item_fp8(const float* W, int K, int N, unsigned char* WT, LAS float* scr, int item, int lane, float scale) {
    const int nblk = N / 32, kb = item / nblk, nb = item % nblk, k0 = 64 * kb, n0 = 32 * nb;
    f32x4 v[8];
#pragma unroll
    for (int it = 0; it < 8; ++it) v[it] = *(const f32x4*)(W + (size_t)(k0 + (lane >> 3) + 8 * it) * N + n0 + (lane & 7) * 4);
#pragma unroll
    for (int it = 0; it < 8; ++it) { const int k = (lane >> 3) + 8 * it, n4 = (lane & 7) * 4; scr[(n4 + 0) * 68 + k] = v[it].x; scr[(n4 + 1) * 68 + k] = v[it].y; scr[(n4 + 2) * 68 + k] = v[it].z; scr[(n4 + 3) * 68 + k] = v[it].w; }
    LDS_WAIT(); asm volatile("" ::: "memory");
#pragma unroll
    for (int it = 0; it < 2; ++it) {
        const int n = (lane >> 2) + 16 * it, c = lane & 3; const LAS float* s = scr + n * 68 + 16 * c;
        u32x4 o;
#pragma unroll
        for (int q = 0; q < 4; ++q) { f32x4 a = *(const LAS f32x4*)(s + 4 * q) * scale;
            a.x = fminf(fmaxf(a.x, -448.f), 448.f); a.y = fminf(fmaxf(a.y, -448.f), 448.f); a.z = fminf(fmaxf(a.z, -448.f), 448.f); a.w = fminf(fmaxf(a.w, -448.f), 448.f);
            int w = __builtin_amdgcn_cvt_pk_fp8_f32(a.x, a.y, 0, false); w = __builtin_amdgcn_cvt_pk_fp8_f32(a.z, a.w, w, true); o[q] = (unsigned)w; }
        *(u32x4*)(WT + (size_t)(n0 + n) * K + k0 + 16 * c) = o;
    }
    LDS_WAIT(); asm volatile("" ::: "memory");
}
__device__ __forceinline__ void ln_row_in(const float* xrow, const float* g, const float* b, u16* orow, int lane) {
    const f32x4* xr = (const f32x4*)xrow + lane;
    f32x4 v[4]; float s = 0.f;
#pragma unroll
    for (int j = 0; j < 4; ++j) { v[j] = xr[64 * j]; s += (v[j].x + v[j].y) + (v[j].z + v[j].w); }
    const float mean = wave_sum(s) * (1.f / DM); float s2 = 0.f;
#pragma unroll
    for (int j = 0; j < 4; ++j) { v[j] = v[j] - mean; s2 += (v[j].x * v[j].x + v[j].y * v[j].y) + (v[j].z * v[j].z + v[j].w * v[j].w); }
    const float rstd = 1.f / sqrtf(wave_sum(s2) * (1.f / DM) + LN_EPS);
    u32x2* o8 = (u32x2*)orow + lane;
#pragma unroll
    for (int j = 0; j < 4; ++j) {
        const f32x4 gg = ((const f32x4*)g)[lane + 64 * j], bb = ((const f32x4*)b)[lane + 64 * j];
        u32x2 w; w.x = pk2(v[j].x * rstd * gg.x + bb.x, v[j].y * rstd * gg.y + bb.y); w.y = pk2(v[j].z * rstd * gg.z + bb.z, v[j].w * rstd * gg.w + bb.w);
        o8[64 * j] = w;
    }
}

struct Args { const float* in[21]; float* out; unsigned char* ws; int ph_lo, ph_hi, li, pad; };

constexpr int P0_I_IN = 16 * 96, P0_I_OUT = 16 * 32, P0_I_W1 = 16 * 64, P0_I_W2 = 16 * 32;
constexpr int P0_DENSE_ITEMS = P0_I_IN + P0_I_OUT, P0_NITEMS = P0_DENSE_ITEMS + NEXP * P0_I_W1 + NEXP * P0_I_W2;
__device__ __forceinline__ void p0_do_item(const Args& a, int it, LAS float* scr, int lane) {
    unsigned char* ws = a.ws; int r = it;
    if (r < P0_I_IN) { p0_transpose_item(a.in[3], 1024, 3072, (u16*)(ws + WS_WIN), scr, r, lane); return; } r -= P0_I_IN;
    if (r < P0_I_OUT) { p0_transpose_item(a.in[10], 1024, 1024, (u16*)(ws + WS_WOUT), scr, r, lane); return; } r -= P0_I_OUT;
    if (r < NEXP * P0_I_W1) { const int e = r / P0_I_W1; p0_transpose_item_fp8(a.in[15] + (size_t)e * 1024 * 2048, 1024, 2048, ws + WS_W1 + (size_t)e * 1024 * 2048, scr, r % P0_I_W1, lane, 1024.0f); return; } r -= NEXP * P0_I_W1;
    { const int e = r / P0_I_W2; p0_transpose_item_fp8(a.in[17] + (size_t)e * 1024 * 1024, 1024, 1024, ws + WS_W2 + (size_t)e * 1024 * 1024, scr, r % P0_I_W2, lane, 2048.0f); }
}
__device__ __forceinline__ void p0_prologue(const Frame& F, const Args& a) {
    unsigned char* ws = a.ws;
    u16* H0 = (u16*)(ws + WS_H0);
    LAS float* scr = (LAS float*)(F.lds + RING_OFF + F.wave * 8704);
    const int gw = F.bid * NWAVES + F.wave, NGW = F.G * NWAVES;
    for (int it = gw; it < P0_DENSE_ITEMS; it += NGW) p0_do_item(a, it, scr, lane_id());
    { u16* RW = (u16*)(ws + WS_RWT); const float* rw = a.in[13];
      for (int idx = F.bid * NTHR + F.tid(); idx < 32768; idx += F.G * NTHR) { const int e = idx >> 10, k = idx & 1023; const float v = rw[k * 32 + e]; const u16 hi = f2bf(v); RW[idx] = hi; RW[32768 + idx] = f2bf(v - bf2f(hi)); } }
    for (int m = gw; m < NTOK; m += NGW) ln_row_in(a.in[0] + (size_t)m * DM, a.in[1], a.in[2], H0 + (size_t)m * DM, lane_id());
}

__device__ __forceinline__ void p4_router(const Frame& F, const Args& a) {
    unsigned char* ws = a.ws;
    const u16* U = (const u16*)(ws + WS_U); u16* H1 = (u16*)(ws + WS_H1); int* LIST = (int*)(ws + WS_LIST); float* GATE = (float*)(ws + WS_GATE); int* CNT = (int*)(F.ctl + CW_CNT);
    const float* g1 = a.in[11]; const float* b1 = a.in[12]; const float* rb = a.in[14];
    const u32x4* RWT = (const u32x4*)(ws + WS_RWT);
    LAS int* lcnt = (LAS int*)(F.lds + TAB_OFF); LAS int* lbase = lcnt + 32; LAS int* ent_e = lcnt + 64; LAS int* ent_p = ent_e + 512;
    const int lane = lane_id(), tok = lane & 15, kg = lane >> 4;
#if defined(MEAS_P4)
    const unsigned long long tq0_ = __builtin_amdgcn_s_memrealtime();
#endif
    LAS float* gl = (LAS float*)(F.lds + TAB_OFF + 8192); LAS float* bl = gl + 1024;
    for (int i = F.tid(); i < 1024; i += NTHR) { gl[i] = g1[i]; bl[i] = b1[i]; }
    for (int i = F.tid(); i < 8192; i += NTHR) { const int img = i >> 12, e = (i >> 7) & 31, c = i & 127; *(LAS u32x4*)(F.lds + RING_OFF + img * 65536 + e * 2048 + 16 * (c ^ (e & 15))) = RWT[i]; }
    for (int batch = F.bid; batch < NTOK / 128; batch += F.G) {
        __syncthreads();
        if (F.tid() < 32) lcnt[F.tid()] = 0;
        __syncthreads();
        const int tl = F.wave * 16 + tok, t = batch * 128 + tl;
        const u32x4* ur = (const u32x4*)(U + (size_t)t * DM) + 2 * kg;
#define P4_CH(s) (8 * ((s) >> 1) + ((s) & 1))
        float s1 = 0.f;
#pragma unroll 8
        for (int s = 0; s < 32; ++s) { const u32x4 w = ur[P4_CH(s)];
            s1 += (__uint_as_float(w.x << 16) + __uint_as_float(w.x & 0xffff0000u)) + (__uint_as_float(w.y << 16) + __uint_as_float(w.y & 0xffff0000u))
                + (__uint_as_float(w.z << 16) + __uint_as_float(w.z & 0xffff0000u)) + (__uint_as_float(w.w << 16) + __uint_as_float(w.w & 0xffff0000u)); }
        s1 += __shfl_xor(s1, 16); s1 += __shfl_xor(s1, 32);
        const float mean = s1 * (1.f / DM);
        float s2 = 0.f;
#pragma unroll 8
        for (int s = 0; s < 32; ++s) { const u32x4 w = ur[P4_CH(s)];
            const float d0 = __uint_as_float(w.x << 16) - mean, d1 = __uint_as_float(w.x & 0xffff0000u) - mean, d2 = __uint_as_float(w.y << 16) - mean, d3 = __uint_as_float(w.y & 0xffff0000u) - mean;
            const float d4 = __uint_as_float(w.z << 16) - mean, d5 = __uint_as_float(w.z & 0xffff0000u) - mean, d6 = __uint_as_float(w.w << 16) - mean, d7 = __uint_as_float(w.w & 0xffff0000u) - mean;
            s2 += (d0 * d0 + d1 * d1) + (d2 * d2 + d3 * d3) + (d4 * d4 + d5 * d5) + (d6 * d6 + d7 * d7); }
        s2 += __shfl_xor(s2, 16); s2 += __shfl_xor(s2, 32);
        const float rstd = 1.f / sqrtf(s2 * (1.f / DM) + LN_EPS);
#if defined(MEAS_P4)
        if (MEAS_P4 == 1 && F.wave == 0 && lane == 0) ((volatile LAS unsigned*)(F.lds + MISC_OFF))[16] += (unsigned)(__builtin_amdgcn_s_memrealtime() - tq0_);
#endif
        f32x4 acc[2];
        acc[0] = (f32x4){0.f, 0.f, 0.f, 0.f}; acc[1] = (f32x4){0.f, 0.f, 0.f, 0.f};
        u32x4* hr = (u32x4*)(H1 + (size_t)t * DM) + 2 * kg;
        u32x2* hq = (u32x2*)(ws + WS_H1Q + (size_t)t * DM) + 2 * kg;
        LAS const unsigned char* wimg = F.lds + RING_OFF + tok * 2048;
#pragma unroll 8
        for (int s = 0; s < 32; ++s) {
            const u32x4 w = ur[P4_CH(s)];
            const f32x4 ga = *(const LAS f32x4*)(gl + 8 * (P4_CH(s) + 2 * kg)), gb = *(const LAS f32x4*)(gl + 8 * (P4_CH(s) + 2 * kg) + 4), ba = *(const LAS f32x4*)(bl + 8 * (P4_CH(s) + 2 * kg)), bb = *(const LAS f32x4*)(bl + 8 * (P4_CH(s) + 2 * kg) + 4);
            float h[8];
            h[0] = (__uint_as_float(w.x << 16) - mean) * rstd * ga.x + ba.x; h[1] = (__uint_as_float(w.x & 0xffff0000u) - mean) * rstd * ga.y + ba.y;
            h[2] = (__uint_as_float(w.y << 16) - mean) * rstd * ga.z + ba.z; h[3] = (__uint_as_float(w.y & 0xffff0000u) - mean) * rstd * ga.w + ba.w;
            h[4] = (__uint_as_float(w.z << 16) - mean) * rstd * gb.x + bb.x; h[5] = (__uint_as_float(w.z & 0xffff0000u) - mean) * rstd * gb.y + bb.y;
            h[6] = (__uint_as_float(w.w << 16) - mean) * rstd * gb.z + bb.z; h[7] = (__uint_as_float(w.w & 0xffff0000u) - mean) * rstd * gb.w + bb.w;
            u32x4 hh, hl;
            hh.x = pk2(h[0], h[1]); hh.y = pk2(h[2], h[3]); hh.z = pk2(h[4], h[5]); hh.w = pk2(h[6], h[7]);
            hr[P4_CH(s)] = hh;
            { u32x2 q8; int w0 = __builtin_amdgcn_cvt_pk_fp8_f32(pg8::clamp8(h[0] * 8.0f), pg8::clamp8(h[1] * 8.0f), 0, false); w0 = __builtin_amdgcn_cvt_pk_fp8_f32(pg8::clamp8(h[2] * 8.0f), pg8::clamp8(h[3] * 8.0f), w0, true);
              int w1 = __builtin_amdgcn_cvt_pk_fp8_f32(pg8::clamp8(h[4] * 8.0f), pg8::clamp8(h[5] * 8.0f), 0, false); w1 = __builtin_amdgcn_cvt_pk_fp8_f32(pg8::clamp8(h[6] * 8.0f), pg8::clamp8(h[7] * 8.0f), w1, true); q8.x = (unsigned)w0; q8.y = (unsigned)w1; hq[P4_CH(s)] = q8; }
            hl.x = pk2(h[0] - __uint_as_float(hh.x << 16), h[1] - __uint_as_float(hh.x & 0xffff0000u)); hl.y = pk2(h[2] - __uint_as_float(hh.y << 16), h[3] - __uint_as_float(hh.y & 0xffff0000u));
            hl.z = pk2(h[4] - __uint_as_float(hh.z << 16), h[5] - __uint_as_float(hh.z & 0xffff0000u)); hl.w = pk2(h[6] - __uint_as_float(hh.w << 16), h[7] - __uint_as_float(hh.w & 0xffff0000u));
            const bf16x8 bh = __builtin_bit_cast(bf16x8, hh), bl = __builtin_bit_cast(bf16x8, hl);
            const unsigned co = 16u * ((unsigned)(P4_CH(s) + 2 * kg) ^ (unsigned)tok);
#pragma unroll
            for (int eh = 0; eh < 2; ++eh) {
                const bf16x8 wh = *(const LAS bf16x8*)(wimg + eh * 32768 + co), wl = *(const LAS bf16x8*)(wimg + 65536 + eh * 32768 + co);
                acc[eh] = __builtin_amdgcn_mfma_f32_16x16x32_bf16(wh, bh, acc[eh], 0, 0, 0);
                acc[eh] = __builtin_amdgcn_mfma_f32_16x16x32_bf16(wl, bh, acc[eh], 0, 0, 0);
                acc[eh] = __builtin_amdgcn_mfma_f32_16x16x32_bf16(wh, bl, acc[eh], 0, 0, 0);
            }
        }
#if defined(MEAS_P4)
        if (MEAS_P4 == 2 && F.wave == 0 && lane == 0) ((volatile LAS unsigned*)(F.lds + MISC_OFF))[16] += (unsigned)(__builtin_amdgcn_s_memrealtime() - tq0_);
#endif
        float lg[8];
#pragma unroll
        for (int eh = 0; eh < 2; ++eh)
#pragma unroll
            for (int r = 0; r < 4; ++r) lg[eh * 4 + r] = acc[eh][r] + rb[16 * eh + 4 * kg + r];
        unsigned used = 0u; float tv[4]; int ti[4];
#pragma unroll
        for (int k = 0; k < 4; ++k) {
            float best = -INFINITY; int bi = 1 << 20;
#pragma unroll
            for (int j = 0; j < 8; ++j) { const int e = 16 * (j >> 2) + 4 * kg + (j & 3); const bool ok = !((used >> j) & 1u) && (lg[j] > best || (lg[j] == best && e < bi)); best = ok ? lg[j] : best; bi = ok ? e : bi; }
#pragma unroll
            for (int off = 16; off <= 32; off <<= 1) { const float ov = __shfl_xor(best, off); const int oi = __shfl_xor(bi, off); const bool tk = ov > best || (ov == best && oi < bi); best = tk ? ov : best; bi = tk ? oi : bi; }
            tv[k] = best; ti[k] = bi;
#pragma unroll
            for (int j = 0; j < 8; ++j) { const int e = 16 * (j >> 2) + 4 * kg + (j & 3); if (e == bi) used |= 1u << j; }
        }
        const float e1 = __expf(tv[1] - tv[0]), e2 = __expf(tv[2] - tv[0]), e3 = __expf(tv[3] - tv[0]);
        const float inv = 1.f / (1.f + e1 + e2 + e3);
        {
            const int me = kg == 0 ? ti[0] : kg == 1 ? ti[1] : kg == 2 ? ti[2] : ti[3];
            const float mg = (kg == 0 ? 1.f : kg == 1 ? e1 : kg == 2 ? e2 : e3) * inv;
            const int pos = __hip_atomic_fetch_add(lcnt + me, 1, __ATOMIC_RELAXED, __HIP_MEMORY_SCOPE_WORKGROUP);
            ent_e[tl * 4 + kg] = me; ent_p[tl * 4 + kg] = pos; GATE[t * 4 + kg] = mg;
        }
        __syncthreads();
        if (F.tid() < 32) lbase[F.tid()] = atomicAdd(CNT + F.tid(), lcnt[F.tid()]);
        __syncthreads();
        { const int e = ent_e[F.tid()]; LIST[(size_t)e * NTOK + lbase[e] + ent_p[F.tid()]] = (batch * 128 + (F.tid() >> 2)) * 4 + (F.tid() & 3); }
    }
}

#undef P4_CH
__device__ __forceinline__ void p7_final(const Frame& F, const Args& a) {
    const u16* H1 = (const u16*)(a.ws + WS_H1); const unsigned char* YS = a.ws + WS_YS; const float* g2 = a.in[19]; const float* b2 = a.in[20];
    const int lane = lane_id(), gw = F.bid * NWAVES + F.wave, NGW = F.G * NWAVES;
    typedef float f32x2 __attribute__((ext_vector_type(2)));
    for (int t = gw; t < NTOK; t += NGW) {
        float v[16]; float s = 0.f;
        unsigned y[4][4];
#pragma unroll
        for (int k = 0; k < 4; ++k)
#pragma unroll
            for (int j = 0; j < 4; ++j) y[k][j] = ((const unsigned*)(YS + ((size_t)t * 4 + k) * DM) + lane)[64 * j];
#pragma unroll
        for (int j = 0; j < 4; ++j) {
            const u32x2 w = ((const u32x2*)(H1 + (size_t)t * DM) + lane)[64 * j];
            float a0 = 0.f, a1 = 0.f, a2 = 0.f, a3 = 0.f;
#pragma unroll
            for (int k = 0; k < 4; ++k) {
                const f32x2 lo = __builtin_amdgcn_cvt_pk_f32_fp8((int)y[k][j], false), hi = __builtin_amdgcn_cvt_pk_f32_fp8((int)y[k][j], true);
                a0 += lo.x; a1 += lo.y; a2 += hi.x; a3 += hi.y;
            }
            a0 = fmaf(a0, 1.0f / 64.0f, DN_ALPHA * __uint_as_float(w.x << 16)); a1 = fmaf(a1, 1.0f / 64.0f, DN_ALPHA * __uint_as_float(w.x & 0xffff0000u));
            a2 = fmaf(a2, 1.0f / 64.0f, DN_ALPHA * __uint_as_float(w.y << 16)); a3 = fmaf(a3, 1.0f / 64.0f, DN_ALPHA * __uint_as_float(w.y & 0xffff0000u));
            v[4 * j] = a0; v[4 * j + 1] = a1; v[4 * j + 2] = a2; v[4 * j + 3] = a3; s += (a0 + a1) + (a2 + a3);
        }
        const float mean = wave_sum(s) * (1.f / DM); float s2 = 0.f;
#pragma unroll
        for (int i = 0; i < 16; ++i) { v[i] -= mean; s2 += v[i] * v[i]; }
        const float rstd = 1.f / sqrtf(wave_sum(s2) * (1.f / DM) + LN_EPS);
        f32x4* o = (f32x4*)(a.out + (size_t)t * DM) + lane;
#pragma unroll
        for (int j = 0; j < 4; ++j) {
            const f32x4 gg = ((const f32x4*)g2)[lane + 64 * j], bb = ((const f32x4*)b2)[lane + 64 * j];
            o[64 * j] = (f32x4){v[4 * j] * rstd * gg.x + bb.x, v[4 * j + 1] * rstd * gg.y + bb.y, v[4 * j + 2] * rstd * gg.z + bb.z, v[4 * j + 3] * rstd * gg.w + bb.w};
        }
    }
}


namespace att {
typedef float f32x16 __attribute__((ext_vector_type(16)));
typedef short s16x4 __attribute__((ext_vector_type(4)));
typedef short v4i16_t __attribute__((ext_vector_type(4)));
constexpr int KV_BUF = 32768, X_OFF = 65536, WSF_OFF = TAB_OFF, TBL_OFF = TAB_OFF + 2048;
constexpr float THR = 6.0f;
constexpr int SFX_OFF = TAB_OFF + 8192, DONE_OFF = TAB_OFF + 8192 + 2048;
__device__ __forceinline__ int crow(int r, int hi) { return (r & 3) + 8 * (r >> 2) + 4 * hi; }
__device__ __forceinline__ unsigned cvtpk(float lo, float hi) { typedef float f2 __attribute__((ext_vector_type(2))); typedef __bf16 b2 __attribute__((ext_vector_type(2))); f2 v = {lo, hi}; b2 b = __builtin_convertvector(v, b2); return __builtin_bit_cast(unsigned, b); }
__device__ __forceinline__ s16x4 vtr(LAS const unsigned char* p) { return __builtin_bit_cast(s16x4, __builtin_amdgcn_ds_read_tr16_b64_v4i16((LAS v4i16_t*)p)); }
__device__ __forceinline__ float swapmax(float m) { auto rr = __builtin_amdgcn_permlane32_swap(__float_as_uint(m), __float_as_uint(m), false, false); return fmaxf(__uint_as_float(rr[0]), __uint_as_float(rr[1])); }
__device__ __forceinline__ float swapsum(float m) { auto rr = __builtin_amdgcn_permlane32_swap(__float_as_uint(m), __float_as_uint(m), false, false); return __uint_as_float(rr[0]) + __uint_as_float(rr[1]); }

template <bool ISA>
__device__ __forceinline__ void attn_unit(const Frame& F, const u16* QKV, u16* O, int b, int hx, int jq, float lam, const float* subg, const float* relb, const float* KN) {
    constexpr int DVB = ISA ? 4 : 2;
    const int lane = lane_id(), w = F.wave, sub = w >> 2, rg = w & 3, r32 = lane & 31, hi = lane >> 5;
    const int q0 = jq * 128, cq = 2 * jq + (rg >> 1);
    const int qpos = q0 + rg * 32 + r32;
    const size_t tok0 = (size_t)b * SEQ;
    const int qcol = (ISA ? hx * 128 : 1536 + hx * 128) + sub * 64;
    const int kcol0 = ISA ? 512 + hx * 128 : 2048 + hx * 128, vcol0 = ISA ? 1024 + hx * 128 : 2560 + hx * 128;
    const int ktop = 2 * jq + 1, kbot = ISA ? 0 : (2 * jq - 8 > 0 ? 2 * jq - 8 : 0);
    const int NTs = ktop - kbot + 1;
    LAS unsigned char* lds = F.lds;
    unsigned soff[2];
#pragma unroll
    for (int i = 0; i < 2; ++i) { const unsigned row = 4u * (8u * i + w) + (lane >> 4); const unsigned f = ((row & 3u) << 2) | ((row >> 2) & 3u); soff[i] = row * (QKVP * 2) + (((unsigned)lane & 15u) ^ f) * 16u; }
    const char* kvbase = (const char*)QKV + (tok0 * QKVP + kcol0) * 2;
    const unsigned ldsw = (unsigned)w * 1024u;
#define ATT_ISSUE(kt, buf) do { const char* kb_ = kvbase + (size_t)(kt) * 64 * QKVP * 2; const char* vb_ = kb_ + (vcol0 - kcol0) * 2; \
        _Pragma("unroll") for (int i_ = 0; i_ < 2; ++i_) { \
            __builtin_amdgcn_global_load_lds((const unsigned*)(kb_ + soff[i_]), (LAS unsigned*)(lds + (buf) * KV_BUF + i_ * 8192 + ldsw), 16, 0, 0); \
            __builtin_amdgcn_global_load_lds((const unsigned*)(vb_ + soff[i_]), (LAS unsigned*)(lds + (buf) * KV_BUF + 16384 + i_ * 8192 + ldsw), 16, 0, 0); } } while (0)
    ATT_ISSUE(ktop, 0);
    if (!ISA) {
        LAS float* tbl = (LAS float*)(lds + TBL_OFF);
        for (int i = F.tid(); i < 1280; i += NTHR) { const int hd = i / 640, idx = i % 640; int rel = idx - 64; rel = rel < -256 ? -256 : (rel > 256 ? 256 : rel); tbl[i] = relb[(2 * hx + hd) * 513 + rel + 256] * LOG2E; }
    }
    bf16x8 qf[4];
    { const u16* qp = QKV + (tok0 + q0 + rg * 32 + r32) * QKVP + qcol + 8 * hi;
#pragma unroll
      for (int s = 0; s < 4; ++s) qf[s] = *(const bf16x8*)(qp + 16 * s); }
    const unsigned fr_ = ((r32 & 3u) << 2) | ((r32 >> 2) & 3u);
    unsigned kad[4];
#pragma unroll
    for (int s = 0; s < 4; ++s) kad[s] = 256u * r32 + 16u * ((8u * sub + 2u * s + hi) ^ fr_);
    const unsigned qd = (lane & 15) >> 2, pd = lane & 3, blk = (lane >> 4) & 1, xlow = 2 * blk + (pd >> 1);
    unsigned vad[DVB][2];
#pragma unroll
    for (int c = 0; c < DVB; ++c)
#pragma unroll
        for (int t = 0; t < 2; ++t) { const unsigned ci = ISA ? (unsigned)c : (unsigned)(2 * sub + c);
            vad[c][t] = 2048u * t + 256u * (4u * hi + qd) + 64u * (ci ^ qd) + 16u * (xlow ^ ((2u * t + hi) & 3u)) + 8u * (pd & 1u); }
    const float sl2 = ISA ? exp2f(-2.0f * (float)(hx + 1)) * LOG2E : 0.f;
    LAS float* wsf = (LAS float*)(lds + WSF_OFF) + w * 64;
    float mrun = -INFINITY, lrun = 0.f;
    LAS float* sfx = (LAS float*)(lds + SFX_OFF) + w * 64;
    LAS int* donecnt = (LAS int*)(lds + DONE_OFF);
    bool wdone = false; float mlow = INFINITY;
    if (ISA) {
        float qq = 0.f;
#pragma unroll
        for (int s = 0; s < 4; ++s)
#pragma unroll
            for (int j = 0; j < 8; ++j) { const float x = bf2f((u16)qf[s][j]); qq = fmaf(x, x, qq); }
        qq = swapsum(qq);
#pragma unroll
        for (int o_ = 1; o_ < 32; o_ <<= 1) qq = fmaxf(qq, __shfl_xor(qq, o_));
        float kn = (lane <= ktop) ? KN[((size_t)b * 64 + lane) * 8 + hx * 2 + sub] : 0.f;
#pragma unroll
        for (int o_ = 1; o_ < 64; o_ <<= 1) { const float t_ = __shfl_up(kn, o_); if (lane >= o_) kn = fmaxf(kn, t_); }
        sfx[lane] = sqrtf(qq * kn) * 1.02f;
        if (w == 0 && lane < 3) donecnt[lane] = 0;
    }
    f32x16 o[DVB];
#pragma unroll
    for (int c = 0; c < DVB; ++c)
#pragma unroll
        for (int r = 0; r < 16; ++r) o[c][r] = 0.f;

    for (int i = 0; i < NTs; ++i) {
        const int kt = ktop - i, buf = i & 1;
        asm volatile("s_waitcnt vmcnt(0)" ::: "memory");
        __syncthreads();
        if (ISA) { if (i > 0 && __builtin_amdgcn_readfirstlane(donecnt[(i - 1) % 3]) == 8) break;
                   if (w == 0 && lane == 0) donecnt[(i + 1) % 3] = 0; }
        if (i + 1 < NTs) ATT_ISSUE(kt - 1, buf ^ 1);
        bool active = ISA ? (kt <= cq) : (kt <= cq && kt >= cq - 8);
        if (ISA && active && !wdone && kt < cq) {
            const float bnd = sfx[kt] + sl2 * (float)(kt * 64 + 63 - (q0 + rg * 32)) - mlow;
            if (bnd < -150.0f) wdone = true;
        }
        if (ISA && wdone) { active = false; if (lane == 0) __hip_atomic_fetch_add(donecnt + (i % 3), 1, __ATOMIC_RELAXED, __HIP_MEMORY_SCOPE_WORKGROUP); }
        if (active) {
            LAS const unsigned char* kbuf = lds + buf * KV_BUF; LAS const unsigned char* vbuf = kbuf + 16384;
            f32x16 p0, p1;
#pragma unroll
            for (int r = 0; r < 16; ++r) { p0[r] = 0.f; p1[r] = 0.f; }
#pragma unroll
            for (int s = 0; s < 4; ++s) {
                const bf16x8 k0 = *(const LAS bf16x8*)(kbuf + kad[s]);
                const bf16x8 k1 = *(const LAS bf16x8*)(kbuf + kad[s] + 8192);
                p0 = __builtin_amdgcn_mfma_f32_32x32x16_bf16(k0, qf[s], p0, 0, 0, 0);
                p1 = __builtin_amdgcn_mfma_f32_32x32x16_bf16(k1, qf[s], p1, 0, 0, 0);
            }
            if (ISA) {
                const float dl = (float)(kt * 64 + 4 * hi - qpos);
#pragma unroll
                for (int r = 0; r < 16; ++r) { const float kc = (float)((r & 3) + 8 * (r >> 2)); p0[r] = fmaf(-sl2, fabsf(dl + kc), p0[r]); p1[r] = fmaf(-sl2, fabsf(dl + kc + 32.0f), p1[r]); }
            } else {
                LAS const float* tb = (LAS const float*)(lds + TBL_OFF) + sub * 640 + (qpos + 64 - kt * 64 - 4 * hi - 63);
#pragma unroll
                for (int r = 0; r < 16; ++r) { const int kc = (r & 3) + 8 * (r >> 2); p0[r] += tb[63 - kc]; p1[r] += tb[63 - 32 - kc]; }
            }
            float mx = fmaxf(p0[0], p1[0]);
#pragma unroll
            for (int r = 1; r < 16; ++r) mx = fmaxf(mx, fmaxf(p0[r], p1[r]));
            const float mt = swapmax(mx);
            if (__any(mt > mrun + THR)) {
                const float mnew = fmaxf(mrun, mt), alpha = __builtin_amdgcn_exp2f(mrun - mnew);
                lrun *= alpha; mrun = mnew;
                if (ISA) { float ml = mrun;
#pragma unroll
                    for (int o_ = 1; o_ < 32; o_ <<= 1) ml = fminf(ml, __shfl_xor(ml, o_));
                    mlow = ml; }
                if (hi == 0) wsf[r32] = alpha;
#pragma unroll
                for (int r = 0; r < 16; ++r) { const float a_ = wsf[crow(r, hi)];
#pragma unroll
                    for (int c = 0; c < DVB; ++c) o[c][r] *= a_; }
            }
            float ps = 0.f;
#pragma unroll
            for (int r = 0; r < 16; ++r) { p0[r] = __builtin_amdgcn_exp2f(p0[r] - mrun); p1[r] = __builtin_amdgcn_exp2f(p1[r] - mrun); ps += p0[r] + p1[r]; }
            lrun += ps;
            u32x4 pw[4];
#pragma unroll
            for (int q = 0; q < 4; ++q) { pw[0][q] = cvtpk(p0[2 * q], p0[2 * q + 1]); pw[1][q] = cvtpk(p0[8 + 2 * q], p0[8 + 2 * q + 1]); pw[2][q] = cvtpk(p1[2 * q], p1[2 * q + 1]); pw[3][q] = cvtpk(p1[8 + 2 * q], p1[8 + 2 * q + 1]); }
#pragma unroll
            for (int c = 0; c < DVB; ++c)
#pragma unroll
                for (int ks = 0; ks < 4; ++ks) {
                    const s16x4 lo = vtr(vbuf + vad[c][0] + 4096 * ks), h4 = vtr(vbuf + vad[c][1] + 4096 * ks);
                    const bf16x8 vf = (bf16x8){lo[0], lo[1], lo[2], lo[3], h4[0], h4[1], h4[2], h4[3]};
                    o[c] = __builtin_amdgcn_mfma_f32_32x32x16_bf16(__builtin_bit_cast(bf16x8, pw[ks]), vf, o[c], 0, 0, 0);
                }
        }
    }
    asm volatile("s_waitcnt vmcnt(0)" ::: "memory");
    { const float lt = swapsum(lrun); const float inv = 1.0f / lt;
      if (hi == 0) wsf[r32] = inv;
#pragma unroll
      for (int r = 0; r < 16; ++r) { const float a_ = wsf[crow(r, hi)];
#pragma unroll
          for (int c = 0; c < DVB; ++c) o[c][r] *= a_; } }
    __syncthreads();
    if (ISA) {
        LAS float* X = (LAS float*)(lds + X_OFF) + rg * 4096;
        if (sub == 1) {
#pragma unroll
            for (int c = 0; c < 4; ++c)
#pragma unroll
                for (int r = 0; r < 16; ++r) X[(c * 16 + r) * 64 + lane] = o[c][r];
        }
        __syncthreads();
        if (sub == 0) {
            float ss[16];
#pragma unroll
            for (int r = 0; r < 16; ++r) ss[r] = 0.f;
#pragma unroll
            for (int c = 0; c < 4; ++c)
#pragma unroll
                for (int r = 0; r < 16; ++r) { const float y = o[c][r] - lam * X[(c * 16 + r) * 64 + lane]; o[c][r] = y; ss[r] += y * y; }
#pragma unroll
            for (int r = 0; r < 16; ++r) {
                float v = ss[r];
                v += __shfl_xor(v, 1); v += __shfl_xor(v, 2); v += __shfl_xor(v, 4); v += __shfl_xor(v, 8); v += __shfl_xor(v, 16);
                ss[r] = 0.8f / sqrtf(v * (1.0f / 128.0f) + 1e-5f);
            }
            float gg[4];
#pragma unroll
            for (int c = 0; c < 4; ++c) gg[c] = subg[32 * c + r32];
            LAS u16* stg = (LAS u16*)(lds + X_OFF + rg * 16384);
            asm volatile("s_waitcnt lgkmcnt(0)" ::: "memory");
#pragma unroll
            for (int c = 0; c < 4; ++c)
#pragma unroll
                for (int r = 0; r < 16; ++r) stg[crow(r, hi) * 128 + 32 * c + r32] = f2bf(o[c][r] * ss[r] * gg[c]);
            asm volatile("s_waitcnt lgkmcnt(0)" ::: "memory");
            u16* og = O + (tok0 + q0 + rg * 32) * DM + hx * 128;
#pragma unroll
            for (int i = 0; i < 8; ++i) { const int row = 4 * i + (lane >> 4), ch = lane & 15; const u32x4 v = *(const LAS u32x4*)((LAS const unsigned char*)stg + row * 256 + ch * 16); *(u32x4*)(og + (size_t)row * DM + ch * 8) = v; }
        }
    } else {
        LAS u16* stg = (LAS u16*)(lds + X_OFF + w * 4096);
#pragma unroll
        for (int c = 0; c < 2; ++c)
#pragma unroll
            for (int r = 0; r < 16; ++r) stg[crow(r, hi) * 64 + 32 * c + r32] = f2bf(o[c][r]);
        asm volatile("s_waitcnt lgkmcnt(0)" ::: "memory");
        u16* og = O + (tok0 + q0 + rg * 32) * DM + 512 + (2 * hx + sub) * 64;
#pragma unroll
        for (int i = 0; i < 4; ++i) { const int row = 8 * i + (lane >> 3), ch = lane & 7; const u32x4 v = *(const LAS u32x4*)((LAS const unsigned char*)stg + row * 128 + ch * 16); *(u32x4*)(og + (size_t)row * DM + ch * 8) = v; }
    }
    __syncthreads();
#undef ATT_ISSUE
}

__device__ __forceinline__ void p2_attention(const Frame& F, const Args& a) {
    const u16* QKV = (const u16*)(a.ws + WS_QKV); u16* O = (u16*)(a.ws + WS_O); const float* KN = (const float*)(a.ws + WS_KN);
    float d1 = 0.f, d2 = 0.f;
    for (int i = 0; i < 64; ++i) { d1 += a.in[4][i] * a.in[5][i]; d2 += a.in[6][i] * a.in[7][i]; }
    const float lam = expf(d1) - expf(d2) + 0.2f;
    int* Q = (int*)(F.ctl + CW_Q) + 64 * (F.bid & 7); int* CQ = (int*)(F.ctl + CW_CQ);
    volatile LAS int* slot = (volatile LAS int*)(F.lds + MISC_OFF + 128);
    const int b = F.bid & 7;
    constexpr int NCONV = 4, NBATCH_C = (P0_NITEMS - P0_DENSE_ITEMS) / 64;
    bool att_left = true, conv_left = true;
    const bool conv_first = (F.bid >> 3) < NCONV;
    bool do_conv = conv_first;
    while (att_left || conv_left) {
        if (do_conv && conv_left) {
            if (F.tid() == 0) *slot = atomicAdd(CQ, 1);
            __syncthreads();
            const int cb = __builtin_amdgcn_readfirstlane(*slot);
            __syncthreads();
            if (cb >= NBATCH_C) { conv_left = false; do_conv = false; continue; }
            LAS float* scr = (LAS float*)(F.lds + RING_OFF + F.wave * 8704);
            const int lane = lane_id();
            for (int j = 0; j < 8; ++j) p0_do_item(a, P0_DENSE_ITEMS + cb * 64 + F.wave * 8 + j, scr, lane);
            __syncthreads();
        } else if (att_left) {
            if (F.tid() == 0) *slot = atomicAdd(Q, 1);
            __syncthreads();
            const int idx = __builtin_amdgcn_readfirstlane(*slot);
            __syncthreads();
            if (idx >= 256) { att_left = false; do_conv = true; continue; }
            if (idx < 64) attn_unit<true>(F, QKV, O, b, 3 - (idx & 1), 31 - (idx >> 1), lam, a.in[8], a.in[9], KN);
            else if (idx < 96) attn_unit<true>(F, QKV, O, b, 1, 31 - (idx - 64), lam, a.in[8], a.in[9], KN);
            else if (idx < 128) attn_unit<true>(F, QKV, O, b, 0, 31 - (idx - 96), lam, a.in[8], a.in[9], KN);
            else { const int i2 = idx - 128; attn_unit<false>(F, QKV, O, b, i2 & 3, 31 - (i2 >> 2), lam, a.in[8], a.in[9], KN); }
        } else do_conv = true;
    }
}
}
#ifndef REP_MASK
#define REP_MASK 0
#endif
__global__ void __launch_bounds__(NTHR, 2) mk_fwd(Args args) {
    extern __shared__ __attribute__((aligned(16))) unsigned char lds_raw[];
    Frame F;
    F.lds = (LAS unsigned char*)lds_raw; F.MISC = (volatile LAS unsigned*)(F.lds + MISC_OFF);
    F.wave = __builtin_amdgcn_readfirstlane((int)threadIdx.x >> 6); F.G = gridDim.x; F.bid = blockIdx.x;
    F.ctl = (gu32*)(args.ws + WS_CTL);
    for (int u = F.tid(); u < 256; u += NTHR) ((LAS unsigned*)(F.lds + MISC_OFF))[u] = 0u;
    __syncthreads();
    const int lo = args.ph_lo, hi = args.ph_hi;
    const bool multi = (hi - lo) > 1;
    XcdBarrier bar; bar.bar = (unsigned*)(F.ctl + CW_BAR) + args.li * XCD_BAR_WORDS; bar.x = 0; bar.st = nullptr; bar.wave = F.wave;
    if (multi) bar = xcd_barrier_post((unsigned*)(F.ctl + CW_BAR) + args.li * XCD_BAR_WORDS, F.MISC + 8, F.wave);
#if defined(MEAS_PHASE)
    unsigned long long tp0_ = 0;
#define MEAS_T0() do { tp0_ = __builtin_amdgcn_s_memrealtime(); } while (0)
#define MEAS_T1(k) do { if (MEAS_PHASE == (k) && F.wave == 0 && lane_id() == 0) ((volatile LAS unsigned*)(F.lds + MISC_OFF))[16] += (unsigned)(__builtin_amdgcn_s_memrealtime() - tp0_); } while (0)
#else
#define MEAS_T0() do {} while (0)
#define MEAS_T1(k) do {} while (0)
#endif
#define IN(k) (lo <= (k) && (k) < hi)
#define SEAM(k) do { if (IN(k) && IN((k) + 1)) xcd_barrier(bar); } while (0)
    unsigned char* ws = args.ws;
    if (IN(0)) { MEAS_T0(); p0_prologue(F, args); if (REP_MASK & 1) p0_prologue(F, args); MEAS_T1(0); SEAM(0); }
    if (IN(1)) {
        MEAS_T0();
        PDense S; S.A = (const u16*)(ws + WS_H0); S.Bt = (const u16*)(ws + WS_WIN); S.out = (u16*)(ws + WS_QKV); S.H0 = nullptr; S.KN = (float*)(ws + WS_KN); S.mode = 0; S.ord.init(NTOK, QKVP, F.G, F.bid);
        pg8::gemm_phase(F.lds + RING_OFF, S, F.wave); if (REP_MASK & 2) pg8::gemm_phase(F.lds + RING_OFF, S, F.wave); MEAS_T1(1); SEAM(1);
    }
    if (IN(2)) {
        MEAS_T0(); att::p2_attention(F, args); MEAS_T1(2);
        SEAM(2); }
    if (IN(3)) {
        MEAS_T0();
        PDense S; S.A = (const u16*)(ws + WS_O); S.Bt = (const u16*)(ws + WS_WOUT); S.out = (u16*)(ws + WS_U); S.H0 = (const u16*)(ws + WS_H0); S.KN = nullptr; S.mode = 1; S.ord.init(NTOK, DM, F.G, F.bid);
        pg8::gemm_phase(F.lds + RING_OFF, S, F.wave); if (REP_MASK & 8) pg8::gemm_phase(F.lds + RING_OFF, S, F.wave); MEAS_T1(3); SEAM(3);
    }
    if (IN(4)) { MEAS_T0(); p4_router(F, args); MEAS_T1(4); SEAM(4); }
    if (IN(5)) {
        MEAS_T0();
        const MoeTab T = moe_tab(F.lds); moe_tables(T, (const int*)(F.ctl + CW_CNT), F.wave);
        PMoe<1> S; S.A = ws + WS_H1Q; S.Bt = ws + WS_W1; S.out = (void*)(ws + WS_ACT); S.list = (const int*)(ws + WS_LIST); S.gate = nullptr; S.bias = args.in[16]; S.T = T; S.c = F.bid; S.ntot = __builtin_amdgcn_readfirstlane(T.tb[NEXP]);
        S.prepare(F.wave);
        pg8::gemm_phase(F.lds + RING_OFF, S, F.wave); if (REP_MASK & 32) pg8::gemm_phase(F.lds + RING_OFF, S, F.wave); MEAS_T1(5); SEAM(5);
    }
    if (IN(6)) {
        MEAS_T0();
        const MoeTab T = moe_tab(F.lds); moe_tables(T, (const int*)(F.ctl + CW_CNT), F.wave);
        PMoe<0> S; S.A = ws + WS_ACT; S.Bt = ws + WS_W2; S.out = (void*)(ws + WS_YS); S.list = (const int*)(ws + WS_LIST); S.gate = (const float*)(ws + WS_GATE); S.bias = args.in[18]; S.T = T; S.c = F.bid; S.ntot = __builtin_amdgcn_readfirstlane(T.tb[NEXP]);
        S.prepare(F.wave);
        pg8::gemm_phase(F.lds + RING_OFF, S, F.wave); if (REP_MASK & 64) pg8::gemm_phase(F.lds + RING_OFF, S, F.wave); MEAS_T1(6); SEAM(6);
    }
    if (IN(7)) { MEAS_T0(); p7_final(F, args); if (REP_MASK & 128) p7_final(F, args); MEAS_T1(7); }
#if defined(MEAS_P4) && !defined(MEAS_PHASE)
#define MEAS_PHASE 99
#define MEAS_MUL 4
#endif
#if defined(MEAS_PHASE)
    { __syncthreads(); const unsigned acc_ = ((volatile LAS unsigned*)(F.lds + MISC_OFF))[16]; const unsigned long long t0_ = __builtin_amdgcn_s_memrealtime();
      while (__builtin_amdgcn_s_memrealtime() - t0_ < (unsigned long long)acc_ * MEAS_MUL) __builtin_amdgcn_s_sleep(16); }
#endif
#undef IN
#undef SEAM
}

extern "C" void kernel_launch(void* const* d_in, const int* in_sizes, int n_in, void* d_out, int out_size, void* d_ws, size_t ws_size, hipStream_t stream) {
    static int grid = 0;
    if (grid == 0) {
        if (n_in != 21 || in_sizes[0] != NTOK * DM || out_size != NTOK * DM || ws_size < WS_END) { fprintf(stderr, "kernel_launch: unexpected shapes / workspace (%d inputs, ws %zu)\n", n_in, ws_size); grid = -1; return; }
        int dev = 0, cus = 0, per_cu = 0;
        if (hipGetDevice(&dev) != hipSuccess || hipDeviceGetAttribute(&cus, hipDeviceAttributeMultiprocessorCount, dev) != hipSuccess) { grid = -1; return; }
        if (hipFuncSetAttribute((const void*)mk_fwd, hipFuncAttributeMaxDynamicSharedMemorySize, LDS_BYTES) != hipSuccess) { fprintf(stderr, "kernel_launch: hipFuncSetAttribute failed\n"); grid = -1; return; }
        if (hipOccupancyMaxActiveBlocksPerMultiprocessor(&per_cu, (const void*)mk_fwd, NTHR, LDS_BYTES) != hipSuccess || per_cu < 1) { fprintf(stderr, "kernel_launch: occupancy query says %d blocks per CU\n", per_cu); (void)hipGetLastError(); grid = -1; return; }
        if (cus < 256) { fprintf(stderr, "kernel_launch: needs 256 CUs, device has %d\n", cus); grid = -1; return; }
        grid = 256;
    }
    if (grid < 0) return;
    const float* lq1 = (const float*)d_in[4]; const float* lk1 = (const float*)d_in[5]; const float* lq2 = (const float*)d_in[6]; const float* lk2 = (const float*)d_in[7];
    const float* subg = (const float*)d_in[8]; const float* relb = (const float*)d_in[9];
    char* ws = (char*)d_ws;
    u16* QKV = (u16*)(ws + WS_QKV); u16* O = (u16*)(ws + WS_O);
    (void)hipMemsetAsync(ws + WS_CTL, 0, CTL_BYTES, stream);
    Args a{};
    for (int i = 0; i < 21; ++i) a.in[i] = (const float*)d_in[i];
    a.out = (float*)d_out; a.ws = (unsigned char*)d_ws;
    int nl = 0;
    auto run = [&](int lo, int hi) { a.ph_lo = lo; a.ph_hi = hi; a.li = nl++; hipLaunchKernelGGL(mk_fwd, dim3(grid), dim3(NTHR), LDS_BYTES, stream, a); };
    run(0, 8);
}
```

```cpp
#define REP_MASK 0
#include <hip/hip_runtime.h>
#include <cstdint>
#include <cstdio>

typedef unsigned short u16;
typedef short bf16x8 __attribute__((ext_vector_type(8)));
typedef float f32x4 __attribute__((ext_vector_type(4)));
typedef unsigned u32x4 __attribute__((ext_vector_type(4)));
typedef unsigned u32x2 __attribute__((ext_vector_type(2)));
#define LAS __attribute__((address_space(3)))

constexpr int NTOK = 32768, DM = 1024, SEQ = 4096, NBATCH = 8;
constexpr int QKVP = 3072;
constexpr int NEXP = 32;
constexpr float LOG2E = 1.4426950408889634f;
constexpr float QSCALE = 0.125f * LOG2E;
constexpr float DN_ALPHA = 1.189207115002721f;
constexpr float LN_EPS = 1e-5f;

constexpr size_t MiB = 1u << 20;
constexpr size_t WS_CTL = 0, CTL_BYTES = 1 * MiB;
constexpr size_t WS_RWT = 1 * MiB;
constexpr size_t WS_KN = 1 * MiB + 256 * 1024;
constexpr size_t WS_H1Q = 80 * MiB;
constexpr size_t WS_WIN = 2 * MiB, WS_WOUT = 8 * MiB, WS_W1 = 16 * MiB, WS_W2 = 144 * MiB;
constexpr size_t WS_H1 = 208 * MiB, WS_LIST = 272 * MiB, WS_GATE = 276 * MiB;
constexpr size_t WS_H0 = 280 * MiB, WS_QKV = 344 * MiB, WS_O = 536 * MiB, WS_U = 416 * MiB, WS_ACT = 280 * MiB;
constexpr size_t WS_YS = 600 * MiB, WS_END = 856 * MiB;

__device__ __forceinline__ float bf2f(u16 v) { return __uint_as_float((unsigned)v << 16); }
__device__ __forceinline__ u16 f2bf(float f) { unsigned u = __float_as_uint(f); return (u16)((u + 0x7fffu + ((u >> 16) & 1u)) >> 16); }
__device__ __forceinline__ unsigned pk2(float lo, float hi) { typedef float f2_ __attribute__((ext_vector_type(2))); typedef __bf16 b2_ __attribute__((ext_vector_type(2))); f2_ v = {lo, hi}; b2_ r = __builtin_convertvector(v, b2_); return __builtin_bit_cast(unsigned, r); }
__device__ __forceinline__ float wave_sum(float v) {
#pragma unroll
    for (int o = 1; o < 64; o <<= 1) v += __shfl_xor(v, o);
    return v;
}


#define GAS __attribute__((address_space(1)))
typedef GAS unsigned gu32;
#define RLX_AGENT __ATOMIC_RELAXED, __HIP_MEMORY_SCOPE_AGENT
#define LDS_WAIT() asm volatile("s_waitcnt lgkmcnt(0)" ::: "memory")
#define VM_WAIT() asm volatile("s_waitcnt vmcnt(0)" ::: "memory")

constexpr int NWAVES = 8, NTHR = 512;
__device__ __forceinline__ int lane_id() { int l; asm volatile("v_mbcnt_lo_u32_b32 %0, -1, 0\n\tv_mbcnt_hi_u32_b32 %0, -1, %0" : "=v"(l)); return l; }
constexpr int RING_OFF = 0, RING_BYTES = 131072, TAB_OFF = 131072, TAB_BYTES = 24576, MISC_OFF = TAB_OFF + TAB_BYTES, LDS_BYTES = MISC_OFF + 1024;
constexpr int CW_CNT = 0;
constexpr int CW_Q = 2048;
constexpr int CW_CQ = 2048 + 64 * 8;
constexpr int CW_BAR = 4096;

#define XB_TMO      128
#define XB_XCNT(j)  (256  + 64 * (j))
#define XB_XSUB(j)  (1280 + 64 * (j))
#define XB_XGEN(j)  (2304 + 64 * (j))
#define XB_TOP      3328
#define XB_TOPGEN   3392
#define XCD_BAR_WORDS 3456
#define XB_SPIN_CAP (1u << 20)
__device__ __forceinline__ unsigned xb_ld(unsigned* p)              { return __hip_atomic_load(p, __ATOMIC_RELAXED, __HIP_MEMORY_SCOPE_AGENT); }
__device__ __forceinline__ unsigned xb_add(unsigned* p, unsigned v) { return __hip_atomic_fetch_add(p, v, __ATOMIC_RELAXED, __HIP_MEMORY_SCOPE_AGENT); }
__device__ __forceinline__ unsigned xb_xcc_id() { return (unsigned)__builtin_amdgcn_s_getreg((3 << 11) | 20) & 0xFu; }
#define XB_SPIN(cond, bar) do { unsigned _sp = 0; while (cond) { __builtin_amdgcn_s_sleep(1); \
    if ((++_sp & 255u) == 0u) { if (xb_ld(&(bar)[XB_TMO])) break; if (_sp > XB_SPIN_CAP) { atomicAdd(&(bar)[XB_TMO], 1u); break; } } } } while (0)
struct XcdBarrier { unsigned* bar; unsigned x; volatile LAS unsigned* st; int wave; };
__device__ __forceinline__ XcdBarrier xcd_barrier_post(unsigned* bar, volatile LAS unsigned* st, int wave) {
    XcdBarrier b; b.bar = bar; b.x = xb_xcc_id(); b.st = st; b.wave = wave;
    if (wave == 0 && lane_id() == 0) (void)xb_add(&bar[XB_XCNT(b.x)], 1u);
    return b;
}
__device__ __forceinline__ void xcd_barrier_complete(unsigned* bar, unsigned x, unsigned& nloc, unsigned& nx) {
    const unsigned G = gridDim.x * gridDim.y * gridDim.z;
    unsigned sum, cnt, mine, sp = 0u;
    for (;;) {
        sum = 0u; cnt = 0u; mine = 0u;
#pragma unroll
        for (unsigned j = 0; j < 16; ++j) { const unsigned c = xb_ld(&bar[XB_XCNT(j)]); sum += c; cnt += (c > 0u) ? 1u : 0u; mine = (j == x) ? c : mine; }
        if (sum == G) break;
        __builtin_amdgcn_s_sleep(1);
        if ((++sp & 255u) == 0u) { if (xb_ld(&bar[XB_TMO])) break; if (sp > XB_SPIN_CAP) { atomicAdd(&bar[XB_TMO], 1u); break; } }
    }
    nloc = mine > 0u ? mine : 1u; nx = cnt > 0u ? cnt : 1u;
}
__device__ __forceinline__ void xcd_barrier(const XcdBarrier& b) {
    asm volatile("s_waitcnt vmcnt(0)" ::: "memory");
    __syncthreads();
    if (b.wave == 0 && lane_id() == 0) {
        unsigned* bar = b.bar;
        __builtin_amdgcn_s_waitcnt(0);
        unsigned nloc = b.st[0], nx = b.st[1];
        if (nloc == 0u) { xcd_barrier_complete(bar, b.x, nloc, nx); b.st[0] = nloc; b.st[1] = nx; }
        const unsigned old = xb_add(&bar[XB_XSUB(b.x)], 1u);
        const unsigned gen = old / nloc;
        if (old + 1u == (gen + 1u) * nloc) {
            __builtin_amdgcn_fence(__ATOMIC_RELEASE, "agent");
            asm volatile("s_waitcnt vmcnt(0)" ::: "memory");
            const unsigned og = xb_add(&bar[XB_TOP], 1u);
            const unsigned tg = og / nx;
            if (og + 1u == (tg + 1u) * nx) xb_add(&bar[XB_TOPGEN], 1u);
            else XB_SPIN(xb_ld(&bar[XB_TOPGEN]) == tg, bar);
            __builtin_amdgcn_fence(__ATOMIC_ACQUIRE, "agent");
            xb_add(&bar[XB_XGEN(b.x)], 1u);
            asm volatile("s_waitcnt vmcnt(0)" ::: "memory");
        } else {
            XB_SPIN(xb_ld(&bar[XB_XGEN(b.x)]) == gen, bar);
            __builtin_amdgcn_fence(__ATOMIC_ACQUIRE, "agent");
            asm volatile("s_waitcnt vmcnt(0)" ::: "memory");
        }
    }
    __syncthreads();
}

namespace pg8 {
constexpr int BM = 256, BK = 64, HALF = 128, HTB = HALF * BK * 2, NXCD = 8, WGM = 8, KD = 1024, NT = KD / BK;
__host__ __device__ __forceinline__ int lds_byte(int r, int c) { return r * 128 + ((((c >> 3) ^ (r >> 1)) & 7) << 4) + (c & 7) * 2; }
__host__ __device__ __forceinline__ void stage_rc(int b, int& R, int& C) { R = b >> 7; C = ((((b >> 4) ^ (R >> 1)) & 7)) * 8; }
__host__ __device__ __forceinline__ int perm32(int rho) { const int n = rho >> 4, i = rho & 15; return 8 * (i >> 2) + 4 * n + (i & 3); }
__device__ __forceinline__ float clamp8(float x) { return __builtin_amdgcn_fmed3f(x, -448.0f, 448.0f); }
__device__ __forceinline__ unsigned cvt_pk_bf16(float lo, float hi) { unsigned r; asm volatile("v_cvt_pk_bf16_f32 %0, %1, %2" : "=v"(r) : "v"(lo), "v"(hi)); return r; }

typedef int v8i32 __attribute__((ext_vector_type(8)));
struct Unit { int pm, pn, e, idx; };

struct StaticOrder {
    int nM, nN, nwg, G, c;
    __device__ void init(int M, int N, int G_, int c_) { nM = M / BM; nN = N / BM; nwg = nM * nN; G = G_; c = c_; }
    __device__ bool next(int i, Unit& u) const {
        const long L = (long)i * G + c; if (L >= nwg) return false;
        int wgid = (int)L; { const int q = nwg / NXCD, r = nwg % NXCD, xcd = wgid % NXCD, off = wgid / NXCD; wgid = (xcd < r ? xcd * (q + 1) : r * (q + 1) + (xcd - r) * q) + off; }
        const int nig = WGM * nN, gid = wgid / nig, fm = gid * WGM, gsz = (nM - fm) < WGM ? (nM - fm) : WGM;
        u.pm = fm + ((wgid % nig) % gsz); u.pn = (wgid % nig) / gsz; u.e = 0; u.idx = i; return true;
    }
};

template <class P>
__device__ __forceinline__ void gemm_phase(LAS unsigned char* lds, const P& S, int wave) {
    const int wid = wave, lane = lane_id(), tid = wid * 64 + lane, wr = wid >> 2, wc = wid & 3, fr = lane & 15, fq = lane >> 4;
    constexpr int KB = P::FP8 ? 1024 : 2048, nt = KB / 128;
    int Rr0, Cc0; unsigned voffB0;
    { int R, C; stage_rc(tid * 16, R, C); const int Rb = 64 * (R >> 5) + perm32(R & 31); Rr0 = R; Cc0 = C; voffB0 = (unsigned)(Rb * KB + C * 2); }
    constexpr unsigned kstep = (unsigned)(BK * 2);
    constexpr unsigned hstep = 32u * KB;
    const __amdgpu_buffer_rsrc_t rA = __builtin_amdgcn_make_buffer_rsrc((void*)S.a_ptr(), 0, 0x7fffffff, 0x00020000), rB = __builtin_amdgcn_make_buffer_rsrc((void*)S.b_ptr(), 0, 0x7fffffff, 0x00020000);
    const unsigned ldsw = (unsigned)wid * 1024u;
    const int aoff[2] = {lds_byte(wr * 64 + fr, fq * 8), lds_byte(wr * 64 + fr, fq * 8 + 32)}, boff[2] = {lds_byte(wc * 32 + fr, fq * 8), lds_byte(wc * 32 + fr, fq * 8 + 32)};
#define PG8_SA(b, h) (((b) * 2 + (h)) * HTB)
#define PG8_SB(b, h) ((4 + (b) * 2 + (h)) * HTB)
#define PG8_STAGE(bufoff, rs, sbase, voff) do { _Pragma("unroll") for (int _i = 0; _i < 2; ++_i) \
        __builtin_amdgcn_raw_ptr_buffer_load_lds(rs, (LAS unsigned*)(lds + (bufoff) + ldsw + _i * 8192), 16, (int)(voff), (int)((sbase) + (unsigned)(_i * 128 * KB)), 0, 0); } while (0)
#define PG8_STAGE_A(bufoff, sbase, un, h) do { _Pragma("unroll") for (int _i = 0; _i < 2; ++_i) \
        __builtin_amdgcn_raw_ptr_buffer_load_lds(rA, (LAS unsigned*)(lds + (bufoff) + ldsw + _i * 8192), 16, (int)S.a_off1(un, h, Rr0 + 64 * _i, Cc0), (int)(sbase), 0, 0); } while (0)
#define PG8_AOFF(vo, un, h) unsigned vo[2] = {0u, 0u}; if constexpr (P::GATHER) { vo[0] = S.a_off1(un, h, Rr0, 0); vo[1] = S.a_off1(un, h, Rr0 + 64, 0); }
#define PG8_STAGE_AV(bufoff, sbase, vo, un, h) do { if constexpr (P::GATHER) { _Pragma("unroll") for (int _i = 0; _i < 2; ++_i) \
        __builtin_amdgcn_raw_ptr_buffer_load_lds(rA, (LAS unsigned*)(lds + (bufoff) + ldsw + _i * 8192), 16, (int)((vo)[_i] + (unsigned)Cc0 * 2u), (int)(sbase), 0, 0); } \
        else PG8_STAGE_A(bufoff, sbase, un, h); } while (0)
#define PG8_LDA(dst, b, h) do { _Pragma("unroll") for (int m = 0; m < 4; ++m) _Pragma("unroll") for (int k = 0; k < 2; ++k) dst[m][k] = *(const LAS bf16x8*)(lds + PG8_SA(b, h) + aoff[k] + m * 2048); } while (0)
#define PG8_LDB(dst, b, h) do { _Pragma("unroll") for (int n = 0; n < 2; ++n) _Pragma("unroll") for (int k = 0; k < 2; ++k) dst[n][k] = *(const LAS bf16x8*)(lds + PG8_SB(b, h) + boff[k] + n * 2048); } while (0)
#define PG8_CAT(x) __builtin_bit_cast(v8i32, __builtin_shufflevector((x)[0], (x)[1], 0, 1, 2, 3, 4, 5, 6, 7, 8, 9, 10, 11, 12, 13, 14, 15))
#define PG8_MMA(ai, bj, At, Bt) do { __builtin_amdgcn_sched_barrier(0); __builtin_amdgcn_s_setprio(1); \
        if constexpr (P::FP8) { _Pragma("unroll") for (int m = 0; m < 4; ++m) _Pragma("unroll") for (int n = 0; n < 2; ++n) \
            acc[ai][bj][m][n] = __builtin_amdgcn_mfma_scale_f32_16x16x128_f8f6f4(PG8_CAT(Bt[n]), PG8_CAT(At[m]), acc[ai][bj][m][n], 0, 0, 0, P::SCALE_B, 0, P::SCALE_A); } \
        else { _Pragma("unroll") for (int m = 0; m < 4; ++m) _Pragma("unroll") for (int n = 0; n < 2; ++n) _Pragma("unroll") for (int k = 0; k < 2; ++k) \
            acc[ai][bj][m][n] = __builtin_amdgcn_mfma_f32_16x16x32_bf16(Bt[n][k], At[m][k], acc[ai][bj][m][n], 0, 0, 0); } \
        __builtin_amdgcn_s_setprio(0); __builtin_amdgcn_sched_barrier(0); } while (0)
#define PG8_WAIT_V(n) asm volatile("s_waitcnt vmcnt(" #n ")" ::: "memory")
#define PG8_WAIT_L(n) asm volatile("s_waitcnt lgkmcnt(" #n ")" ::: "memory")
#define PG8_BAR __builtin_amdgcn_s_barrier()
#define PG8_SCHED __builtin_amdgcn_sched_barrier(0)
    Unit cur, nxt; int ui = 0;
    if (!S.next(0, cur)) return;
    f32x4 acc[2][2][4][2];
#pragma unroll
    for (int a = 0; a < 2; ++a)
#pragma unroll
        for (int b = 0; b < 2; ++b)
#pragma unroll
            for (int m = 0; m < 4; ++m)
#pragma unroll
                for (int n = 0; n < 2; ++n) acc[a][b][m][n] = (f32x4){0.f, 0.f, 0.f, 0.f};
    bf16x8 At[4][2], B0[2][2], B1[2][2];
    unsigned cA = S.a_base(cur), cB = S.b_base(cur);
    PG8_STAGE(PG8_SB(0, 0), rB, cB, voffB0); PG8_STAGE(PG8_SB(0, 1), rB, cB + hstep, voffB0); PG8_STAGE_A(PG8_SA(0, 0), cA, cur, 0); PG8_STAGE_A(PG8_SA(0, 1), cA, cur, 1);
    if (wr == 1) PG8_BAR;
    PG8_WAIT_V(2); PG8_BAR;
    PG8_STAGE(PG8_SB(1, 0), rB, cB + kstep, voffB0); PG8_STAGE_A(PG8_SA(1, 0), cA + kstep, cur, 0); PG8_STAGE(PG8_SB(1, 1), rB, cB + hstep + kstep, voffB0);
    PG8_WAIT_V(6); PG8_BAR;
    for (;;) {
        const bool has_next = S.next(ui + 1, nxt);
        const unsigned nA = has_next ? S.a_base(nxt) : cA, nB = has_next ? S.b_base(nxt) : cB;
#pragma unroll 1
        for (int t = 0; t < nt; t += 2) {
            const bool last = (t == nt - 2);
            const unsigned a1 = cA + (unsigned)(t + 1) * kstep;
            const unsigned a2 = last ? nA : cA + (unsigned)(t + 2) * kstep, b2 = last ? nB : cB + (unsigned)(t + 2) * kstep;
            const unsigned a3 = a2 + kstep, b3 = b2 + kstep;
            Unit un2; { const bool nx_ = last && has_next; un2.pm = nx_ ? nxt.pm : cur.pm; un2.pn = nx_ ? nxt.pn : cur.pn; un2.e = nx_ ? nxt.e : cur.e; un2.idx = nx_ ? nxt.idx : cur.idx; }
            { PG8_AOFF(vo_, cur, 1); PG8_LDB(B0, 0, 0); PG8_LDB(B1, 0, 1); PG8_SCHED; PG8_LDA(At, 0, 0); PG8_STAGE_AV(PG8_SA(1, 1), a1, vo_, cur, 1); }
            PG8_WAIT_V(8); PG8_WAIT_L(0); PG8_BAR; PG8_MMA(0, 0, At, B0); PG8_MMA(0, 1, At, B1); PG8_BAR; PG8_SCHED;
            { PG8_AOFF(vo_, un2, 0); PG8_LDA(At, 0, 1); PG8_STAGE(PG8_SB(0, 0), rB, b2, voffB0); PG8_STAGE(PG8_SB(0, 1), rB, b2 + hstep, voffB0); PG8_STAGE_AV(PG8_SA(0, 0), a2, vo_, un2, 0); }
            PG8_WAIT_V(8); PG8_WAIT_L(0); PG8_BAR; PG8_MMA(1, 0, At, B0); PG8_MMA(1, 1, At, B1); PG8_BAR; PG8_SCHED;
            { PG8_AOFF(vo_, un2, 1); PG8_LDB(B0, 1, 0); PG8_LDB(B1, 1, 1); PG8_SCHED; PG8_LDA(At, 1, 0); PG8_STAGE_AV(PG8_SA(0, 1), a2, vo_, un2, 1); }
            PG8_WAIT_V(8); PG8_WAIT_L(0); PG8_BAR; PG8_MMA(0, 0, At, B0); PG8_MMA(0, 1, At, B1); PG8_BAR; PG8_SCHED;
            { PG8_AOFF(vo_, un2, 0); PG8_LDA(At, 1, 1); PG8_STAGE(PG8_SB(1, 0), rB, b3, voffB0); PG8_STAGE(PG8_SB(1, 1), rB, b3 + hstep, voffB0); PG8_STAGE_AV(PG8_SA(1, 0), a3, vo_, un2, 0); }
            PG8_WAIT_V(8); PG8_WAIT_L(0); PG8_BAR; PG8_MMA(1, 0, At, B0); PG8_MMA(1, 1, At, B1); PG8_BAR; PG8_SCHED;
        }
        if (wr == 0) PG8_BAR;
        { const int le_ = lane_id(); S.epi(acc, cur, wr, wc, le_ & 15, le_ >> 4); }
        if (!has_next) break;
#pragma unroll
        for (int a = 0; a < 2; ++a)
#pragma unroll
            for (int b = 0; b < 2; ++b)
#pragma unroll
                for (int m = 0; m < 4; ++m)
#pragma unroll
                    for (int n = 0; n < 2; ++n) acc[a][b][m][n] = (f32x4){0.f, 0.f, 0.f, 0.f};
        cur = nxt; cA = nA; cB = nB; ++ui;
        if (wr == 1) PG8_BAR;
    }
    PG8_WAIT_V(0);
    PG8_BAR;
#undef PG8_SA
#undef PG8_SB
#undef PG8_STAGE
#undef PG8_STAGE_A
#undef PG8_AOFF
#undef PG8_STAGE_AV
#undef PG8_LDA
#undef PG8_LDB
#undef PG8_MMA
#undef PG8_CAT
#undef PG8_WAIT_V
#undef PG8_WAIT_L
#undef PG8_BAR
#undef PG8_SCHED
}
}

__device__ __forceinline__ u32x4 ror8(u32x4 v) { u32x4 r;
#pragma unroll
    for (int q = 0; q < 4; ++q) r[q] = (unsigned)__builtin_amdgcn_update_dpp(0, (int)v[q], 0x128, 0xf, 0xf, true);
    return r; }
struct PDense {
    static constexpr bool PERM = true, FP8 = false, GATHER = false; static constexpr int SCALE_A = 0, SCALE_B = 0;
    const u16* A; const u16* Bt; u16* out; const u16* H0; float* KN; int mode; pg8::StaticOrder ord;
    __device__ __forceinline__ bool next(int i, pg8::Unit& u) const { return ord.next(i, u); }
    __device__ __forceinline__ const void* a_ptr() const { return A; }
    __device__ __forceinline__ const void* b_ptr() const { return Bt; }
    __device__ __forceinline__ unsigned a_base(const pg8::Unit& u) const { return (unsigned)u.pm * 256u * 2048u; }
    __device__ __forceinline__ unsigned b_base(const pg8::Unit& u) const { return (unsigned)u.pn * 256u * 2048u; }
    __device__ __forceinline__ unsigned a_off1(const pg8::Unit&, int h, int R, int C) const { return (unsigned)((h * 128 + R) * 1024 + C) * 2u; }
    __device__ __forceinline__ void epi(const f32x4 (&acc)[2][2][4][2], const pg8::Unit& u, int wr, int wc, int fr, int fq) const {
        const int ldc = mode == 0 ? QKVP : DM;
        const float sc = (mode == 0 && (u.pn < 2 || u.pn == 6 || u.pn == 7)) ? QSCALE : 1.0f;
        const int hh = fr >> 3, frl = fr & 7;
        const int rowb = u.pm * 256 + wr * 64, colo = u.pn * 256 + wc * 64 + 8 * fq;
        const bool knorm = (mode == 0) && (u.pn == 2 || u.pn == 3);
#pragma unroll
        for (int ai = 0; ai < 2; ++ai) {
            float cmx = 0.f;
#pragma unroll
            for (int m = 0; m < 4; ++m) {
                if (knorm) { float nr = 0.f;
#pragma unroll
                    for (int bj = 0; bj < 2; ++bj) { const f32x4 x0 = acc[ai][bj][m][0], x1 = acc[ai][bj][m][1]; nr += (x0[0] * x0[0] + x0[1] * x0[1]) + (x0[2] * x0[2] + x0[3] * x0[3]) + (x1[0] * x1[0] + x1[1] * x1[1]) + (x1[2] * x1[2] + x1[3] * x1[3]); }
                    nr += __shfl_xor(nr, 16); nr += __shfl_xor(nr, 32);
#pragma unroll
                    for (int o_ = 1; o_ < 16; o_ <<= 1) nr = fmaxf(nr, __shfl_xor(nr, o_));
                    cmx = fmaxf(cmx, nr); }
                u32x4 W[2];
#pragma unroll
                for (int bj = 0; bj < 2; ++bj) {
                    f32x4 v0 = acc[ai][bj][m][0] * sc, v1 = acc[ai][bj][m][1] * sc;
                    if (mode == 1) {
                        const u32x4 h = *(const u32x4*)(H0 + (size_t)(rowb + ai * 128 + m * 16 + fr) * DM + colo + 32 * bj);
                        v0[0] += DN_ALPHA * __uint_as_float(h.x << 16); v0[1] += DN_ALPHA * __uint_as_float(h.x & 0xffff0000u); v0[2] += DN_ALPHA * __uint_as_float(h.y << 16); v0[3] += DN_ALPHA * __uint_as_float(h.y & 0xffff0000u);
                        v1[0] += DN_ALPHA * __uint_as_float(h.z << 16); v1[1] += DN_ALPHA * __uint_as_float(h.z & 0xffff0000u); v1[2] += DN_ALPHA * __uint_as_float(h.w << 16); v1[3] += DN_ALPHA * __uint_as_float(h.w & 0xffff0000u);
                    }
                    W[bj].x = pg8::cvt_pk_bf16(v0[0], v0[1]); W[bj].y = pg8::cvt_pk_bf16(v0[2], v0[3]); W[bj].z = pg8::cvt_pk_bf16(v1[0], v1[1]); W[bj].w = pg8::cvt_pk_bf16(v1[2], v1[3]);
                }
                const u32x4 rcv = ror8(hh ? W[0] : W[1]);
                const u32x4 s1 = hh ? rcv : W[0], s2 = hh ? W[1] : rcv;
                u16* p1 = out + (size_t)(rowb + ai * 128 + m * 16 + frl) * ldc + colo + 32 * hh;
                *(u32x4*)p1 = s1; *(u32x4*)(p1 + (size_t)8 * ldc) = s2;
            }
            if (knorm && fr == 0 && fq == 0) KN[(size_t)(u.pm * 4 + ai * 2 + wr) * 8 + (u.pn - 2) * 4 + wc] = cmx;
        }
    }
};

struct MoeTab { LAS int* tb; LAS int* cn; LAS int* rowoff; };
__device__ __forceinline__ MoeTab moe_tab(LAS unsigned char* lds) { MoeTab t; t.rowoff = (LAS int*)(lds + TAB_OFF); t.tb = (LAS int*)(lds + TAB_OFF + 20480); t.cn = t.tb + 40; return t; }
__device__ __forceinline__ void moe_tables(const MoeTab& T, const int* cnt, int wave) {
    if (wave == 0 && lane_id() == 0) { int s = 0; for (int e = 0; e < NEXP; ++e) { const int c = __hip_atomic_load(cnt + e, RLX_AGENT); T.cn[e] = c; T.tb[e] = s; s += (c + 255) >> 8; } T.tb[NEXP] = s; }
    __syncthreads();
}
__device__ __forceinline__ int moe_find_e(const MoeTab& T, int RT) { int e = 0; while (e < NEXP - 1 && RT >= T.tb[e + 1]) ++e; return e; }

template <int UP>
struct PMoe {
    static constexpr bool PERM = true, FP8 = true, GATHER = (UP != 0); static constexpr int SCALE_A = UP ? 0x7c7c7c7c : 0x7d7d7d7d, SCALE_B = UP ? 0x75757575 : 0x74747474;
    static constexpr int NPN = UP ? 8 : 4, RPG = UP ? 4 : 8;
    const unsigned char* A; const unsigned char* Bt; void* out; const int* list; const float* gate; const float* bias; MoeTab T; int c, ntot;
    __device__ __forceinline__ bool next(int i, pg8::Unit& u) const {
        const int x = c & 7, s = c >> 3; const int RT = (i * 8 + x) * RPG + (s % RPG);
        if (RT >= ntot) return false;
        u.pm = RT; u.pn = s / RPG; u.e = moe_find_e(T, RT); u.idx = i; return true;
    }
    __device__ __forceinline__ const void* a_ptr() const { return A; }
    __device__ __forceinline__ const void* b_ptr() const { return Bt; }
    __device__ __forceinline__ unsigned a_base(const pg8::Unit& u) const { return UP ? 0u : (unsigned)u.pm * 256u * 1024u; }
    __device__ __forceinline__ unsigned b_base(const pg8::Unit& u) const { return ((unsigned)u.e * (UP ? 2048u : 1024u) + (unsigned)u.pn * 256u) * 1024u; }
    __device__ __forceinline__ unsigned a_off1(const pg8::Unit& u, int h, int R, int C) const { return UP ? (unsigned)T.rowoff[u.idx * 256 + h * 128 + R] + (unsigned)C * 2u : (unsigned)((h * 128 + R) * 1024 + C * 2); }
    __device__ __forceinline__ void prepare(int wave) const {
        const int tidx = wave * 64 + lane_id();
        pg8::Unit u;
        if (UP) {
            for (int i = 0; next(i, u); ++i) {
                if (tidx < 256) { const int r = (u.pm - T.tb[u.e]) * 256 + tidx; const int ent = list[(size_t)u.e * NTOK + (r < T.cn[u.e] ? r : 0)]; T.rowoff[i * 256 + tidx] = (ent >> 2) * 1024; }
            }
        } else {
            for (int i = 0; next(i, u); ++i) {
                if (tidx < 256) { const int r = (u.pm - T.tb[u.e]) * 256 + tidx; int ent = -1; float g = 0.f;
                    if (r < T.cn[u.e]) { ent = list[(size_t)u.e * NTOK + r]; g = gate[ent]; }
                    T.rowoff[i * 512 + tidx] = ent; ((LAS float*)T.rowoff)[i * 512 + 256 + tidx] = g; }
            }
        }
        __syncthreads();
    }
    __device__ __forceinline__ void epi(const f32x4 (&acc)[2][2][4][2], const pg8::Unit& u, int wr, int wc, int fr, int fq) const {
        const int colo = u.pn * 256 + wc * 64 + 8 * fq;
        if (UP) {
            const float* bp = bias + (size_t)u.e * 2048 + colo;
            f32x4 bv[2][2];
            const f32x4 mulv = {4.0f, 1.0f, 4.0f, 1.0f};
#pragma unroll
            for (int bj = 0; bj < 2; ++bj)
#pragma unroll
                for (int hq = 0; hq < 2; ++hq) { const f32x4 bb = *(const f32x4*)(bp + bj * 32 + 4 * hq); bv[bj][hq] = (f32x4){4.0f * bb[0], bb[1] + 1.0f, 4.0f * bb[2], bb[3] + 1.0f}; }
#pragma unroll
            for (int ai = 0; ai < 2; ++ai) {
                unsigned wv[2][4];
#pragma unroll
                for (int m = 0; m < 4; ++m)
#pragma unroll
                    for (int bj = 0; bj < 2; ++bj) {
                        const f32x4 v0 = acc[ai][bj][m][0] * mulv + bv[bj][0], v1 = acc[ai][bj][m][1] * mulv + bv[bj][1];
                        float a[4];
#pragma unroll
                        for (int p = 0; p < 4; ++p) {
                            const float glu4 = p < 2 ? v0[2 * p] : v1[2 * p - 4], lin1 = p < 2 ? v0[2 * p + 1] : v1[2 * p - 3];
                            const float xg4 = fminf(glu4, 28.0f), xl1 = __builtin_amdgcn_fmed3f(lin1, -6.0f, 8.0f);
                            a[p] = xg4 * __builtin_amdgcn_rcpf(1.0f + __builtin_amdgcn_exp2f((-1.702f * LOG2E * 0.25f) * xg4)) * xl1;
                        }
                        int w = __builtin_amdgcn_cvt_pk_fp8_f32(a[0], a[1], 0, false); w = __builtin_amdgcn_cvt_pk_fp8_f32(a[2], a[3], w, true);
                        wv[bj][m] = (unsigned)w;
                    }
#pragma unroll
                for (int bj = 0; bj < 2; ++bj) {
#pragma unroll
                    for (int m = 0; m < 2; ++m) { const auto r_ = __builtin_amdgcn_permlane32_swap(wv[bj][m], wv[bj][m + 2], false, false); wv[bj][m] = r_[0]; wv[bj][m + 2] = r_[1]; }
#pragma unroll
                    for (int m = 0; m < 4; m += 2) { const auto r_ = __builtin_amdgcn_permlane16_swap(wv[bj][m], wv[bj][m + 1], false, false); wv[bj][m] = r_[0]; wv[bj][m + 1] = r_[1]; }
                    unsigned char* rowp = (unsigned char*)out + (size_t)(u.pm * 256 + wr * 64 + ai * 128 + fq * 16 + fr) * 1024 + (u.pn * 128 + wc * 32) + bj * 16;
                    *(u32x4*)rowp = (u32x4){wv[bj][0], wv[bj][1], wv[bj][2], wv[bj][3]};
                }
            }
        } else {
            const float* bp = bias + (size_t)u.e * 1024 + colo;
            f32x4 bv[2][2];
#pragma unroll
            for (int bj = 0; bj < 2; ++bj) { bv[bj][0] = *(const f32x4*)(bp + bj * 32); bv[bj][1] = *(const f32x4*)(bp + bj * 32 + 4); }
            const int hh = fr >> 3, frl = fr & 7;
#pragma unroll
            for (int ai = 0; ai < 2; ++ai)
#pragma unroll
                for (int m = 0; m < 4; ++m) {
                    const int rlb = wr * 64 + ai * 128 + m * 16;
                    const float gt = ((LAS const float*)T.rowoff)[u.idx * 512 + 256 + rlb + fr];
                    const int e1 = T.rowoff[u.idx * 512 + rlb + frl], e2 = T.rowoff[u.idx * 512 + rlb + frl + 8];
                    u32x2 W[2];
#pragma unroll
                    for (int bj = 0; bj < 2; ++bj) {
                        const f32x4 v0 = (acc[ai][bj][m][0] + bv[bj][0]) * (gt * 64.0f), v1 = (acc[ai][bj][m][1] + bv[bj][1]) * (gt * 64.0f);
                        int w0 = __builtin_amdgcn_cvt_pk_fp8_f32(pg8::clamp8(v0[0]), pg8::clamp8(v0[1]), 0, false); w0 = __builtin_amdgcn_cvt_pk_fp8_f32(pg8::clamp8(v0[2]), pg8::clamp8(v0[3]), w0, true);
                        int w1 = __builtin_amdgcn_cvt_pk_fp8_f32(pg8::clamp8(v1[0]), pg8::clamp8(v1[1]), 0, false); w1 = __builtin_amdgcn_cvt_pk_fp8_f32(pg8::clamp8(v1[2]), pg8::clamp8(v1[3]), w1, true);
                        W[bj].x = (unsigned)w0; W[bj].y = (unsigned)w1;
                    }
                    u32x2 snd = hh ? W[0] : W[1], rcv;
                    rcv.x = (unsigned)__builtin_amdgcn_update_dpp(0, (int)snd.x, 0x128, 0xf, 0xf, true); rcv.y = (unsigned)__builtin_amdgcn_update_dpp(0, (int)snd.y, 0x128, 0xf, 0xf, true);
                    const u32x2 s1 = hh ? rcv : W[0], s2 = hh ? W[1] : rcv;
                    if (e1 >= 0) *(u32x2*)((unsigned char*)out + (size_t)e1 * 1024 + colo + 32 * hh) = s1;
                    if (e2 >= 0) *(u32x2*)((unsigned char*)out + (size_t)e2 * 1024 + colo + 32 * hh) = s2;
                }
        }
    }
};

struct Frame {
    LAS unsigned char* lds; volatile LAS unsigned* MISC; gu32* ctl; int wave, G, bid;
    __device__ __forceinline__ int tid() const { return wave * 64 + lane_id(); }
};
__device__ __forceinline__ void p0_transpose_item(const float* W, int K, int N, u16* WT, LAS float* scr, int item, int lane) {
    const int nblk = N / 32, kb = item / nblk, nb = item % nblk, k0 = 64 * kb, n0 = 32 * nb;
    f32x4 v[8];
#pragma unroll
    for (int it = 0; it < 8; ++it) v[it] = *(const f32x4*)(W + (size_t)(k0 + (lane >> 3) + 8 * it) * N + n0 + (lane & 7) * 4);
#pragma unroll
    for (int it = 0; it < 8; ++it) { const int k = (lane >> 3) + 8 * it, n4 = (lane & 7) * 4; scr[(n4 + 0) * 68 + k] = v[it].x; scr[(n4 + 1) * 68 + k] = v[it].y; scr[(n4 + 2) * 68 + k] = v[it].z; scr[(n4 + 3) * 68 + k] = v[it].w; }
    LDS_WAIT(); asm volatile("" ::: "memory");
#pragma unroll
    for (int it = 0; it < 4; ++it) {
        const int n = (lane >> 3) + 8 * it, c = lane & 7; const LAS float* s = scr + n * 68 + 8 * c;
        const f32x4 a = *(const LAS f32x4*)s, b = *(const LAS f32x4*)(s + 4);
        u32x4 o; o.x = pk2(a.x, a.y); o.y = pk2(a.z, a.w); o.z = pk2(b.x, b.y); o.w = pk2(b.z, b.w);
        *(u32x4*)(WT + (size_t)(n0 + n) * K + k0 + 8 * c) = o;
    }
    LDS_WAIT(); asm volatile("" ::: "memory");
}
__device__ __forceinline__ void p0_transpose_item_fp8(const float* W, int K, int N, unsigned char* WT, LAS float* scr, int item, int lane, float scale) {
    const int nblk = N / 32, kb = item / nblk, nb = item % nblk, k0 = 64 * kb, n0 = 32 * nb;
    f32x4 v[8];
#pragma unroll
    for (int it = 0; it < 8; ++it) v[it] = *(const f32x4*)(W + (size_t)(k0 + (lane >> 3) + 8 * it) * N + n0 + (lane & 7) * 4);
#pragma unroll
    for (int it = 0; it < 8; ++it) { const int k = (lane >> 3) + 8 * it, n4 = (lane & 7) * 4; scr[(n4 + 0) * 68 + k] = v[it].x; scr[(n4 + 1) * 68 + k] = v[it].y; scr[(n4 + 2) * 68 + k] = v[it].z; scr[(n4 + 3) * 68 + k] = v[it].w; }
    LDS_WAIT(); asm volatile("" ::: "memory");
#pragma unroll
    for (int it = 0; it < 2; ++it) {
        const int n = (lane >> 2) + 16 * it, c = lane & 3; const LAS float* s = scr + n * 68 + 16 * c;
        u32x4 o;
#pragma unroll
        for (int q = 0; q < 4; ++q) { f32x4 a = *(const LAS f32x4*)(s + 4 * q) * scale;
            a.x = fminf(fmaxf(a.x, -448.f), 448.f); a.y = fminf(fmaxf(a.y, -448.f), 448.f); a.z = fminf(fmaxf(a.z, -448.f), 448.f); a.w = fminf(fmaxf(a.w, -448.f), 448.f);
            int w = __builtin_amdgcn_cvt_pk_fp8_f32(a.x, a.y, 0, false); w = __builtin_amdgcn_cvt_pk_fp8_f32(a.z, a.w, w, true); o[q] = (unsigned)w; }
        *(u32x4*)(WT + (size_t)(n0 + n) * K + k0 + 16 * c) = o;
    }
    LDS_WAIT(); asm volatile("" ::: "memory");
}
__device__ __forceinline__ void ln_row_in(const float* xrow, const float* g, const float* b, u16* orow, int lane) {
    const f32x4* xr = (const f32x4*)xrow + lane;
    f32x4 v[4]; float s = 0.f;
#pragma unroll
    for (int j = 0; j < 4; ++j) { v[j] = xr[64 * j]; s += (v[j].x + v[j].y) + (v[j].z + v[j].w); }
    const float mean = wave_sum(s) * (1.f / DM); float s2 = 0.f;
#pragma unroll
    for (int j = 0; j < 4; ++j) { v[j] = v[j] - mean; s2 += (v[j].x * v[j].x + v[j].y * v[j].y) + (v[j].z * v[j].z + v[j].w * v[j].w); }
    const float rstd = 1.f / sqrtf(wave_sum(s2) * (1.f / DM) + LN_EPS);
    u32x2* o8 = (u32x2*)orow + lane;
#pragma unroll
    for (int j = 0; j < 4; ++j) {
        const f32x4 gg = ((const f32x4*)g)[lane + 64 * j], bb = ((const f32x4*)b)[lane + 64 * j];
        u32x2 w; w.x = pk2(v[j].x * rstd * gg.x + bb.x, v[j].y * rstd * gg.y + bb.y); w.y = pk2(v[j].z * rstd * gg.z + bb.z, v[j].w * rstd * gg.w + bb.w);
        o8[64 * j] = w;
    }
}

struct Args { const float* in[21]; float* out; unsigned char* ws; int ph_lo, ph_hi, li, pad; };

constexpr int P0_I_IN = 16 * 96, P0_I_OUT = 16 * 32, P0_I_W1 = 16 * 64, P0_I_W2 = 16 * 32;
constexpr int P0_DENSE_ITEMS = P0_I_IN + P0_I_OUT, P0_NITEMS = P0_DENSE_ITEMS + NEXP * P0_I_W1 + NEXP * P0_I_W2;
__device__ __forceinline__ void p0_do_item(const Args& a, int it, LAS float* scr, int lane) {
    unsigned char* ws = a.ws; int r = it;
    if (r < P0_I_IN) { p0_transpose_item(a.in[3], 1024, 3072, (u16*)(ws + WS_WIN), scr, r, lane); return; } r -= P0_I_IN;
    if (r < P0_I_OUT) { p0_transpose_item(a.in[10], 1024, 1024, (u16*)(ws + WS_WOUT), scr, r, lane); return; } r -= P0_I_OUT;
    if (r < NEXP * P0_I_W1) { const int e = r / P0_I_W1; p0_transpose_item_fp8(a.in[15] + (size_t)e * 1024 * 2048, 1024, 2048, ws + WS_W1 + (size_t)e * 1024 * 2048, scr, r % P0_I_W1, lane, 1024.0f); return; } r -= NEXP * P0_I_W1;
    { const int e = r / P0_I_W2; p0_transpose_item_fp8(a.in[17] + (size_t)e * 1024 * 1024, 1024, 1024, ws + WS_W2 + (size_t)e * 1024 * 1024, scr, r % P0_I_W2, lane, 2048.0f); }
}
__device__ __forceinline__ void cvt_batch8(const Args& a, int it0, LAS float* scr, int lane) {
    unsigned char* ws = a.ws;
    int r = it0 - P0_DENSE_ITEMS; const bool w1 = r < NEXP * P0_I_W1; if (!w1) r -= NEXP * P0_I_W1;
    const int per = w1 ? P0_I_W1 : P0_I_W2, e = r / per, q0 = r % per, N = w1 ? 2048 : 1024, nblk = N / 32;
    const float* W = (w1 ? a.in[15] : a.in[17]) + (size_t)e * 1024 * N;
    unsigned char* WT = ws + (w1 ? WS_W1 : WS_W2) + (size_t)e * 1024 * N;
    const float scale = w1 ? 1024.0f : 2048.0f;
    f32x4 va[8], vb[8];
#define CVT_LOAD(v, q) do { const int kb_ = (q) / nblk, nb_ = (q) % nblk; const float* s_ = W + (size_t)(64 * kb_ + (lane >> 3)) * N + 32 * nb_ + (lane & 7) * 4; \
        _Pragma("unroll") for (int it = 0; it < 8; ++it) v[it] = *(const f32x4*)(s_ + (size_t)(8 * it) * N); } while (0)
#define CVT_FIN(v, q) do { const int kb_ = (q) / nblk, nb_ = (q) % nblk; \
        _Pragma("unroll") for (int it = 0; it < 8; ++it) { const int k = (lane >> 3) + 8 * it, n4 = (lane & 7) * 4; scr[(n4 + 0) * 68 + k] = v[it].x; scr[(n4 + 1) * 68 + k] = v[it].y; scr[(n4 + 2) * 68 + k] = v[it].z; scr[(n4 + 3) * 68 + k] = v[it].w; } \
        LDS_WAIT(); asm volatile("" ::: "memory"); \
        _Pragma("unroll") for (int it = 0; it < 2; ++it) { const int n = (lane >> 2) + 16 * it, c = lane & 3; const LAS float* sp = scr + n * 68 + 16 * c; u32x4 o; \
            _Pragma("unroll") for (int qq = 0; qq < 4; ++qq) { f32x4 x = *(const LAS f32x4*)(sp + 4 * qq) * scale; \
                x.x = fminf(fmaxf(x.x, -448.f), 448.f); x.y = fminf(fmaxf(x.y, -448.f), 448.f); x.z = fminf(fmaxf(x.z, -448.f), 448.f); x.w = fminf(fmaxf(x.w, -448.f), 448.f); \
                int wd = __builtin_amdgcn_cvt_pk_fp8_f32(x.x, x.y, 0, false); wd = __builtin_amdgcn_cvt_pk_fp8_f32(x.z, x.w, wd, true); o[qq] = (unsigned)wd; } \
            *(u32x4*)(WT + (size_t)(32 * nb_ + n) * 1024 + 64 * kb_ + 16 * c) = o; } \
        LDS_WAIT(); asm volatile("" ::: "memory"); } while (0)
    CVT_LOAD(va, q0);
#pragma unroll 1
    for (int j = 0; j < 8; j += 2) {
        CVT_LOAD(vb, q0 + j + 1);
        CVT_FIN(va, q0 + j);
        if (j + 2 < 8) CVT_LOAD(va, q0 + j + 2);
        CVT_FIN(vb, q0 + j + 1);
    }
#undef CVT_LOAD
#undef CVT_FIN
}
__device__ __forceinline__ void p0_prologue(const Frame& F, const Args& a) {
    unsigned char* ws = a.ws;
    u16* H0 = (u16*)(ws + WS_H0);
    LAS float* scr = (LAS float*)(F.lds + RING_OFF + F.wave * 8704);
    const int gw = F.bid * NWAVES + F.wave, NGW = F.G * NWAVES;
    for (int it = gw; it < P0_DENSE_ITEMS; it += NGW) p0_do_item(a, it, scr, lane_id());
    { u16* RW = (u16*)(ws + WS_RWT); const float* rw = a.in[13];
      for (int idx = F.bid * NTHR + F.tid(); idx < 32768; idx += F.G * NTHR) { const int e = idx >> 10, k = idx & 1023; const float v = rw[k * 32 + e]; const u16 hi = f2bf(v); RW[idx] = hi; RW[32768 + idx] = f2bf(v - bf2f(hi)); } }
    for (int m = gw; m < NTOK; m += NGW) ln_row_in(a.in[0] + (size_t)m * DM, a.in[1], a.in[2], H0 + (size_t)m * DM, lane_id());
}

__device__ __forceinline__ void p4_router(const Frame& F, const Args& a) {
    unsigned char* ws = a.ws;
    const u16* U = (const u16*)(ws + WS_U); u16* H1 = (u16*)(ws + WS_H1); int* LIST = (int*)(ws + WS_LIST); float* GATE = (float*)(ws + WS_GATE); int* CNT = (int*)(F.ctl + CW_CNT);
    const float* g1 = a.in[11]; const float* b1 = a.in[12]; const float* rb = a.in[14];
    const u32x4* RWT = (const u32x4*)(ws + WS_RWT);
    LAS int* lcnt = (LAS int*)(F.lds + TAB_OFF); LAS int* lbase = lcnt + 32; LAS int* ent_e = lcnt + 64; LAS int* ent_p = ent_e + 512;
    const int lane = lane_id(), tok = lane & 15, kg = lane >> 4;
#if defined(MEAS_P4)
    const unsigned long long tq0_ = __builtin_amdgcn_s_memrealtime();
#endif
    LAS float* gl = (LAS float*)(F.lds + TAB_OFF + 8192); LAS float* bl = gl + 1024;
    for (int i = F.tid(); i < 1024; i += NTHR) { gl[i] = g1[i]; bl[i] = b1[i]; }
    for (int i = F.tid(); i < 8192; i += NTHR) { const int img = i >> 12, e = (i >> 7) & 31, c = i & 127; *(LAS u32x4*)(F.lds + RING_OFF + img * 65536 + e * 2048 + 16 * (c ^ (e & 15))) = RWT[i]; }
    for (int batch = F.bid; batch < NTOK / 128; batch += F.G) {
        __syncthreads();
        if (F.tid() < 32) lcnt[F.tid()] = 0;
        __syncthreads();
        LAS float* stat = (LAS float*)(F.lds + TAB_OFF + 16384) + F.wave * 32;
#pragma unroll 1
        for (int j2 = 0; j2 < 16; j2 += 2) {
            const int ta = batch * 128 + F.wave * 16 + j2;
            u32x2 wa[4], wb[4];
#pragma unroll
            for (int q = 0; q < 4; ++q) { wa[q] = ((const u32x2*)(U + (size_t)ta * DM) + lane)[64 * q]; wb[q] = ((const u32x2*)(U + (size_t)(ta + 1) * DM) + lane)[64 * q]; }
            float va[16], vb[16]; float sa = 0.f, sb = 0.f;
#pragma unroll
            for (int q = 0; q < 4; ++q) {
                va[4 * q] = __uint_as_float(wa[q].x << 16); va[4 * q + 1] = __uint_as_float(wa[q].x & 0xffff0000u); va[4 * q + 2] = __uint_as_float(wa[q].y << 16); va[4 * q + 3] = __uint_as_float(wa[q].y & 0xffff0000u);
                vb[4 * q] = __uint_as_float(wb[q].x << 16); vb[4 * q + 1] = __uint_as_float(wb[q].x & 0xffff0000u); vb[4 * q + 2] = __uint_as_float(wb[q].y << 16); vb[4 * q + 3] = __uint_as_float(wb[q].y & 0xffff0000u);
                sa += (va[4 * q] + va[4 * q + 1]) + (va[4 * q + 2] + va[4 * q + 3]); sb += (vb[4 * q] + vb[4 * q + 1]) + (vb[4 * q + 2] + vb[4 * q + 3]); }
            const float ma = wave_sum(sa) * (1.f / DM), mb = wave_sum(sb) * (1.f / DM); float qa = 0.f, qb = 0.f;
#pragma unroll
            for (int i = 0; i < 16; ++i) { va[i] -= ma; vb[i] -= mb; qa += va[i] * va[i]; qb += vb[i] * vb[i]; }
            const float ra = 1.f / sqrtf(wave_sum(qa) * (1.f / DM) + LN_EPS), rb_ = 1.f / sqrtf(wave_sum(qb) * (1.f / DM) + LN_EPS);
            if (lane == 0) { stat[2 * j2] = ma; stat[2 * j2 + 1] = ra; stat[2 * j2 + 2] = mb; stat[2 * j2 + 3] = rb_; }
#pragma unroll
            for (int q = 0; q < 4; ++q) {
                const f32x4 gg = *(const LAS f32x4*)(gl + lane * 4 + 256 * q), bb = *(const LAS f32x4*)(bl + lane * 4 + 256 * q);
                int w0 = __builtin_amdgcn_cvt_pk_fp8_f32(pg8::clamp8((va[4 * q] * ra * gg.x + bb.x) * 8.0f), pg8::clamp8((va[4 * q + 1] * ra * gg.y + bb.y) * 8.0f), 0, false);
                w0 = __builtin_amdgcn_cvt_pk_fp8_f32(pg8::clamp8((va[4 * q + 2] * ra * gg.z + bb.z) * 8.0f), pg8::clamp8((va[4 * q + 3] * ra * gg.w + bb.w) * 8.0f), w0, true);
                int w1 = __builtin_amdgcn_cvt_pk_fp8_f32(pg8::clamp8((vb[4 * q] * rb_ * gg.x + bb.x) * 8.0f), pg8::clamp8((vb[4 * q + 1] * rb_ * gg.y + bb.y) * 8.0f), 0, false);
                w1 = __builtin_amdgcn_cvt_pk_fp8_f32(pg8::clamp8((vb[4 * q + 2] * rb_ * gg.z + bb.z) * 8.0f), pg8::clamp8((vb[4 * q + 3] * rb_ * gg.w + bb.w) * 8.0f), w1, true);
                ((unsigned*)(ws + WS_H1Q + (size_t)ta * DM) + lane)[64 * q] = (unsigned)w0; ((unsigned*)(ws + WS_H1Q + (size_t)(ta + 1) * DM) + lane)[64 * q] = (unsigned)w1;
            }
        }
        asm volatile("s_waitcnt lgkmcnt(0)" ::: "memory");
        const int tl = F.wave * 16 + tok, t = batch * 128 + tl;
        const u32x4* ur = (const u32x4*)(U + (size_t)t * DM) + 2 * kg;
#define P4_CH(s) (8 * ((s) >> 1) + ((s) & 1))
        const float mean = stat[2 * tok], rstd = stat[2 * tok + 1];
        f32x4 acc[2];
        acc[0] = (f32x4){0.f, 0.f, 0.f, 0.f}; acc[1] = (f32x4){0.f, 0.f, 0.f, 0.f};
        LAS const unsigned char* wimg = F.lds + RING_OFF + tok * 2048;
        u32x4 wq[4];
#pragma unroll
        for (int j = 0; j < 4; ++j) wq[j] = ur[P4_CH(j)];
#pragma unroll 1
        for (int s4 = 0; s4 < 32; s4 += 4)
#pragma unroll
        for (int j = 0; j < 4; ++j) {
            const int s = s4 + j;
            const u32x4 w = wq[j];
            if (s4 + 4 < 32) wq[j] = ur[P4_CH(s + 4)];
            const f32x4 ga = *(const LAS f32x4*)(gl + 8 * (P4_CH(s) + 2 * kg)), gb = *(const LAS f32x4*)(gl + 8 * (P4_CH(s) + 2 * kg) + 4), ba = *(const LAS f32x4*)(bl + 8 * (P4_CH(s) + 2 * kg)), bb = *(const LAS f32x4*)(bl + 8 * (P4_CH(s) + 2 * kg) + 4);
            float h[8];
            h[0] = (__uint_as_float(w.x << 16) - mean) * rstd * ga.x + ba.x; h[1] = (__uint_as_float(w.x & 0xffff0000u) - mean) * rstd * ga.y + ba.y;
            h[2] = (__uint_as_float(w.y << 16) - mean) * rstd * ga.z + ba.z; h[3] = (__uint_as_float(w.y & 0xffff0000u) - mean) * rstd * ga.w + ba.w;
            h[4] = (__uint_as_float(w.z << 16) - mean) * rstd * gb.x + bb.x; h[5] = (__uint_as_float(w.z & 0xffff0000u) - mean) * rstd * gb.y + bb.y;
            h[6] = (__uint_as_float(w.w << 16) - mean) * rstd * gb.z + bb.z; h[7] = (__uint_as_float(w.w & 0xffff0000u) - mean) * rstd * gb.w + bb.w;
            u32x4 hh, hl;
            hh.x = pk2(h[0], h[1]); hh.y = pk2(h[2], h[3]); hh.z = pk2(h[4], h[5]); hh.w = pk2(h[6], h[7]);
            hl.x = pk2(h[0] - __uint_as_float(hh.x << 16), h[1] - __uint_as_float(hh.x & 0xffff0000u)); hl.y = pk2(h[2] - __uint_as_float(hh.y << 16), h[3] - __uint_as_float(hh.y & 0xffff0000u));
            hl.z = pk2(h[4] - __uint_as_float(hh.z << 16), h[5] - __uint_as_float(hh.z & 0xffff0000u)); hl.w = pk2(h[6] - __uint_as_float(hh.w << 16), h[7] - __uint_as_float(hh.w & 0xffff0000u));
            const bf16x8 bh = __builtin_bit_cast(bf16x8, hh), bl = __builtin_bit_cast(bf16x8, hl);
            const unsigned co = 16u * ((unsigned)(P4_CH(s) + 2 * kg) ^ (unsigned)tok);
#pragma unroll
            for (int eh = 0; eh < 2; ++eh) {
                const bf16x8 wh = *(const LAS bf16x8*)(wimg + eh * 32768 + co), wl = *(const LAS bf16x8*)(wimg + 65536 + eh * 32768 + co);
                acc[eh] = __builtin_amdgcn_mfma_f32_16x16x32_bf16(wh, bh, acc[eh], 0, 0, 0);
                acc[eh] = __builtin_amdgcn_mfma_f32_16x16x32_bf16(wl, bh, acc[eh], 0, 0, 0);
                acc[eh] = __builtin_amdgcn_mfma_f32_16x16x32_bf16(wh, bl, acc[eh], 0, 0, 0);
            }
        }
#if defined(MEAS_P4)
        if (MEAS_P4 == 2 && F.wave == 0 && lane == 0) ((volatile LAS unsigned*)(F.lds + MISC_OFF))[16] += (unsigned)(__builtin_amdgcn_s_memrealtime() - tq0_);
#endif
        float lg[8];
#pragma unroll
        for (int eh = 0; eh < 2; ++eh)
#pragma unroll
            for (int r = 0; r < 4; ++r) lg[eh * 4 + r] = acc[eh][r] + rb[16 * eh + 4 * kg + r];
        unsigned used = 0u; float tv[4]; int ti[4];
#pragma unroll
        for (int k = 0; k < 4; ++k) {
            float best = -INFINITY; int bi = 1 << 20;
#pragma unroll
            for (int j = 0; j < 8; ++j) { const int e = 16 * (j >> 2) + 4 * kg + (j & 3); const bool ok = !((used >> j) & 1u) && (lg[j] > best || (lg[j] == best && e < bi)); best = ok ? lg[j] : best; bi = ok ? e : bi; }
#pragma unroll
            for (int off = 16; off <= 32; off <<= 1) { const float ov = __shfl_xor(best, off); const int oi = __shfl_xor(bi, off); const bool tk = ov > best || (ov == best && oi < bi); best = tk ? ov : best; bi = tk ? oi : bi; }
            tv[k] = best; ti[k] = bi;
#pragma unroll
            for (int j = 0; j < 8; ++j) { const int e = 16 * (j >> 2) + 4 * kg + (j & 3); if (e == bi) used |= 1u << j; }
        }
        const float e1 = __expf(tv[1] - tv[0]), e2 = __expf(tv[2] - tv[0]), e3 = __expf(tv[3] - tv[0]);
        const float inv = 1.f / (1.f + e1 + e2 + e3);
        {
            const int me = kg == 0 ? ti[0] : kg == 1 ? ti[1] : kg == 2 ? ti[2] : ti[3];
            const float mg = (kg == 0 ? 1.f : kg == 1 ? e1 : kg == 2 ? e2 : e3) * inv;
            const int pos = __hip_atomic_fetch_add(lcnt + me, 1, __ATOMIC_RELAXED, __HIP_MEMORY_SCOPE_WORKGROUP);
            ent_e[tl * 4 + kg] = me; ent_p[tl * 4 + kg] = pos; GATE[t * 4 + kg] = mg;
        }
        __syncthreads();
        if (F.tid() < 32) lbase[F.tid()] = atomicAdd(CNT + F.tid(), lcnt[F.tid()]);
        __syncthreads();
        { const int e = ent_e[F.tid()]; LIST[(size_t)e * NTOK + lbase[e] + ent_p[F.tid()]] = (batch * 128 + (F.tid() >> 2)) * 4 + (F.tid() & 3); }
    }
}

#undef P4_CH
__device__ __forceinline__ void p7_final(const Frame& F, const Args& a) {
    const u16* U = (const u16*)(a.ws + WS_U); const unsigned char* YS = a.ws + WS_YS; const float* g1 = a.in[11]; const float* b1 = a.in[12]; const float* g2 = a.in[19]; const float* b2 = a.in[20];
    const int lane = lane_id(), gw = F.bid * NWAVES + F.wave, NGW = F.G * NWAVES;
    typedef float f32x2 __attribute__((ext_vector_type(2)));
    for (int t = gw; t < NTOK; t += NGW) {
        float v[16]; float s = 0.f;
        unsigned y[4][4];
#pragma unroll
        for (int k = 0; k < 4; ++k)
#pragma unroll
            for (int j = 0; j < 4; ++j) y[k][j] = ((const unsigned*)(YS + ((size_t)t * 4 + k) * DM) + lane)[64 * j];
#pragma unroll
        for (int j = 0; j < 4; ++j) { const u32x2 w = ((const u32x2*)(U + (size_t)t * DM) + lane)[64 * j];
            v[4 * j] = __uint_as_float(w.x << 16); v[4 * j + 1] = __uint_as_float(w.x & 0xffff0000u); v[4 * j + 2] = __uint_as_float(w.y << 16); v[4 * j + 3] = __uint_as_float(w.y & 0xffff0000u);
            s += (v[4 * j] + v[4 * j + 1]) + (v[4 * j + 2] + v[4 * j + 3]); }
        { const float mean1 = wave_sum(s) * (1.f / DM); float q = 0.f;
#pragma unroll
          for (int i = 0; i < 16; ++i) { v[i] -= mean1; q += v[i] * v[i]; }
          const float rstd1 = 1.f / sqrtf(wave_sum(q) * (1.f / DM) + LN_EPS);
          s = 0.f;
#pragma unroll
          for (int j = 0; j < 4; ++j) {
              const f32x4 gg = ((const f32x4*)g1)[lane + 64 * j], bb = ((const f32x4*)b1)[lane + 64 * j];
              float a0 = 0.f, a1 = 0.f, a2 = 0.f, a3 = 0.f;
#pragma unroll
              for (int k = 0; k < 4; ++k) {
                  const f32x2 lo = __builtin_amdgcn_cvt_pk_f32_fp8((int)y[k][j], false), hi = __builtin_amdgcn_cvt_pk_f32_fp8((int)y[k][j], true);
                  a0 += lo.x; a1 += lo.y; a2 += hi.x; a3 += hi.y;
              }
              a0 = fmaf(a0, 1.0f / 64.0f, DN_ALPHA * (v[4 * j] * rstd1 * gg.x + bb.x)); a1 = fmaf(a1, 1.0f / 64.0f, DN_ALPHA * (v[4 * j + 1] * rstd1 * gg.y + bb.y));
              a2 = fmaf(a2, 1.0f / 64.0f, DN_ALPHA * (v[4 * j + 2] * rstd1 * gg.z + bb.z)); a3 = fmaf(a3, 1.0f / 64.0f, DN_ALPHA * (v[4 * j + 3] * rstd1 * gg.w + bb.w));
              v[4 * j] = a0; v[4 * j + 1] = a1; v[4 * j + 2] = a2; v[4 * j + 3] = a3; s += (a0 + a1) + (a2 + a3);
          } }
        const float mean = wave_sum(s) * (1.f / DM); float s2 = 0.f;
#pragma unroll
        for (int i = 0; i < 16; ++i) { v[i] -= mean; s2 += v[i] * v[i]; }
        const float rstd = 1.f / sqrtf(wave_sum(s2) * (1.f / DM) + LN_EPS);
        f32x4* o = (f32x4*)(a.out + (size_t)t * DM) + lane;
#pragma unroll
        for (int j = 0; j < 4; ++j) {
            const f32x4 gg = ((const f32x4*)g2)[lane + 64 * j], bb = ((const f32x4*)b2)[lane + 64 * j];
            o[64 * j] = (f32x4){v[4 * j] * rstd * gg.x + bb.x, v[4 * j + 1] * rstd * gg.y + bb.y, v[4 * j + 2] * rstd * gg.z + bb.z, v[4 * j + 3] * rstd * gg.w + bb.w};
        }
    }
}


namespace att {
typedef float f32x16 __attribute__((ext_vector_type(16)));
typedef short s16x4 __attribute__((ext_vector_type(4)));
typedef short v4i16_t __attribute__((ext_vector_type(4)));
constexpr int KV_BUF = 32768, X_OFF = 65536, WSF_OFF = TAB_OFF, TBL_OFF = TAB_OFF + 2048;
constexpr float THR = 6.0f;
constexpr int DONE_OFF = TAB_OFF + 2048 + 4 * 1280 * 4;
__device__ __forceinline__ int crow(int r, int hi) { return (r & 3) + 8 * (r >> 2) + 4 * hi; }
__device__ __forceinline__ unsigned cvtpk(float lo, float hi) { typedef float f2 __attribute__((ext_vector_type(2))); typedef __bf16 b2 __attribute__((ext_vector_type(2))); f2 v = {lo, hi}; b2 b = __builtin_convertvector(v, b2); return __builtin_bit_cast(unsigned, b); }
__device__ __forceinline__ s16x4 vtr(LAS const unsigned char* p) { return __builtin_bit_cast(s16x4, __builtin_amdgcn_ds_read_tr16_b64_v4i16((LAS v4i16_t*)p)); }
__device__ __forceinline__ float swapmax(float m) { auto rr = __builtin_amdgcn_permlane32_swap(__float_as_uint(m), __float_as_uint(m), false, false); return fmaxf(__uint_as_float(rr[0]), __uint_as_float(rr[1])); }
__device__ __forceinline__ float swapsum(float m) { auto rr = __builtin_amdgcn_permlane32_swap(__float_as_uint(m), __float_as_uint(m), false, false); return __uint_as_float(rr[0]) + __uint_as_float(rr[1]); }

__device__ __forceinline__ void glds16(const void* g, unsigned lds_base) {
    unsigned sv; asm volatile("s_mov_b32 %0, m0\n\ts_mov_b32 m0, %2\n\ts_nop 0\n\tglobal_load_lds_dwordx4 %1, off\n\ts_mov_b32 m0, %0" : "=&s"(sv) : "v"(g), "s"(lds_base) : "memory"); }

template <bool ISA>
__device__ __forceinline__ void attn_unit(const Frame& F, const u16* QKV, u16* O, int b, int hx, int jq, float lam, const float* subg, const float* relb, const float* KN, int* qnext, volatile LAS int* qslot) {
    constexpr int DVB = ISA ? 4 : 2;
#ifdef MEAS_ATT
    const unsigned long long tu0_ = __builtin_amdgcn_s_memrealtime();
#endif
    const int lane = lane_id(), w = F.wave, sub = w >> 2, rg = w & 3, r32 = lane & 31, hi = lane >> 5;
    const int q0 = jq * 128, cq = 2 * jq + (rg >> 1);
    const int qpos = q0 + rg * 32 + r32;
    const size_t tok0 = (size_t)b * SEQ;
    const int qcol = (ISA ? hx * 128 : 1536 + hx * 128) + sub * 64;
    const int kcol0 = ISA ? 512 + hx * 128 : 2048 + hx * 128, vcol0 = ISA ? 1024 + hx * 128 : 2560 + hx * 128;
    const int ktop = 2 * jq + 1, kbot = ISA ? 0 : (2 * jq - 8 > 0 ? 2 * jq - 8 : 0);
    const int NTs = ktop - kbot + 1;
    LAS unsigned char* lds = F.lds;
    unsigned soff[2];
#pragma unroll
    for (int i = 0; i < 2; ++i) { const unsigned row = 4u * (8u * i + w) + (lane >> 4); const unsigned f = ((row & 3u) << 2) | ((row >> 2) & 3u); soff[i] = row * (QKVP * 2) + (((unsigned)lane & 15u) ^ f) * 16u; }
    const char* kvbase = (const char*)QKV + (tok0 * QKVP + kcol0) * 2;
    const unsigned ldsw = (unsigned)(w & 3) * 1024u;
    const unsigned ldsb0 = (unsigned)(unsigned long)lds;
#define ATT_ISSUE(kt, buf) do { if (w < 4) { const char* kb_ = kvbase + (size_t)(kt) * 64 * QKVP * 2; const char* vb_ = kb_ + (vcol0 - kcol0) * 2; \
        _Pragma("unroll") for (int i_ = 0; i_ < 2; ++i_) _Pragma("unroll") for (int h_ = 0; h_ < 2; ++h_) { \
            glds16(kb_ + soff[i_] + h_ * 16 * QKVP * 2, (unsigned)__builtin_amdgcn_readfirstlane((int)(ldsb0 + (unsigned)(buf) * KV_BUF + i_ * 8192 + h_ * 4096 + ldsw))); \
            glds16(vb_ + soff[i_] + h_ * 16 * QKVP * 2, (unsigned)__builtin_amdgcn_readfirstlane((int)(ldsb0 + (unsigned)(buf) * KV_BUF + 16384 + i_ * 8192 + h_ * 4096 + ldsw))); } } } while (0)
    ATT_ISSUE(ktop, 0);
    if (NTs > 1) ATT_ISSUE(ktop - 1, 1);
    bf16x8 qf[4];
    { const u16* qp = QKV + (tok0 + q0 + rg * 32 + r32) * QKVP + qcol + 8 * hi;
#pragma unroll
      for (int s = 0; s < 4; ++s) qf[s] = *(const bf16x8*)(qp + 16 * s); }
    const unsigned fr_ = ((r32 & 3u) << 2) | ((r32 >> 2) & 3u);
    unsigned kad[4];
#pragma unroll
    for (int s = 0; s < 4; ++s) kad[s] = 256u * r32 + 16u * ((8u * sub + 2u * s + hi) ^ fr_);
    const unsigned qd = (lane & 15) >> 2, pd = lane & 3, blk = (lane >> 4) & 1, xlow = 2 * blk + (pd >> 1);
    unsigned vad[DVB][2];
#pragma unroll
    for (int c = 0; c < DVB; ++c)
#pragma unroll
        for (int t = 0; t < 2; ++t) { const unsigned ci = ISA ? (unsigned)c : (unsigned)(2 * sub + c);
            vad[c][t] = 2048u * t + 256u * (4u * hi + qd) + 64u * (ci ^ qd) + 16u * (xlow ^ ((2u * t + hi) & 3u)) + 8u * (pd & 1u); }
    const float sl2 = ISA ? exp2f(-2.0f * (float)(hx + 1)) * LOG2E : 0.f;
    LAS float* wsf = (LAS float*)(lds + WSF_OFF) + w * 64;
    float mrun = -INFINITY, lrun = 0.f;
    float sfxv = 0.f;
    LAS int* donecnt = (LAS int*)(lds + DONE_OFF);
    bool wdone = false; float mlow = INFINITY;
    float knl = 0.f;
    if (ISA) {
        knl = (lane <= ktop) ? KN[((size_t)b * 64 + lane) * 8 + hx * 2 + sub] : 0.f;
        if (w == 0 && lane < 3) donecnt[lane] = 0;
    }
#define ATT_BOUND() do { float qq = 0.f; \
        _Pragma("unroll") for (int s = 0; s < 4; ++s) _Pragma("unroll") for (int j = 0; j < 8; ++j) { const float x = bf2f((u16)qf[s][j]); qq = fmaf(x, x, qq); } \
        qq = swapsum(qq); \
        _Pragma("unroll") for (int o_ = 1; o_ < 32; o_ <<= 1) qq = fmaxf(qq, __shfl_xor(qq, o_)); \
        float kn = knl; \
        _Pragma("unroll") for (int o_ = 1; o_ < 64; o_ <<= 1) { const float t_ = __shfl_up(kn, o_); if (lane >= o_) kn = fmaxf(kn, t_); } \
        sfxv = sqrtf(qq * kn) * 1.02f; } while (0)
    f32x16 o[DVB];
#pragma unroll
    for (int c = 0; c < DVB; ++c)
#pragma unroll
        for (int r = 0; r < 16; ++r) o[c][r] = 0.f;

    int buf = 0;
#ifdef MEAS_ATT
    if (MEAS_ATT == 7 && w == MEAS_W && lane == 0) ((volatile LAS unsigned*)(lds + MISC_OFF))[16] += (unsigned)(__builtin_amdgcn_s_memrealtime() - tu0_);
#endif
    for (int i = 0; i < NTs; ++i) {
        const int kt = ktop - i;
        const int nbuf = buf == 2 ? 0 : buf + 1;
#ifdef MEAS_ATT
        const unsigned long long ta_ = __builtin_amdgcn_s_memrealtime();
#endif
        if (i + 1 < NTs) asm volatile("s_waitcnt vmcnt(8)" ::: "memory"); else asm volatile("s_waitcnt vmcnt(0)" ::: "memory");
#ifdef MEAS_ATT
        const unsigned long long tb_ = __builtin_amdgcn_s_memrealtime();
#endif
        __syncthreads();
#ifdef MEAS_ATT
        const unsigned long long tc_ = __builtin_amdgcn_s_memrealtime();
        if (w == MEAS_W && lane == 0) { if (MEAS_ATT == 1) ((volatile LAS unsigned*)(lds + MISC_OFF))[16] += (unsigned)(tb_ - ta_); if (MEAS_ATT == 2) ((volatile LAS unsigned*)(lds + MISC_OFF))[16] += (unsigned)(tc_ - tb_); }
#endif
        LAS const unsigned char* kbuf = lds + buf * KV_BUF; LAS const unsigned char* vbuf = kbuf + 16384;
        bf16x8 kf0[4], kf1[4];
#pragma unroll
        for (int s = 0; s < 4; ++s) { kf0[s] = *(const LAS bf16x8*)(kbuf + kad[s]); kf1[s] = *(const LAS bf16x8*)(kbuf + kad[s] + 8192); }
        int dcnt = 0;
        if (ISA) { if (i > 0) dcnt = donecnt[(i - 1) % 3];
                   if (w == 0 && lane == 0) donecnt[(i + 1) % 3] = 0; }
        bool active = ISA ? (kt <= cq) : (kt <= cq && kt >= cq - 8);
        if (ISA && active && !wdone && kt < cq) {
            const float bnd = __int_as_float(__builtin_amdgcn_readlane(__float_as_int(sfxv), kt)) + sl2 * (float)(kt * 64 + 63 - (q0 + rg * 32)) - mlow;
            if (bnd < -150.0f) wdone = true;
        }
        if (ISA && wdone) { active = false; if (lane == 0) __hip_atomic_fetch_add(donecnt + (i % 3), 1, __ATOMIC_RELAXED, __HIP_MEMORY_SCOPE_WORKGROUP); }
        if (active) {
            f32x16 p0, p1;
#pragma unroll
            for (int r = 0; r < 16; ++r) { p0[r] = 0.f; p1[r] = 0.f; }
#pragma unroll
            for (int s = 0; s < 4; ++s) {
                p0 = __builtin_amdgcn_mfma_f32_32x32x16_bf16(kf0[s], qf[s], p0, 0, 0, 0);
                p1 = __builtin_amdgcn_mfma_f32_32x32x16_bf16(kf1[s], qf[s], p1, 0, 0, 0);
            }
#ifdef MEAS_ATT
            __builtin_amdgcn_sched_barrier(0);
            const unsigned long long t1_ = __builtin_amdgcn_s_memrealtime();
            __builtin_amdgcn_sched_barrier(0);
            if (MEAS_ATT == 4 && w == MEAS_W && lane == 0) ((volatile LAS unsigned*)(lds + MISC_OFF))[16] += (unsigned)(t1_ - tc_);
#endif
            constexpr int NPV = DVB * 4, VPF = 6;
            s16x4 vlo[VPF], vhi[VPF];
#pragma unroll
            for (int j = 0; j < VPF; ++j) { vlo[j] = vtr(vbuf + vad[j >> 2][0] + 4096 * (j & 3)); vhi[j] = vtr(vbuf + vad[j >> 2][1] + 4096 * (j & 3)); }
            if (ISA) {
                const float dl = (float)(kt * 64 + 4 * hi - qpos);
#pragma unroll
                for (int r = 0; r < 16; ++r) { const float kc = (float)((r & 3) + 8 * (r >> 2)); p0[r] = fmaf(-sl2, fabsf(dl + kc), p0[r]); p1[r] = fmaf(-sl2, fabsf(dl + kc + 32.0f), p1[r]); }
            } else {
                LAS const float* tb = (LAS const float*)(lds + TBL_OFF) + hx * 1280 + sub * 640 + (qpos + 64 - kt * 64 - 4 * hi - 63);
#pragma unroll
                for (int r = 0; r < 16; ++r) { const int kc = (r & 3) + 8 * (r >> 2); p0[r] += tb[63 - kc]; p1[r] += tb[63 - 32 - kc]; }
            }
            float mxa = fmaxf(p0[0], p1[0]), mxb = fmaxf(p0[4], p1[4]), mxc = fmaxf(p0[8], p1[8]), mxd = fmaxf(p0[12], p1[12]);
#pragma unroll
            for (int r = 1; r < 4; ++r) { mxa = fmaxf(mxa, fmaxf(p0[r], p1[r])); mxb = fmaxf(mxb, fmaxf(p0[4 + r], p1[4 + r])); mxc = fmaxf(mxc, fmaxf(p0[8 + r], p1[8 + r])); mxd = fmaxf(mxd, fmaxf(p0[12 + r], p1[12 + r])); }
            const float mt = swapmax(fmaxf(fmaxf(mxa, mxb), fmaxf(mxc, mxd)));
            if (__any(mt > mrun + THR)) {
                const float mnew = fmaxf(mrun, mt), alpha = __builtin_amdgcn_exp2f(mrun - mnew);
                lrun *= alpha; mrun = mnew;
                if (ISA) { float ml = mrun;
#pragma unroll
                    for (int o_ = 1; o_ < 32; o_ <<= 1) ml = fminf(ml, __shfl_xor(ml, o_));
                    mlow = ml; }
                if (hi == 0) wsf[r32] = alpha;
#pragma unroll
                for (int r = 0; r < 16; ++r) { const float a_ = wsf[crow(r, hi)];
#pragma unroll
                    for (int c = 0; c < DVB; ++c) o[c][r] *= a_; }
            }
            float psa = 0.f, psb = 0.f, psc = 0.f, psd = 0.f;
#pragma unroll
            for (int r = 0; r < 16; r += 4) {
                p0[r] = __builtin_amdgcn_exp2f(p0[r] - mrun); p1[r] = __builtin_amdgcn_exp2f(p1[r] - mrun); psa += p0[r] + p1[r];
                p0[r + 1] = __builtin_amdgcn_exp2f(p0[r + 1] - mrun); p1[r + 1] = __builtin_amdgcn_exp2f(p1[r + 1] - mrun); psb += p0[r + 1] + p1[r + 1];
                p0[r + 2] = __builtin_amdgcn_exp2f(p0[r + 2] - mrun); p1[r + 2] = __builtin_amdgcn_exp2f(p1[r + 2] - mrun); psc += p0[r + 2] + p1[r + 2];
                p0[r + 3] = __builtin_amdgcn_exp2f(p0[r + 3] - mrun); p1[r + 3] = __builtin_amdgcn_exp2f(p1[r + 3] - mrun); psd += p0[r + 3] + p1[r + 3]; }
            const float ps = (psa + psb) + (psc + psd);
            lrun += ps;
            u32x4 pw[4];
#pragma unroll
            for (int q = 0; q < 4; ++q) { pw[0][q] = cvtpk(p0[2 * q], p0[2 * q + 1]); pw[1][q] = cvtpk(p0[8 + 2 * q], p0[8 + 2 * q + 1]); pw[2][q] = cvtpk(p1[2 * q], p1[2 * q + 1]); pw[3][q] = cvtpk(p1[8 + 2 * q], p1[8 + 2 * q + 1]); }
#ifdef MEAS_ATT
            __builtin_amdgcn_sched_barrier(0);
            const unsigned long long t2_ = __builtin_amdgcn_s_memrealtime();
            __builtin_amdgcn_sched_barrier(0);
            if (MEAS_ATT == 5 && w == MEAS_W && lane == 0) ((volatile LAS unsigned*)(lds + MISC_OFF))[16] += (unsigned)(t2_ - t1_);
#endif
#pragma unroll
            for (int j = 0; j < NPV; ++j) {
                const s16x4 lo = vlo[j % VPF], h4 = vhi[j % VPF];
                const bf16x8 vf = (bf16x8){lo[0], lo[1], lo[2], lo[3], h4[0], h4[1], h4[2], h4[3]};
                if (j + VPF < NPV) { const int jn = j + VPF; vlo[j % VPF] = vtr(vbuf + vad[jn >> 2][0] + 4096 * (jn & 3)); vhi[j % VPF] = vtr(vbuf + vad[jn >> 2][1] + 4096 * (jn & 3)); }
                o[j >> 2] = __builtin_amdgcn_mfma_f32_32x32x16_bf16(__builtin_bit_cast(bf16x8, pw[j & 3]), vf, o[j >> 2], 0, 0, 0);
            }
#ifdef MEAS_ATT
            __builtin_amdgcn_sched_barrier(0);
            if (MEAS_ATT == 6 && w == MEAS_W && lane == 0) ((volatile LAS unsigned*)(lds + MISC_OFF))[16] += (unsigned)(__builtin_amdgcn_s_memrealtime() - t2_);
#endif
        }
#ifdef MEAS_ATT
        if (MEAS_ATT == 3 && w == MEAS_W && lane == 0) { asm volatile("s_nop 0" :: "v"(o[0][0]), "v"(o[DVB - 1][15])); ((volatile LAS unsigned*)(lds + MISC_OFF))[16] += (unsigned)(__builtin_amdgcn_s_memrealtime() - tc_); }
#endif
        if (ISA && i == 0) ATT_BOUND();
        if (ISA && __builtin_amdgcn_readfirstlane(dcnt) == 8) break;
        if (i + 2 < NTs) ATT_ISSUE(kt - 2, nbuf == 2 ? 0 : nbuf + 1);
        buf = nbuf;
    }
#ifdef MEAS_ATT
    const unsigned long long tu1_ = __builtin_amdgcn_s_memrealtime();
#endif
    asm volatile("s_waitcnt vmcnt(0)" ::: "memory");
    int pre_ = 0;
    if (F.tid() == 0) pre_ = atomicAdd(qnext, 1);
    float gg[4] = {0.f, 0.f, 0.f, 0.f};
    if (ISA && sub == 0) {
#pragma unroll
        for (int c = 0; c < 4; ++c) gg[c] = subg[32 * c + r32] * 0.8f;
    }
    { const float lt = swapsum(lrun); const float inv = __builtin_amdgcn_rcpf(lt);
      if (hi == 0) wsf[r32] = inv;
#pragma unroll
      for (int r = 0; r < 16; ++r) { const float a_ = wsf[crow(r, hi)];
#pragma unroll
          for (int c = 0; c < DVB; ++c) o[c][r] *= a_; } }
    __syncthreads();
#ifdef MEAS_ATT
    if (MEAS_ATT == 9 && w == MEAS_W && lane == 0) ((volatile LAS unsigned*)(lds + MISC_OFF))[16] += (unsigned)(__builtin_amdgcn_s_memrealtime() - tu1_);
#endif
    if (ISA) {
        LAS f32x4* X4 = (LAS f32x4*)(lds + X_OFF) + rg * 1024;
        if (sub == 1) {
#pragma unroll
            for (int c = 0; c < 4; ++c)
#pragma unroll
                for (int g = 0; g < 4; ++g) X4[(c * 4 + g) * 64 + lane] = (f32x4){o[c][4 * g], o[c][4 * g + 1], o[c][4 * g + 2], o[c][4 * g + 3]};
        }
        __syncthreads();
        if (sub == 0) {
            float ss[16];
#pragma unroll
            for (int r = 0; r < 16; ++r) ss[r] = 0.f;
#pragma unroll
            for (int c = 0; c < 4; ++c)
#pragma unroll
                for (int g = 0; g < 4; ++g) { const f32x4 x = X4[(c * 4 + g) * 64 + lane];
#pragma unroll
                    for (int e = 0; e < 4; ++e) { const int r = 4 * g + e; const float y = o[c][r] - lam * x[e]; o[c][r] = y; ss[r] += y * y; } }
#pragma unroll
            for (int r = 0; r < 16; ++r) {
                float v = ss[r];
                v += __int_as_float(__builtin_amdgcn_update_dpp(0, __float_as_int(v), 0x128, 0xf, 0xf, true));
                v += __int_as_float(__builtin_amdgcn_update_dpp(0, __float_as_int(v), 0x124, 0xf, 0xf, true));
                v += __int_as_float(__builtin_amdgcn_update_dpp(0, __float_as_int(v), 0x122, 0xf, 0xf, true));
                v += __int_as_float(__builtin_amdgcn_update_dpp(0, __float_as_int(v), 0x121, 0xf, 0xf, true));
                v += __int_as_float(__builtin_amdgcn_ds_swizzle(__float_as_int(v), 0x401f));
                ss[r] = __builtin_amdgcn_rsqf(v * (1.0f / 128.0f) + 1e-5f);
            }
            LAS u16* stg = (LAS u16*)(lds + X_OFF + rg * 16384);
            asm volatile("s_waitcnt lgkmcnt(0)" ::: "memory");
#pragma unroll
            for (int c = 0; c < 4; ++c)
#pragma unroll
                for (int r = 0; r < 16; ++r) stg[crow(r, hi) * 128 + 32 * c + r32] = f2bf(o[c][r] * ss[r] * gg[c]);
            asm volatile("s_waitcnt lgkmcnt(0)" ::: "memory");
            u16* og = O + (tok0 + q0 + rg * 32) * DM + hx * 128;
#pragma unroll
            for (int i = 0; i < 8; ++i) { const int row = 4 * i + (lane >> 4), ch = lane & 15; const u32x4 v = *(const LAS u32x4*)((LAS const unsigned char*)stg + row * 256 + ch * 16); *(u32x4*)(og + (size_t)row * DM + ch * 8) = v; }
        }
    } else {
        LAS u16* stg = (LAS u16*)(lds + X_OFF + w * 4096);
#pragma unroll
        for (int c = 0; c < 2; ++c)
#pragma unroll
            for (int r = 0; r < 16; ++r) stg[crow(r, hi) * 64 + 32 * c + r32] = f2bf(o[c][r]);
        asm volatile("s_waitcnt lgkmcnt(0)" ::: "memory");
        u16* og = O + (tok0 + q0 + rg * 32) * DM + 512 + (2 * hx + sub) * 64;
#pragma unroll
        for (int i = 0; i < 4; ++i) { const int row = 8 * i + (lane >> 3), ch = lane & 7; const u32x4 v = *(const LAS u32x4*)((LAS const unsigned char*)stg + row * 128 + ch * 16); *(u32x4*)(og + (size_t)row * DM + ch * 8) = v; }
    }
    if (F.tid() == 0) *qslot = pre_;
    __syncthreads();
#ifdef MEAS_ATT
    if (MEAS_ATT == 8 && w == MEAS_W && lane == 0) ((volatile LAS unsigned*)(lds + MISC_OFF))[16] += (unsigned)(__builtin_amdgcn_s_memrealtime() - tu1_);
#endif
#undef ATT_ISSUE
#undef ATT_BOUND
}

__device__ __forceinline__ void p2_attention(const Frame& F, const Args& a) {
    const u16* QKV = (const u16*)(a.ws + WS_QKV); u16* O = (u16*)(a.ws + WS_O); const float* KN = (const float*)(a.ws + WS_KN);
    float d1 = 0.f, d2 = 0.f;
    for (int i = 0; i < 64; ++i) { d1 += a.in[4][i] * a.in[5][i]; d2 += a.in[6][i] * a.in[7][i]; }
    const float lam = expf(d1) - expf(d2) + 0.2f;
    int* Q = (int*)(F.ctl + CW_Q) + 64 * (F.bid & 7); int* CQ = (int*)(F.ctl + CW_CQ);
    volatile LAS int* slot = (volatile LAS int*)(F.lds + MISC_OFF + 128);
    const int b = F.bid & 7;
    constexpr int NCONV = 8, NBATCH_C = (P0_NITEMS - P0_DENSE_ITEMS) / 64;
    { LAS float* tbl = (LAS float*)(F.lds + TBL_OFF); const float* relb = a.in[9];
      for (int i = F.tid(); i < 4 * 1280; i += NTHR) { const int hd2 = i / 640, idx = i % 640; int rel = idx - 64; rel = rel < -256 ? -256 : (rel > 256 ? 256 : rel); tbl[i] = relb[hd2 * 513 + rel + 256] * LOG2E; }
      __syncthreads(); }
    bool att_left = true, conv_left = true;
    const bool conv_first = (F.bid >> 3) < NCONV;
    bool do_conv = conv_first;
    bool have = false;
    while (att_left || conv_left) {
        if (do_conv && conv_left) {
            if (!have) { if (F.tid() == 0) *slot = atomicAdd(CQ, 1); __syncthreads(); }
            const int cb = __builtin_amdgcn_readfirstlane(*slot);
            __syncthreads();
            if (cb >= NBATCH_C) { conv_left = false; do_conv = false; have = false; continue; }
            int pre = 0;
            if (F.tid() == 0) pre = atomicAdd(CQ, 1);
            LAS float* scr = (LAS float*)(F.lds + RING_OFF + F.wave * 8704);
            const int lane = lane_id();
            cvt_batch8(a, P0_DENSE_ITEMS + cb * 64 + F.wave * 8, scr, lane);
            if (F.tid() == 0) *slot = pre;
            __syncthreads();
            have = true;
        } else if (att_left) {
            if (!have) { if (F.tid() == 0) *slot = atomicAdd(Q, 1); __syncthreads(); }
            const int idx = __builtin_amdgcn_readfirstlane(*slot);
            __syncthreads();
            if (idx >= 256) { att_left = false; do_conv = true; have = false; continue; }
            if (idx < 128) {
                const int hxa = idx < 64 ? 3 - (idx & 1) : (idx < 96 ? 1 : 0), jqa = idx < 64 ? 31 - (idx >> 1) : 31 - ((idx - 64) & 31);
                attn_unit<true>(F, QKV, O, b, hxa, jqa, lam, a.in[8], a.in[9], KN, Q, slot);
            } else { const int i2 = idx - 128; attn_unit<false>(F, QKV, O, b, i2 & 3, 31 - (i2 >> 2), lam, a.in[8], a.in[9], KN, Q, slot); }
            have = true;
        } else { do_conv = true; have = false; }
    }
}
}
#ifndef REP_MASK
#define REP_MASK 0
#endif
__global__ void __launch_bounds__(NTHR, 2) mk_fwd(Args args) {
    extern __shared__ __attribute__((aligned(16))) unsigned char lds_raw[];
    Frame F;
    F.lds = (LAS unsigned char*)lds_raw; F.MISC = (volatile LAS unsigned*)(F.lds + MISC_OFF);
    F.wave = __builtin_amdgcn_readfirstlane((int)threadIdx.x >> 6); F.G = gridDim.x; F.bid = blockIdx.x;
    F.ctl = (gu32*)(args.ws + WS_CTL);
    for (int u = F.tid(); u < 256; u += NTHR) ((LAS unsigned*)(F.lds + MISC_OFF))[u] = 0u;
    __syncthreads();
    const int lo = args.ph_lo, hi = args.ph_hi;
    const bool multi = (hi - lo) > 1;
    XcdBarrier bar; bar.bar = (unsigned*)(F.ctl + CW_BAR) + args.li * XCD_BAR_WORDS; bar.x = 0; bar.st = nullptr; bar.wave = F.wave;
    if (multi) bar = xcd_barrier_post((unsigned*)(F.ctl + CW_BAR) + args.li * XCD_BAR_WORDS, F.MISC + 8, F.wave);
#if defined(MEAS_PHASE)
    unsigned long long tp0_ = 0;
#define MEAS_T0() do { tp0_ = __builtin_amdgcn_s_memrealtime(); } while (0)
#define MEAS_T1(k) do { if (MEAS_PHASE == (k) && F.wave == 0 && lane_id() == 0) ((volatile LAS unsigned*)(F.lds + MISC_OFF))[16] += (unsigned)(__builtin_amdgcn_s_memrealtime() - tp0_); } while (0)
#else
#define MEAS_T0() do {} while (0)
#define MEAS_T1(k) do {} while (0)
#endif
#define IN(k) (lo <= (k) && (k) < hi)
#define SEAM(k) do { if (IN(k) && IN((k) + 1)) xcd_barrier(bar); } while (0)
    unsigned char* ws = args.ws;
    if (IN(0)) { MEAS_T0(); p0_prologue(F, args); if (REP_MASK & 1) p0_prologue(F, args); MEAS_T1(0); SEAM(0); }
    if (IN(1)) {
        MEAS_T0();
        PDense S; S.A = (const u16*)(ws + WS_H0); S.Bt = (const u16*)(ws + WS_WIN); S.out = (u16*)(ws + WS_QKV); S.H0 = nullptr; S.KN = (float*)(ws + WS_KN); S.mode = 0; S.ord.init(NTOK, QKVP, F.G, F.bid);
        pg8::gemm_phase(F.lds + RING_OFF, S, F.wave); if (REP_MASK & 2) pg8::gemm_phase(F.lds + RING_OFF, S, F.wave); MEAS_T1(1); SEAM(1);
    }
    if (IN(2)) {
        MEAS_T0(); att::p2_attention(F, args); MEAS_T1(2);
        SEAM(2); }
    if (IN(3)) {
        MEAS_T0();
        PDense S; S.A = (const u16*)(ws + WS_O); S.Bt = (const u16*)(ws + WS_WOUT); S.out = (u16*)(ws + WS_U); S.H0 = (const u16*)(ws + WS_H0); S.KN = nullptr; S.mode = 1; S.ord.init(NTOK, DM, F.G, F.bid);
        pg8::gemm_phase(F.lds + RING_OFF, S, F.wave); if (REP_MASK & 8) pg8::gemm_phase(F.lds + RING_OFF, S, F.wave); MEAS_T1(3); SEAM(3);
    }
    if (IN(4)) { MEAS_T0(); p4_router(F, args); MEAS_T1(4); SEAM(4); }
    if (IN(5)) {
        MEAS_T0();
        const MoeTab T = moe_tab(F.lds); moe_tables(T, (const int*)(F.ctl + CW_CNT), F.wave);
        PMoe<1> S; S.A = ws + WS_H1Q; S.Bt = ws + WS_W1; S.out = (void*)(ws + WS_ACT); S.list = (const int*)(ws + WS_LIST); S.gate = nullptr; S.bias = args.in[16]; S.T = T; S.c = F.bid; S.ntot = __builtin_amdgcn_readfirstlane(T.tb[NEXP]);
        S.prepare(F.wave);
        pg8::gemm_phase(F.lds + RING_OFF, S, F.wave); if (REP_MASK & 32) pg8::gemm_phase(F.lds + RING_OFF, S, F.wave); MEAS_T1(5); SEAM(5);
    }
    if (IN(6)) {
        MEAS_T0();
        const MoeTab T = moe_tab(F.lds); moe_tables(T, (const int*)(F.ctl + CW_CNT), F.wave);
        PMoe<0> S; S.A = ws + WS_ACT; S.Bt = ws + WS_W2; S.out = (void*)(ws + WS_YS); S.list = (const int*)(ws + WS_LIST); S.gate = (const float*)(ws + WS_GATE); S.bias = args.in[18]; S.T = T; S.c = F.bid; S.ntot = __builtin_amdgcn_readfirstlane(T.tb[NEXP]);
        S.prepare(F.wave);
        pg8::gemm_phase(F.lds + RING_OFF, S, F.wave); if (REP_MASK & 64) pg8::gemm_phase(F.lds + RING_OFF, S, F.wave); MEAS_T1(6); SEAM(6);
    }
    if (IN(7)) { MEAS_T0(); p7_final(F, args); if (REP_MASK & 128) p7_final(F, args); MEAS_T1(7); }
#if (defined(MEAS_P4) || defined(MEAS_ATT) || defined(MEAS_GEPI) || defined(MEAS_P0)) && !defined(MEAS_PHASE)
#define MEAS_PHASE 99
#define MEAS_MUL 4
#endif
#if defined(MEAS_PHASE)
    { __syncthreads(); const unsigned acc_ = ((volatile LAS unsigned*)(F.lds + MISC_OFF))[16]; const unsigned long long t0_ = __builtin_amdgcn_s_memrealtime();
      while (__builtin_amdgcn_s_memrealtime() - t0_ < (unsigned long long)acc_ * MEAS_MUL) __builtin_amdgcn_s_sleep(16); }
#endif
#undef IN
#undef SEAM
}

extern "C" void kernel_launch(void* const* d_in, const int* in_sizes, int n_in, void* d_out, int out_size, void* d_ws, size_t ws_size, hipStream_t stream) {
    static int grid = 0;
    if (grid == 0) {
        if (n_in != 21 || in_sizes[0] != NTOK * DM || out_size != NTOK * DM || ws_size < WS_END) { fprintf(stderr, "kernel_launch: unexpected shapes / workspace (%d inputs, ws %zu)\n", n_in, ws_size); grid = -1; return; }
        int dev = 0, cus = 0, per_cu = 0;
        if (hipGetDevice(&dev) != hipSuccess || hipDeviceGetAttribute(&cus, hipDeviceAttributeMultiprocessorCount, dev) != hipSuccess) { grid = -1; return; }
        if (hipFuncSetAttribute((const void*)mk_fwd, hipFuncAttributeMaxDynamicSharedMemorySize, LDS_BYTES) != hipSuccess) { fprintf(stderr, "kernel_launch: hipFuncSetAttribute failed\n"); grid = -1; return; }
        if (hipOccupancyMaxActiveBlocksPerMultiprocessor(&per_cu, (const void*)mk_fwd, NTHR, LDS_BYTES) != hipSuccess || per_cu < 1) { fprintf(stderr, "kernel_launch: occupancy query says %d blocks per CU\n", per_cu); (void)hipGetLastError(); grid = -1; return; }
        if (cus < 256) { fprintf(stderr, "kernel_launch: needs 256 CUs, device has %d\n", cus); grid = -1; return; }
        grid = 256;
    }
    if (grid < 0) return;
    const float* lq1 = (const float*)d_in[4]; const float* lk1 = (const float*)d_in[5]; const float* lq2 = (const float*)d_in[6]; const float* lk2 = (const float*)d_in[7];
    const float* subg = (const float*)d_in[8]; const float* relb = (const float*)d_in[9];
    char* ws = (char*)d_ws;
    u16* QKV = (u16*)(ws + WS_QKV); u16* O = (u16*)(ws + WS_O);
    (void)hipMemsetAsync(ws + WS_CTL, 0, CTL_BYTES, stream);
    Args a{};
    for (int i = 0; i < 21; ++i) a.in[i] = (const float*)d_in[i];
    a.out = (float*)d_out; a.ws = (unsigned char*)d_ws;
    int nl = 0;
    auto run = [&](int lo, int hi) { a.ph_lo = lo; a.ph_hi = hi; a.li = nl++; hipLaunchKernelGGL(mk_fwd, dim3(grid), dim3(NTHR), LDS_BYTES, stream, a); };
    run(0, 8);
}
```

```cpp
#define REP_MASK 0
#include <hip/hip_runtime.h>
#include <cstdint>
#include <cstdio>

typedef unsigned short u16;
typedef short bf16x8 __attribute__((ext_vector_type(8)));
typedef float f32x4 __attribute__((ext_vector_type(4)));
typedef unsigned u32x4 __attribute__((ext_vector_type(4)));
typedef unsigned u32x2 __attribute__((ext_vector_type(2)));
#define LAS __attribute__((address_space(3)))

constexpr int NTOK = 32768, DM = 1024, SEQ = 4096, NBATCH = 8;
constexpr int QKVP = 3072;
constexpr int NEXP = 32;
constexpr float LOG2E = 1.4426950408889634f;
constexpr float QSCALE = 0.125f * LOG2E;
constexpr float DN_ALPHA = 1.189207115002721f;
constexpr float LN_EPS = 1e-5f;

constexpr size_t MiB = 1u << 20;
constexpr size_t WS_CTL = 0, CTL_BYTES = 1 * MiB;
constexpr size_t WS_RWT = 1 * MiB;
constexpr size_t WS_KN = 1 * MiB + 256 * 1024;
constexpr size_t WS_H1Q = 80 * MiB;
constexpr size_t WS_WIN = 2 * MiB, WS_WOUT = 8 * MiB, WS_W1 = 16 * MiB, WS_W2 = 144 * MiB;
constexpr size_t WS_H1 = 208 * MiB, WS_LIST = 272 * MiB, WS_GATE = 276 * MiB;
constexpr size_t WS_H0 = 280 * MiB, WS_QKV = 344 * MiB, WS_O = 536 * MiB, WS_U = 416 * MiB, WS_ACT = 280 * MiB;
constexpr size_t WS_YS = 600 * MiB, WS_END = 856 * MiB;

__device__ __forceinline__ float bf2f(u16 v) { return __uint_as_float((unsigned)v << 16); }
__device__ __forceinline__ u16 f2bf(float f) { unsigned u = __float_as_uint(f); return (u16)((u + 0x7fffu + ((u >> 16) & 1u)) >> 16); }
__device__ __forceinline__ unsigned pk2(float lo, float hi) { typedef float f2_ __attribute__((ext_vector_type(2))); typedef __bf16 b2_ __attribute__((ext_vector_type(2))); f2_ v = {lo, hi}; b2_ r = __builtin_convertvector(v, b2_); return __builtin_bit_cast(unsigned, r); }
__device__ __forceinline__ float wave_sum(float v) {
#pragma unroll
    for (int o = 1; o < 64; o <<= 1) v += __shfl_xor(v, o);
    return v;
}


#define GAS __attribute__((address_space(1)))
typedef GAS unsigned gu32;
#define RLX_AGENT __ATOMIC_RELAXED, __HIP_MEMORY_SCOPE_AGENT
#define LDS_WAIT() asm volatile("s_waitcnt lgkmcnt(0)" ::: "memory")
#define VM_WAIT() asm volatile("s_waitcnt vmcnt(0)" ::: "memory")

constexpr int NWAVES = 8, NTHR = 512;
__device__ __forceinline__ int lane_id() { int l; asm volatile("v_mbcnt_lo_u32_b32 %0, -1, 0\n\tv_mbcnt_hi_u32_b32 %0, -1, %0" : "=v"(l)); return l; }
constexpr int RING_OFF = 0, RING_BYTES = 131072, TAB_OFF = 131072, TAB_BYTES = 24576, MISC_OFF = TAB_OFF + TAB_BYTES, LDS_BYTES = MISC_OFF + 1024;
constexpr int CW_CNT = 0;
constexpr int CW_Q = 2048;
constexpr int CW_CQ = 2048 + 64 * 8;
constexpr int CW_BAR = 4096;

#define XB_TMO      128
#define XB_XCNT(j)  (256  + 64 * (j))
#define XB_XSUB(j)  (1280 + 64 * (j))
#define XB_XGEN(j)  (2304 + 64 * (j))
#define XB_TOP      3328
#define XB_TOPGEN   3392
#define XCD_BAR_WORDS 3456
#define XB_SPIN_CAP (1u << 20)
__device__ __forceinline__ unsigned xb_ld(unsigned* p)              { return __hip_atomic_load(p, __ATOMIC_RELAXED, __HIP_MEMORY_SCOPE_AGENT); }
__device__ __forceinline__ unsigned xb_add(unsigned* p, unsigned v) { return __hip_atomic_fetch_add(p, v, __ATOMIC_RELAXED, __HIP_MEMORY_SCOPE_AGENT); }
__device__ __forceinline__ unsigned xb_xcc_id() { return (unsigned)__builtin_amdgcn_s_getreg((3 << 11) | 20) & 0xFu; }
#define XB_SPIN(cond, bar) do { unsigned _sp = 0; while (cond) { __builtin_amdgcn_s_sleep(1); \
    if ((++_sp & 255u) == 0u) { if (xb_ld(&(bar)[XB_TMO])) break; if (_sp > XB_SPIN_CAP) { atomicAdd(&(bar)[XB_TMO], 1u); break; } } } } while (0)
struct XcdBarrier { unsigned* bar; unsigned x; volatile LAS unsigned* st; int wave; };
__device__ __forceinline__ XcdBarrier xcd_barrier_post(unsigned* bar, volatile LAS unsigned* st, int wave) {
    XcdBarrier b; b.bar = bar; b.x = xb_xcc_id(); b.st = st; b.wave = wave;
    if (wave == 0 && lane_id() == 0) (void)xb_add(&bar[XB_XCNT(b.x)], 1u);
    return b;
}
__device__ __forceinline__ void xcd_barrier_complete(unsigned* bar, unsigned x, unsigned& nloc, unsigned& nx) {
    const unsigned G = gridDim.x * gridDim.y * gridDim.z;
    unsigned sum, cnt, mine, sp = 0u;
    for (;;) {
        sum = 0u; cnt = 0u; mine = 0u;
#pragma unroll
        for (unsigned j = 0; j < 16; ++j) { const unsigned c = xb_ld(&bar[XB_XCNT(j)]); sum += c; cnt += (c > 0u) ? 1u : 0u; mine = (j == x) ? c : mine; }
        if (sum == G) break;
        __builtin_amdgcn_s_sleep(1);
        if ((++sp & 255u) == 0u) { if (xb_ld(&bar[XB_TMO])) break; if (sp > XB_SPIN_CAP) { atomicAdd(&bar[XB_TMO], 1u); break; } }
    }
    nloc = mine > 0u ? mine : 1u; nx = cnt > 0u ? cnt : 1u;
}
__device__ __forceinline__ void xcd_barrier(const XcdBarrier& b) {
    asm volatile("s_waitcnt vmcnt(0)" ::: "memory");
    __syncthreads();
    if (b.wave == 0 && lane_id() == 0) {
        unsigned* bar = b.bar;
        __builtin_amdgcn_s_waitcnt(0);
        unsigned nloc = b.st[0], nx = b.st[1];
        if (nloc == 0u) { xcd_barrier_complete(bar, b.x, nloc, nx); b.st[0] = nloc; b.st[1] = nx; }
        const unsigned old = xb_add(&bar[XB_XSUB(b.x)], 1u);
        const unsigned gen = old / nloc;
        if (old + 1u == (gen + 1u) * nloc) {
            __builtin_amdgcn_fence(__ATOMIC_RELEASE, "agent");
            asm volatile("s_waitcnt vmcnt(0)" ::: "memory");
            const unsigned og = xb_add(&bar[XB_TOP], 1u);
            const unsigned tg = og / nx;
            if (og + 1u == (tg + 1u) * nx) xb_add(&bar[XB_TOPGEN], 1u);
            else XB_SPIN(xb_ld(&bar[XB_TOPGEN]) == tg, bar);
            __builtin_amdgcn_fence(__ATOMIC_ACQUIRE, "agent");
            xb_add(&bar[XB_XGEN(b.x)], 1u);
            asm volatile("s_waitcnt vmcnt(0)" ::: "memory");
        } else {
            XB_SPIN(xb_ld(&bar[XB_XGEN(b.x)]) == gen, bar);
            __builtin_amdgcn_fence(__ATOMIC_ACQUIRE, "agent");
            asm volatile("s_waitcnt vmcnt(0)" ::: "memory");
        }
    }
    __syncthreads();
}

namespace pg8 {
constexpr int BM = 256, BK = 64, HALF = 128, HTB = HALF * BK * 2, NXCD = 8, WGM = 8, KD = 1024, NT = KD / BK;
__host__ __device__ __forceinline__ int lds_byte(int r, int c) { const int st = (r >> 4) * 2 + (c >> 5), rr = r & 15, cc = c & 31, ob = rr * 64 + cc * 2; return st * 1024 + (ob ^ (((ob >> 9) & 1) << 5)); }
__host__ __device__ __forceinline__ void stage_rc(int b, int& R, int& C) { const int st = b / 1024, sb = b % 1024, swz = sb ^ (((sb >> 9) & 1) << 5); R = (st >> 1) * 16 + swz / 64; C = (st & 1) * 32 + (swz % 64) / 2; }
__host__ __device__ __forceinline__ int perm32(int rho) { const int n = rho >> 4, i = rho & 15; return 8 * (i >> 2) + 4 * n + (i & 3); }
__device__ __forceinline__ float clamp8(float x) { return __builtin_amdgcn_fmed3f(x, -448.0f, 448.0f); }
__device__ __forceinline__ unsigned cvt_pk_bf16(float lo, float hi) { unsigned r; asm volatile("v_cvt_pk_bf16_f32 %0, %1, %2" : "=v"(r) : "v"(lo), "v"(hi)); return r; }

typedef int v8i32 __attribute__((ext_vector_type(8)));
struct Unit { int pm, pn, e, idx; };

struct StaticOrder {
    int nM, nN, nwg, G, c;
    __device__ void init(int M, int N, int G_, int c_) { nM = M / BM; nN = N / BM; nwg = nM * nN; G = G_; c = c_; }
    __device__ bool next(int i, Unit& u) const {
        const long L = (long)i * G + c; if (L >= nwg) return false;
        int wgid = (int)L; { const int q = nwg / NXCD, r = nwg % NXCD, xcd = wgid % NXCD, off = wgid / NXCD; wgid = (xcd < r ? xcd * (q + 1) : r * (q + 1) + (xcd - r) * q) + off; }
        const int nig = WGM * nN, gid = wgid / nig, fm = gid * WGM, gsz = (nM - fm) < WGM ? (nM - fm) : WGM;
        u.pm = fm + ((wgid % nig) % gsz); u.pn = (wgid % nig) / gsz; u.e = 0; u.idx = i; return true;
    }
};

template <class P>
__device__ __forceinline__ void gemm_phase(LAS unsigned char* lds, const P& S, int wave) {
    const int wid = wave, lane = lane_id(), tid = wid * 64 + lane, wr = wid >> 2, wc = wid & 3, fr = lane & 15, fq = lane >> 4;
    constexpr int KB = P::FP8 ? 1024 : 2048, nt = KB / 128;
    int Rr0, Cc0; unsigned voffB0;
    { int R, C; stage_rc(tid * 16, R, C); const int Rb = 64 * (R >> 5) + perm32(R & 31); Rr0 = R; Cc0 = C; voffB0 = (unsigned)(Rb * KB + C * 2); }
    constexpr unsigned kstep = (unsigned)(BK * 2);
    constexpr unsigned hstep = 32u * KB;
    const __amdgpu_buffer_rsrc_t rA = __builtin_amdgcn_make_buffer_rsrc((void*)S.a_ptr(), 0, 0x7fffffff, 0x00020000), rB = __builtin_amdgcn_make_buffer_rsrc((void*)S.b_ptr(), 0, 0x7fffffff, 0x00020000);
    const unsigned ldsw = (unsigned)wid * 1024u;
    const int aoff = lds_byte(wr * 64 + fr, fq * 8), boff = lds_byte(wc * 32 + fr, fq * 8);
#define PG8_SA(b, h) (((b) * 2 + (h)) * HTB)
#define PG8_SB(b, h) ((4 + (b) * 2 + (h)) * HTB)
#define PG8_STAGE(bufoff, rs, sbase, voff) do { _Pragma("unroll") for (int _i = 0; _i < 2; ++_i) \
        __builtin_amdgcn_raw_ptr_buffer_load_lds(rs, (LAS unsigned*)(lds + (bufoff) + ldsw + _i * 8192), 16, (int)(voff), (int)((sbase) + (unsigned)(_i * 128 * KB)), 0, 0); } while (0)
#define PG8_STAGE_A(bufoff, sbase, un, h) do { _Pragma("unroll") for (int _i = 0; _i < 2; ++_i) \
        __builtin_amdgcn_raw_ptr_buffer_load_lds(rA, (LAS unsigned*)(lds + (bufoff) + ldsw + _i * 8192), 16, (int)S.a_off1(un, h, Rr0 + 64 * _i, Cc0), (int)(sbase), 0, 0); } while (0)
#define PG8_AOFF(vo, un, h) unsigned vo[2] = {0u, 0u}; if constexpr (P::GATHER) { vo[0] = S.a_off1(un, h, Rr0, 0); vo[1] = S.a_off1(un, h, Rr0 + 64, 0); }
#define PG8_STAGE_AV(bufoff, sbase, vo, un, h) do { if constexpr (P::GATHER) { _Pragma("unroll") for (int _i = 0; _i < 2; ++_i) \
        __builtin_amdgcn_raw_ptr_buffer_load_lds(rA, (LAS unsigned*)(lds + (bufoff) + ldsw + _i * 8192), 16, (int)((vo)[_i] + (unsigned)Cc0 * 2u), (int)(sbase), 0, 0); } \
        else PG8_STAGE_A(bufoff, sbase, un, h); } while (0)
#define PG8_LDA(dst, b, h) do { _Pragma("unroll") for (int m = 0; m < 4; ++m) _Pragma("unroll") for (int k = 0; k < 2; ++k) dst[m][k] = *(const LAS bf16x8*)(lds + PG8_SA(b, h) + aoff + m * 2048 + k * 1024); } while (0)
#define PG8_LDB(dst, b, h) do { _Pragma("unroll") for (int n = 0; n < 2; ++n) _Pragma("unroll") for (int k = 0; k < 2; ++k) dst[n][k] = *(const LAS bf16x8*)(lds + PG8_SB(b, h) + boff + n * 2048 + k * 1024); } while (0)
#define PG8_CAT(x) __builtin_bit_cast(v8i32, __builtin_shufflevector((x)[0], (x)[1], 0, 1, 2, 3, 4, 5, 6, 7, 8, 9, 10, 11, 12, 13, 14, 15))
#define PG8_MMA(ai, bj, At, Bt) do { __builtin_amdgcn_sched_barrier(0); __builtin_amdgcn_s_setprio(1); \
        if constexpr (P::FP8) { _Pragma("unroll") for (int m = 0; m < 4; ++m) _Pragma("unroll") for (int n = 0; n < 2; ++n) \
            acc[ai][bj][m][n] = __builtin_amdgcn_mfma_scale_f32_16x16x128_f8f6f4(PG8_CAT(Bt[n]), PG8_CAT(At[m]), acc[ai][bj][m][n], 0, 0, 0, P::SCALE_B, 0, P::SCALE_A); } \
        else { _Pragma("unroll") for (int m = 0; m < 4; ++m) _Pragma("unroll") for (int n = 0; n < 2; ++n) _Pragma("unroll") for (int k = 0; k < 2; ++k) \
            acc[ai][bj][m][n] = __builtin_amdgcn_mfma_f32_16x16x32_bf16(Bt[n][k], At[m][k], acc[ai][bj][m][n], 0, 0, 0); } \
        __builtin_amdgcn_s_setprio(0); __builtin_amdgcn_sched_barrier(0); } while (0)
#define PG8_WAIT_V(n) asm volatile("s_waitcnt vmcnt(" #n ")" ::: "memory")
#define PG8_WAIT_L(n) asm volatile("s_waitcnt lgkmcnt(" #n ")" ::: "memory")
#define PG8_BAR __builtin_amdgcn_s_barrier()
#define PG8_SCHED __builtin_amdgcn_sched_barrier(0)
    Unit cur, nxt; int ui = 0;
    if (!S.next(0, cur)) return;
    f32x4 acc[2][2][4][2];
#pragma unroll
    for (int a = 0; a < 2; ++a)
#pragma unroll
        for (int b = 0; b < 2; ++b)
#pragma unroll
            for (int m = 0; m < 4; ++m)
#pragma unroll
                for (int n = 0; n < 2; ++n) acc[a][b][m][n] = (f32x4){0.f, 0.f, 0.f, 0.f};
    bf16x8 At[4][2], B0[2][2], B1[2][2];
    unsigned cA = S.a_base(cur), cB = S.b_base(cur);
    PG8_STAGE(PG8_SB(0, 0), rB, cB, voffB0); PG8_STAGE(PG8_SB(0, 1), rB, cB + hstep, voffB0); PG8_STAGE_A(PG8_SA(0, 0), cA, cur, 0); PG8_STAGE_A(PG8_SA(0, 1), cA, cur, 1);
    if (wr == 1) PG8_BAR;
    PG8_WAIT_V(2); PG8_BAR;
    PG8_STAGE(PG8_SB(1, 0), rB, cB + kstep, voffB0); PG8_STAGE_A(PG8_SA(1, 0), cA + kstep, cur, 0); PG8_STAGE(PG8_SB(1, 1), rB, cB + hstep + kstep, voffB0);
    PG8_WAIT_V(6); PG8_BAR;
    for (;;) {
        const bool has_next = S.next(ui + 1, nxt);
        const unsigned nA = has_next ? S.a_base(nxt) : cA, nB = has_next ? S.b_base(nxt) : cB;
#pragma unroll 1
        for (int t = 0; t < nt; t += 2) {
            const bool last = (t == nt - 2);
            const unsigned a1 = cA + (unsigned)(t + 1) * kstep;
            const unsigned a2 = last ? nA : cA + (unsigned)(t + 2) * kstep, b2 = last ? nB : cB + (unsigned)(t + 2) * kstep;
            const unsigned a3 = a2 + kstep, b3 = b2 + kstep;
            Unit un2; { const bool nx_ = last && has_next; un2.pm = nx_ ? nxt.pm : cur.pm; un2.pn = nx_ ? nxt.pn : cur.pn; un2.e = nx_ ? nxt.e : cur.e; un2.idx = nx_ ? nxt.idx : cur.idx; }
            { PG8_AOFF(vo_, cur, 1); PG8_LDB(B0, 0, 0); PG8_LDB(B1, 0, 1); PG8_SCHED; PG8_LDA(At, 0, 0); PG8_STAGE_AV(PG8_SA(1, 1), a1, vo_, cur, 1); }
            PG8_WAIT_V(8); PG8_WAIT_L(0); PG8_BAR; PG8_MMA(0, 0, At, B0); PG8_MMA(0, 1, At, B1); PG8_BAR; PG8_SCHED;
            { PG8_AOFF(vo_, un2, 0); PG8_LDA(At, 0, 1); PG8_STAGE(PG8_SB(0, 0), rB, b2, voffB0); PG8_STAGE(PG8_SB(0, 1), rB, b2 + hstep, voffB0); PG8_STAGE_AV(PG8_SA(0, 0), a2, vo_, un2, 0); }
            PG8_WAIT_V(8); PG8_WAIT_L(0); PG8_BAR; PG8_MMA(1, 0, At, B0); PG8_MMA(1, 1, At, B1); PG8_BAR; PG8_SCHED;
            { PG8_AOFF(vo_, un2, 1); PG8_LDB(B0, 1, 0); PG8_LDB(B1, 1, 1); PG8_SCHED; PG8_LDA(At, 1, 0); PG8_STAGE_AV(PG8_SA(0, 1), a2, vo_, un2, 1); }
            PG8_WAIT_V(8); PG8_WAIT_L(0); PG8_BAR; PG8_MMA(0, 0, At, B0); PG8_MMA(0, 1, At, B1); PG8_BAR; PG8_SCHED;
            { PG8_AOFF(vo_, un2, 0); PG8_LDA(At, 1, 1); PG8_STAGE(PG8_SB(1, 0), rB, b3, voffB0); PG8_STAGE(PG8_SB(1, 1), rB, b3 + hstep, voffB0); PG8_STAGE_AV(PG8_SA(1, 0), a3, vo_, un2, 0); }
            PG8_WAIT_V(8); PG8_WAIT_L(0); PG8_BAR; PG8_MMA(1, 0, At, B0); PG8_MMA(1, 1, At, B1); PG8_BAR; PG8_SCHED;
        }
        if (wr == 0) PG8_BAR;
        { const int le_ = lane_id(); S.epi(acc, cur, wr, wc, le_ & 15, le_ >> 4); }
        if (!has_next) break;
#pragma unroll
        for (int a = 0; a < 2; ++a)
#pragma unroll
            for (int b = 0; b < 2; ++b)
#pragma unroll
                for (int m = 0; m < 4; ++m)
#pragma unroll
                    for (int n = 0; n < 2; ++n) acc[a][b][m][n] = (f32x4){0.f, 0.f, 0.f, 0.f};
        cur = nxt; cA = nA; cB = nB; ++ui;
        if (wr == 1) PG8_BAR;
    }
    PG8_WAIT_V(0);
    PG8_BAR;
#undef PG8_SA
#undef PG8_SB
#undef PG8_STAGE
#undef PG8_STAGE_A
#undef PG8_AOFF
#undef PG8_STAGE_AV
#undef PG8_LDA
#undef PG8_LDB
#undef PG8_MMA
#undef PG8_CAT
#undef PG8_WAIT_V
#undef PG8_WAIT_L
#undef PG8_BAR
#undef PG8_SCHED
}
}

__device__ __forceinline__ u32x4 ror8(u32x4 v) { u32x4 r;
#pragma unroll
    for (int q = 0; q < 4; ++q) r[q] = (unsigned)__builtin_amdgcn_update_dpp(0, (int)v[q], 0x128, 0xf, 0xf, true);
    return r; }
template <bool F8, int MODE>
struct PDenseT {
    static constexpr bool PERM = true, FP8 = F8, GATHER = false; static constexpr int SCALE_A = F8 ? 0x7b7b7b7b : 0, SCALE_B = F8 ? 0x74747474 : 0;
    static constexpr unsigned PITCH = F8 ? 1024u : 2048u;
    const void* A; const void* Bt; u16* out; const u16* H0; float* KN; static constexpr int mode = MODE; pg8::StaticOrder ord;
    __device__ __forceinline__ bool next(int i, pg8::Unit& u) const { return ord.next(i, u); }
    __device__ __forceinline__ const void* a_ptr() const { return A; }
    __device__ __forceinline__ const void* b_ptr() const { return Bt; }
    __device__ __forceinline__ unsigned a_base(const pg8::Unit& u) const { return (unsigned)u.pm * 256u * PITCH; }
    __device__ __forceinline__ unsigned b_base(const pg8::Unit& u) const { return (unsigned)u.pn * 256u * PITCH; }
    __device__ __forceinline__ unsigned a_off1(const pg8::Unit&, int h, int R, int C) const { return (unsigned)(h * 128 + R) * PITCH + (unsigned)C * 2u; }
    __device__ __forceinline__ void epi(const f32x4 (&acc)[2][2][4][2], const pg8::Unit& u, int wr, int wc, int fr, int fq) const {
        const int ldc = mode == 0 ? QKVP : DM;
        const float sc = (mode == 0 && (u.pn < 2 || u.pn == 6 || u.pn == 7)) ? QSCALE : 1.0f;
        const int hh = fr >> 3, frl = fr & 7;
        const int rowb = u.pm * 256 + wr * 64, colo = u.pn * 256 + wc * 64 + 8 * fq;
        const bool knorm = (mode == 0) && (u.pn == 2 || u.pn == 3);
#pragma unroll
        for (int ai = 0; ai < 2; ++ai) {
            float cmx = 0.f;
#pragma unroll
            for (int m = 0; m < 4; ++m) {
                if (knorm) { float nr = 0.f;
#pragma unroll
                    for (int bj = 0; bj < 2; ++bj) { const f32x4 x0 = acc[ai][bj][m][0], x1 = acc[ai][bj][m][1]; nr += (x0[0] * x0[0] + x0[1] * x0[1]) + (x0[2] * x0[2] + x0[3] * x0[3]) + (x1[0] * x1[0] + x1[1] * x1[1]) + (x1[2] * x1[2] + x1[3] * x1[3]); }
                    nr += __shfl_xor(nr, 16); nr += __shfl_xor(nr, 32);
#pragma unroll
                    for (int o_ = 1; o_ < 16; o_ <<= 1) nr = fmaxf(nr, __shfl_xor(nr, o_));
                    cmx = fmaxf(cmx, nr); }
                u32x4 W[2];
#pragma unroll
                for (int bj = 0; bj < 2; ++bj) {
                    f32x4 v0 = acc[ai][bj][m][0] * sc, v1 = acc[ai][bj][m][1] * sc;
                    if (mode == 1) {
                        const u32x4 h = *(const u32x4*)(H0 + (size_t)(rowb + ai * 128 + m * 16 + fr) * DM + colo + 32 * bj);
                        v0[0] += DN_ALPHA * __uint_as_float(h.x << 16); v0[1] += DN_ALPHA * __uint_as_float(h.x & 0xffff0000u); v0[2] += DN_ALPHA * __uint_as_float(h.y << 16); v0[3] += DN_ALPHA * __uint_as_float(h.y & 0xffff0000u);
                        v1[0] += DN_ALPHA * __uint_as_float(h.z << 16); v1[1] += DN_ALPHA * __uint_as_float(h.z & 0xffff0000u); v1[2] += DN_ALPHA * __uint_as_float(h.w << 16); v1[3] += DN_ALPHA * __uint_as_float(h.w & 0xffff0000u);
                    }
                    W[bj].x = pg8::cvt_pk_bf16(v0[0], v0[1]); W[bj].y = pg8::cvt_pk_bf16(v0[2], v0[3]); W[bj].z = pg8::cvt_pk_bf16(v1[0], v1[1]); W[bj].w = pg8::cvt_pk_bf16(v1[2], v1[3]);
                }
                const u32x4 rcv = ror8(hh ? W[0] : W[1]);
                const u32x4 s1 = hh ? rcv : W[0], s2 = hh ? W[1] : rcv;
                u16* p1 = out + (size_t)(rowb + ai * 128 + m * 16 + frl) * ldc + colo + 32 * hh;
                *(u32x4*)p1 = s1; *(u32x4*)(p1 + (size_t)8 * ldc) = s2;
            }
            if (knorm && fr == 0 && fq == 0) KN[(size_t)(u.pm * 4 + ai * 2 + wr) * 8 + (u.pn - 2) * 4 + wc] = cmx;
        }
    }
};

struct MoeTab { LAS int* tb; LAS int* cn; LAS int* rowoff; };
__device__ __forceinline__ MoeTab moe_tab(LAS unsigned char* lds) { MoeTab t; t.rowoff = (LAS int*)(lds + TAB_OFF); t.tb = (LAS int*)(lds + TAB_OFF + 20480); t.cn = t.tb + 40; return t; }
__device__ __forceinline__ void moe_tables(const MoeTab& T, const int* cnt, int wave) {
    if (wave == 0 && lane_id() == 0) { int s = 0; for (int e = 0; e < NEXP; ++e) { const int c = __hip_atomic_load(cnt + e, RLX_AGENT); T.cn[e] = c; T.tb[e] = s; s += (c + 255) >> 8; } T.tb[NEXP] = s; }
    __syncthreads();
}
__device__ __forceinline__ int moe_find_e(const MoeTab& T, int RT) { int e = 0; while (e < NEXP - 1 && RT >= T.tb[e + 1]) ++e; return e; }

template <int UP>
struct PMoe {
    static constexpr bool PERM = true, FP8 = true, GATHER = (UP != 0); static constexpr int SCALE_A = UP ? 0x7c7c7c7c : 0x7d7d7d7d, SCALE_B = UP ? 0x75757575 : 0x74747474;
    static constexpr int NPN = UP ? 8 : 4, RPG = UP ? 4 : 8;
    const unsigned char* A; const unsigned char* Bt; void* out; const int* list; const float* gate; const float* bias; MoeTab T; int c, ntot;
    __device__ __forceinline__ bool next(int i, pg8::Unit& u) const {
        const int x = c & 7, s = c >> 3; const int RT = (i * 8 + x) * RPG + (s % RPG);
        if (RT >= ntot) return false;
        u.pm = RT; u.pn = s / RPG; u.e = moe_find_e(T, RT); u.idx = i; return true;
    }
    __device__ __forceinline__ const void* a_ptr() const { return A; }
    __device__ __forceinline__ const void* b_ptr() const { return Bt; }
    __device__ __forceinline__ unsigned a_base(const pg8::Unit& u) const { return UP ? 0u : (unsigned)u.pm * 256u * 1024u; }
    __device__ __forceinline__ unsigned b_base(const pg8::Unit& u) const { return ((unsigned)u.e * (UP ? 2048u : 1024u) + (unsigned)u.pn * 256u) * 1024u; }
    __device__ __forceinline__ unsigned a_off1(const pg8::Unit& u, int h, int R, int C) const { return UP ? (unsigned)T.rowoff[u.idx * 256 + h * 128 + R] + (unsigned)C * 2u : (unsigned)((h * 128 + R) * 1024 + C * 2); }
    __device__ __forceinline__ void prepare(int wave) const {
        const int tidx = wave * 64 + lane_id();
        pg8::Unit u;
        if (UP) {
            for (int i = 0; next(i, u); ++i) {
                if (tidx < 256) { const int r = (u.pm - T.tb[u.e]) * 256 + tidx; const int ent = list[(size_t)u.e * NTOK + (r < T.cn[u.e] ? r : 0)]; T.rowoff[i * 256 + tidx] = (ent >> 2) * 1024; }
            }
        } else {
            for (int i = 0; next(i, u); ++i) {
                if (tidx < 256) { const int r = (u.pm - T.tb[u.e]) * 256 + tidx; int ent = -1; float g = 0.f;
                    if (r < T.cn[u.e]) { ent = list[(size_t)u.e * NTOK + r]; g = gate[ent]; }
                    T.rowoff[i * 512 + tidx] = ent; ((LAS float*)T.rowoff)[i * 512 + 256 + tidx] = g; }
            }
        }
        __syncthreads();
    }
    __device__ __forceinline__ void epi(const f32x4 (&acc)[2][2][4][2], const pg8::Unit& u, int wr, int wc, int fr, int fq) const {
        const int colo = u.pn * 256 + wc * 64 + 8 * fq;
        if (UP) {
            const float* bp = bias + (size_t)u.e * 2048 + colo;
            f32x4 bv[2][2];
            const f32x4 mulv = {4.0f, 1.0f, 4.0f, 1.0f};
#pragma unroll
            for (int bj = 0; bj < 2; ++bj)
#pragma unroll
                for (int hq = 0; hq < 2; ++hq) { const f32x4 bb = *(const f32x4*)(bp + bj * 32 + 4 * hq); bv[bj][hq] = (f32x4){4.0f * bb[0], bb[1] + 1.0f, 4.0f * bb[2], bb[3] + 1.0f}; }
#pragma unroll
            for (int ai = 0; ai < 2; ++ai) {
                unsigned wv[2][4];
#pragma unroll
                for (int m = 0; m < 4; ++m)
#pragma unroll
                    for (int bj = 0; bj < 2; ++bj) {
                        const f32x4 v0 = acc[ai][bj][m][0] * mulv + bv[bj][0], v1 = acc[ai][bj][m][1] * mulv + bv[bj][1];
                        float a[4];
#pragma unroll
                        for (int p = 0; p < 4; ++p) {
                            const float glu4 = p < 2 ? v0[2 * p] : v1[2 * p - 4], lin1 = p < 2 ? v0[2 * p + 1] : v1[2 * p - 3];
                            const float xg4 = fminf(glu4, 28.0f), xl1 = __builtin_amdgcn_fmed3f(lin1, -6.0f, 8.0f);
                            a[p] = xg4 * __builtin_amdgcn_rcpf(1.0f + __builtin_amdgcn_exp2f((-1.702f * LOG2E * 0.25f) * xg4)) * xl1;
                        }
                        int w = __builtin_amdgcn_cvt_pk_fp8_f32(a[0], a[1], 0, false); w = __builtin_amdgcn_cvt_pk_fp8_f32(a[2], a[3], w, true);
                        wv[bj][m] = (unsigned)w;
                    }
#pragma unroll
                for (int bj = 0; bj < 2; ++bj) {
#pragma unroll
                    for (int m = 0; m < 2; ++m) { const auto r_ = __builtin_amdgcn_permlane32_swap(wv[bj][m], wv[bj][m + 2], false, false); wv[bj][m] = r_[0]; wv[bj][m + 2] = r_[1]; }
#pragma unroll
                    for (int m = 0; m < 4; m += 2) { const auto r_ = __builtin_amdgcn_permlane16_swap(wv[bj][m], wv[bj][m + 1], false, false); wv[bj][m] = r_[0]; wv[bj][m + 1] = r_[1]; }
                    unsigned char* rowp = (unsigned char*)out + (size_t)(u.pm * 256 + wr * 64 + ai * 128 + fq * 16 + fr) * 1024 + (u.pn * 128 + wc * 32) + bj * 16;
                    *(u32x4*)rowp = (u32x4){wv[bj][0], wv[bj][1], wv[bj][2], wv[bj][3]};
                }
            }
        } else {
            const float* bp = bias + (size_t)u.e * 1024 + colo;
            f32x4 bv[2][2];
#pragma unroll
            for (int bj = 0; bj < 2; ++bj) { bv[bj][0] = *(const f32x4*)(bp + bj * 32); bv[bj][1] = *(const f32x4*)(bp + bj * 32 + 4); }
            const int hh = fr >> 3, frl = fr & 7;
#pragma unroll
            for (int ai = 0; ai < 2; ++ai)
#pragma unroll
                for (int m = 0; m < 4; ++m) {
                    const int rlb = wr * 64 + ai * 128 + m * 16;
                    const float gt = ((LAS const float*)T.rowoff)[u.idx * 512 + 256 + rlb + fr];
                    const int e1 = T.rowoff[u.idx * 512 + rlb + frl], e2 = T.rowoff[u.idx * 512 + rlb + frl + 8];
                    u32x2 W[2];
#pragma unroll
                    for (int bj = 0; bj < 2; ++bj) {
                        const f32x4 v0 = (acc[ai][bj][m][0] + bv[bj][0]) * (gt * 64.0f), v1 = (acc[ai][bj][m][1] + bv[bj][1]) * (gt * 64.0f);
                        int w0 = __builtin_amdgcn_cvt_pk_fp8_f32(pg8::clamp8(v0[0]), pg8::clamp8(v0[1]), 0, false); w0 = __builtin_amdgcn_cvt_pk_fp8_f32(pg8::clamp8(v0[2]), pg8::clamp8(v0[3]), w0, true);
                        int w1 = __builtin_amdgcn_cvt_pk_fp8_f32(pg8::clamp8(v1[0]), pg8::clamp8(v1[1]), 0, false); w1 = __builtin_amdgcn_cvt_pk_fp8_f32(pg8::clamp8(v1[2]), pg8::clamp8(v1[3]), w1, true);
                        W[bj].x = (unsigned)w0; W[bj].y = (unsigned)w1;
                    }
                    u32x2 snd = hh ? W[0] : W[1], rcv;
                    rcv.x = (unsigned)__builtin_amdgcn_update_dpp(0, (int)snd.x, 0x128, 0xf, 0xf, true); rcv.y = (unsigned)__builtin_amdgcn_update_dpp(0, (int)snd.y, 0x128, 0xf, 0xf, true);
                    const u32x2 s1 = hh ? rcv : W[0], s2 = hh ? W[1] : rcv;
                    if (e1 >= 0) *(u32x2*)((unsigned char*)out + (size_t)e1 * 1024 + colo + 32 * hh) = s1;
                    if (e2 >= 0) *(u32x2*)((unsigned char*)out + (size_t)e2 * 1024 + colo + 32 * hh) = s2;
                }
        }
    }
};

struct Frame {
    LAS unsigned char* lds; volatile LAS unsigned* MISC; gu32* ctl; int wave, G, bid;
    __device__ __forceinline__ int tid() const { return wave * 64 + lane_id(); }
};
__device__ __forceinline__ void p0_transpose_item(const float* W, int K, int N, u16* WT, LAS float* scr, int item, int lane) {
    const int nblk = N / 32, kb = item / nblk, nb = item % nblk, k0 = 64 * kb, n0 = 32 * nb;
    f32x4 v[8];
#pragma unroll
    for (int it = 0; it < 8; ++it) v[it] = *(const f32x4*)(W + (size_t)(k0 + (lane >> 3) + 8 * it) * N + n0 + (lane & 7) * 4);
#pragma unroll
    for (int it = 0; it < 8; ++it) { const int k = (lane >> 3) + 8 * it, n4 = (lane & 7) * 4; scr[(n4 + 0) * 68 + k] = v[it].x; scr[(n4 + 1) * 68 + k] = v[it].y; scr[(n4 + 2) * 68 + k] = v[it].z; scr[(n4 + 3) * 68 + k] = v[it].w; }
    LDS_WAIT(); asm volatile("" ::: "memory");
#pragma unroll
    for (int it = 0; it < 4; ++it) {
        const int n = (lane >> 3) + 8 * it, c = lane & 7; const LAS float* s = scr + n * 68 + 8 * c;
        const f32x4 a = *(const LAS f32x4*)s, b = *(const LAS f32x4*)(s + 4);
        u32x4 o; o.x = pk2(a.x, a.y); o.y = pk2(a.z, a.w); o.z = pk2(b.x, b.y); o.w = pk2(b.z, b.w);
        *(u32x4*)(WT + (size_t)(n0 + n) * K + k0 + 8 * c) = o;
    }
    LDS_WAIT(); asm volatile("" ::: "memory");
}
__device__ __forceinline__ void p0_transpose_item_fp8(const float* W, int K, int N, unsigned char* WT, LAS float* scr, int item, int lane, float scale) {
    const int nblk = N / 32, kb = item / nblk, nb = item % nblk, k0 = 64 * kb, n0 = 32 * nb;
    f32x4 v[8];
#pragma unroll
    for (int it = 0; it < 8; ++it) v[it] = *(const f32x4*)(W + (size_t)(k0 + (lane >> 3) + 8 * it) * N + n0 + (lane & 7) * 4);
#pragma unroll
    for (int it = 0; it < 8; ++it) { const int k = (lane >> 3) + 8 * it, n4 = (lane & 7) * 4; scr[(n4 + 0) * 68 + k] = v[it].x; scr[(n4 + 1) * 68 + k] = v[it].y; scr[(n4 + 2) * 68 + k] = v[it].z; scr[(n4 + 3) * 68 + k] = v[it].w; }
    LDS_WAIT(); asm volatile("" ::: "memory");
#pragma unroll
    for (int it = 0; it < 2; ++it) {
        const int n = (lane >> 2) + 16 * it, c = lane & 3; const LAS float* s = scr + n * 68 + 16 * c;
        u32x4 o;
#pragma unroll
        for (int q = 0; q < 4; ++q) { f32x4 a = *(const LAS f32x4*)(s + 4 * q) * scale;
            a.x = fminf(fmaxf(a.x, -448.f), 448.f); a.y = fminf(fmaxf(a.y, -448.f), 448.f); a.z = fminf(fmaxf(a.z, -448.f), 448.f); a.w = fminf(fmaxf(a.w, -448.f), 448.f);
            int w = __builtin_amdgcn_cvt_pk_fp8_f32(a.x, a.y, 0, false); w = __builtin_amdgcn_cvt_pk_fp8_f32(a.z, a.w, w, true); o[q] = (unsigned)w; }
        *(u32x4*)(WT + (size_t)(n0 + n) * K + k0 + 16 * c) = o;
    }
    LDS_WAIT(); asm volatile("" ::: "memory");
}
__device__ __forceinline__ void ln_row_in(const float* xrow, const float* g, const float* b, u16* orow, int lane) {
    const f32x4* xr = (const f32x4*)xrow + lane;
    f32x4 v[4]; float s = 0.f;
#pragma unroll
    for (int j = 0; j < 4; ++j) { v[j] = xr[64 * j]; s += (v[j].x + v[j].y) + (v[j].z + v[j].w); }
    const float mean = wave_sum(s) * (1.f / DM); float s2 = 0.f;
#pragma unroll
    for (int j = 0; j < 4; ++j) { v[j] = v[j] - mean; s2 += (v[j].x * v[j].x + v[j].y * v[j].y) + (v[j].z * v[j].z + v[j].w * v[j].w); }
    const float rstd = 1.f / sqrtf(wave_sum(s2) * (1.f / DM) + LN_EPS);
    u32x2* o8 = (u32x2*)orow + lane;
#pragma unroll
    for (int j = 0; j < 4; ++j) {
        const f32x4 gg = ((const f32x4*)g)[lane + 64 * j], bb = ((const f32x4*)b)[lane + 64 * j];
        u32x2 w; w.x = pk2(v[j].x * rstd * gg.x + bb.x, v[j].y * rstd * gg.y + bb.y); w.y = pk2(v[j].z * rstd * gg.z + bb.z, v[j].w * rstd * gg.w + bb.w);
        o8[64 * j] = w;
    }
}

struct Args { const float* in[21]; float* out; unsigned char* ws; int ph_lo, ph_hi, li, pad; };

constexpr int P0_I_IN = 16 * 96, P0_I_OUT = 16 * 32, P0_I_W1 = 16 * 64, P0_I_W2 = 16 * 32;
constexpr int P0_DENSE_ITEMS = P0_I_IN + P0_I_OUT, P0_NITEMS = P0_DENSE_ITEMS + NEXP * P0_I_W1 + NEXP * P0_I_W2;
__device__ __forceinline__ void p0_do_item(const Args& a, int it, LAS float* scr, int lane) {
    unsigned char* ws = a.ws; int r = it;
    if (r < P0_I_IN) { p0_transpose_item(a.in[3], 1024, 3072, (u16*)(ws + WS_WIN), scr, r, lane); return; } r -= P0_I_IN;
    if (r < P0_I_OUT) { p0_transpose_item_fp8(a.in[10], 1024, 1024, ws + WS_WOUT, scr, r, lane, 2048.0f); return; } r -= P0_I_OUT;
    if (r < NEXP * P0_I_W1) { const int e = r / P0_I_W1; p0_transpose_item_fp8(a.in[15] + (size_t)e * 1024 * 2048, 1024, 2048, ws + WS_W1 + (size_t)e * 1024 * 2048, scr, r % P0_I_W1, lane, 1024.0f); return; } r -= NEXP * P0_I_W1;
    { const int e = r / P0_I_W2; p0_transpose_item_fp8(a.in[17] + (size_t)e * 1024 * 1024, 1024, 1024, ws + WS_W2 + (size_t)e * 1024 * 1024, scr, r % P0_I_W2, lane, 2048.0f); }
}
__device__ __forceinline__ void cvt_batch8(const Args& a, int it0, LAS float* scr, int lane) {
    unsigned char* ws = a.ws;
    int r = it0 - P0_DENSE_ITEMS; const bool w1 = r < NEXP * P0_I_W1; if (!w1) r -= NEXP * P0_I_W1;
    const int per = w1 ? P0_I_W1 : P0_I_W2, e = r / per, q0 = r % per, N = w1 ? 2048 : 1024, nblk = N / 32;
    const float* W = (w1 ? a.in[15] : a.in[17]) + (size_t)e * 1024 * N;
    unsigned char* WT = ws + (w1 ? WS_W1 : WS_W2) + (size_t)e * 1024 * N;
    const float scale = w1 ? 1024.0f : 2048.0f;
    f32x4 va[8], vb[8];
#define CVT_LOAD(v, q) do { const int kb_ = (q) / nblk, nb_ = (q) % nblk; const float* s_ = W + (size_t)(64 * kb_ + (lane >> 3)) * N + 32 * nb_ + (lane & 7) * 4; \
        _Pragma("unroll") for (int it = 0; it < 8; ++it) v[it] = *(const f32x4*)(s_ + (size_t)(8 * it) * N); } while (0)
#define CVT_FIN(v, q) do { const int kb_ = (q) / nblk, nb_ = (q) % nblk; \
        _Pragma("unroll") for (int it = 0; it < 8; ++it) { const int k = (lane >> 3) + 8 * it, n4 = (lane & 7) * 4; scr[(n4 + 0) * 68 + k] = v[it].x; scr[(n4 + 1) * 68 + k] = v[it].y; scr[(n4 + 2) * 68 + k] = v[it].z; scr[(n4 + 3) * 68 + k] = v[it].w; } \
        LDS_WAIT(); asm volatile("" ::: "memory"); \
        _Pragma("unroll") for (int it = 0; it < 2; ++it) { const int n = (lane >> 2) + 16 * it, c = lane & 3; const LAS float* sp = scr + n * 68 + 16 * c; u32x4 o; \
            _Pragma("unroll") for (int qq = 0; qq < 4; ++qq) { f32x4 x = *(const LAS f32x4*)(sp + 4 * qq) * scale; \
                x.x = fminf(fmaxf(x.x, -448.f), 448.f); x.y = fminf(fmaxf(x.y, -448.f), 448.f); x.z = fminf(fmaxf(x.z, -448.f), 448.f); x.w = fminf(fmaxf(x.w, -448.f), 448.f); \
                int wd = __builtin_amdgcn_cvt_pk_fp8_f32(x.x, x.y, 0, false); wd = __builtin_amdgcn_cvt_pk_fp8_f32(x.z, x.w, wd, true); o[qq] = (unsigned)wd; } \
            *(u32x4*)(WT + (size_t)(32 * nb_ + n) * 1024 + 64 * kb_ + 16 * c) = o; } \
        LDS_WAIT(); asm volatile("" ::: "memory"); } while (0)
    CVT_LOAD(va, q0);
#pragma unroll 1
    for (int j = 0; j < 8; j += 2) {
        CVT_LOAD(vb, q0 + j + 1);
        CVT_FIN(va, q0 + j);
        if (j + 2 < 8) CVT_LOAD(va, q0 + j + 2);
        CVT_FIN(vb, q0 + j + 1);
    }
#undef CVT_LOAD
#undef CVT_FIN
}
__device__ __forceinline__ void p0_prologue(const Frame& F, const Args& a) {
    unsigned char* ws = a.ws;
    u16* H0 = (u16*)(ws + WS_H0);
    LAS float* scr = (LAS float*)(F.lds + RING_OFF + F.wave * 8704);
    const int gw = F.bid * NWAVES + F.wave, NGW = F.G * NWAVES;
    for (int it = gw; it < P0_DENSE_ITEMS; it += NGW) p0_do_item(a, it, scr, lane_id());
    { u16* RW = (u16*)(ws + WS_RWT); const float* rw = a.in[13];
      for (int idx = F.bid * NTHR + F.tid(); idx < 32768; idx += F.G * NTHR) { const int e = idx >> 10, k = idx & 1023; const float v = rw[k * 32 + e]; const u16 hi = f2bf(v); RW[idx] = hi; RW[32768 + idx] = f2bf(v - bf2f(hi)); } }
    for (int m = gw; m < NTOK; m += NGW) ln_row_in(a.in[0] + (size_t)m * DM, a.in[1], a.in[2], H0 + (size_t)m * DM, lane_id());
}

__device__ __forceinline__ void p4_router(const Frame& F, const Args& a) {
    unsigned char* ws = a.ws;
    const u16* U = (const u16*)(ws + WS_U); u16* H1 = (u16*)(ws + WS_H1); int* LIST = (int*)(ws + WS_LIST); float* GATE = (float*)(ws + WS_GATE); int* CNT = (int*)(F.ctl + CW_CNT);
    const float* g1 = a.in[11]; const float* b1 = a.in[12]; const float* rb = a.in[14];
    const u32x4* RWT = (const u32x4*)(ws + WS_RWT);
    LAS int* lcnt = (LAS int*)(F.lds + TAB_OFF); LAS int* lbase = lcnt + 32; LAS int* ent_e = lcnt + 64; LAS int* ent_p = ent_e + 512;
    const int lane = lane_id(), tok = lane & 15, kg = lane >> 4;
#if defined(MEAS_P4)
    const unsigned long long tq0_ = __builtin_amdgcn_s_memrealtime();
#endif
    LAS float* gl = (LAS float*)(F.lds + TAB_OFF + 8192); LAS float* bl = gl + 1024;
    for (int i = F.tid(); i < 1024; i += NTHR) { gl[i] = g1[i]; bl[i] = b1[i]; }
    for (int i = F.tid(); i < 8192; i += NTHR) { const int img = i >> 12, e = (i >> 7) & 31, c = i & 127; *(LAS u32x4*)(F.lds + RING_OFF + img * 65536 + e * 2048 + 16 * (c ^ (e & 15))) = RWT[i]; }
    for (int batch = F.bid; batch < NTOK / 128; batch += F.G) {
        __syncthreads();
        if (F.tid() < 32) lcnt[F.tid()] = 0;
        __syncthreads();
        LAS float* stat = (LAS float*)(F.lds + TAB_OFF + 16384) + F.wave * 32;
#pragma unroll 1
        for (int j2 = 0; j2 < 16; j2 += 2) {
            const int ta = batch * 128 + F.wave * 16 + j2;
            u32x2 wa[4], wb[4];
#pragma unroll
            for (int q = 0; q < 4; ++q) { wa[q] = ((const u32x2*)(U + (size_t)ta * DM) + lane)[64 * q]; wb[q] = ((const u32x2*)(U + (size_t)(ta + 1) * DM) + lane)[64 * q]; }
            float va[16], vb[16]; float sa = 0.f, sb = 0.f;
#pragma unroll
            for (int q = 0; q < 4; ++q) {
                va[4 * q] = __uint_as_float(wa[q].x << 16); va[4 * q + 1] = __uint_as_float(wa[q].x & 0xffff0000u); va[4 * q + 2] = __uint_as_float(wa[q].y << 16); va[4 * q + 3] = __uint_as_float(wa[q].y & 0xffff0000u);
                vb[4 * q] = __uint_as_float(wb[q].x << 16); vb[4 * q + 1] = __uint_as_float(wb[q].x & 0xffff0000u); vb[4 * q + 2] = __uint_as_float(wb[q].y << 16); vb[4 * q + 3] = __uint_as_float(wb[q].y & 0xffff0000u);
                sa += (va[4 * q] + va[4 * q + 1]) + (va[4 * q + 2] + va[4 * q + 3]); sb += (vb[4 * q] + vb[4 * q + 1]) + (vb[4 * q + 2] + vb[4 * q + 3]); }
            const float ma = wave_sum(sa) * (1.f / DM), mb = wave_sum(sb) * (1.f / DM); float qa = 0.f, qb = 0.f;
#pragma unroll
            for (int i = 0; i < 16; ++i) { va[i] -= ma; vb[i] -= mb; qa += va[i] * va[i]; qb += vb[i] * vb[i]; }
            const float ra = 1.f / sqrtf(wave_sum(qa) * (1.f / DM) + LN_EPS), rb_ = 1.f / sqrtf(wave_sum(qb) * (1.f / DM) + LN_EPS);
            if (lane == 0) { stat[2 * j2] = ma; stat[2 * j2 + 1] = ra; stat[2 * j2 + 2] = mb; stat[2 * j2 + 3] = rb_; }
#pragma unroll
            for (int q = 0; q < 4; ++q) {
                const f32x4 gg = *(const LAS f32x4*)(gl + lane * 4 + 256 * q), bb = *(const LAS f32x4*)(bl + lane * 4 + 256 * q);
                int w0 = __builtin_amdgcn_cvt_pk_fp8_f32(pg8::clamp8((va[4 * q] * ra * gg.x + bb.x) * 8.0f), pg8::clamp8((va[4 * q + 1] * ra * gg.y + bb.y) * 8.0f), 0, false);
                w0 = __builtin_amdgcn_cvt_pk_fp8_f32(pg8::clamp8((va[4 * q + 2] * ra * gg.z + bb.z) * 8.0f), pg8::clamp8((va[4 * q + 3] * ra * gg.w + bb.w) * 8.0f), w0, true);
                int w1 = __builtin_amdgcn_cvt_pk_fp8_f32(pg8::clamp8((vb[4 * q] * rb_ * gg.x + bb.x) * 8.0f), pg8::clamp8((vb[4 * q + 1] * rb_ * gg.y + bb.y) * 8.0f), 0, false);
                w1 = __builtin_amdgcn_cvt_pk_fp8_f32(pg8::clamp8((vb[4 * q + 2] * rb_ * gg.z + bb.z) * 8.0f), pg8::clamp8((vb[4 * q + 3] * rb_ * gg.w + bb.w) * 8.0f), w1, true);
                ((unsigned*)(ws + WS_H1Q + (size_t)ta * DM) + lane)[64 * q] = (unsigned)w0; ((unsigned*)(ws + WS_H1Q + (size_t)(ta + 1) * DM) + lane)[64 * q] = (unsigned)w1;
            }
        }
        asm volatile("s_waitcnt lgkmcnt(0)" ::: "memory");
        const int tl = F.wave * 16 + tok, t = batch * 128 + tl;
        const u32x4* ur = (const u32x4*)(U + (size_t)t * DM) + 2 * kg;
#define P4_CH(s) (8 * ((s) >> 1) + ((s) & 1))
        const float mean = stat[2 * tok], rstd = stat[2 * tok + 1];
        f32x4 acc[2];
        acc[0] = (f32x4){0.f, 0.f, 0.f, 0.f}; acc[1] = (f32x4){0.f, 0.f, 0.f, 0.f};
        LAS const unsigned char* wimg = F.lds + RING_OFF + tok * 2048;
        u32x4 wq[4];
#pragma unroll
        for (int j = 0; j < 4; ++j) wq[j] = ur[P4_CH(j)];
#pragma unroll 1
        for (int s4 = 0; s4 < 32; s4 += 4)
#pragma unroll
        for (int j = 0; j < 4; ++j) {
            const int s = s4 + j;
            const u32x4 w = wq[j];
            if (s4 + 4 < 32) wq[j] = ur[P4_CH(s + 4)];
            const f32x4 ga = *(const LAS f32x4*)(gl + 8 * (P4_CH(s) + 2 * kg)), gb = *(const LAS f32x4*)(gl + 8 * (P4_CH(s) + 2 * kg) + 4), ba = *(const LAS f32x4*)(bl + 8 * (P4_CH(s) + 2 * kg)), bb = *(const LAS f32x4*)(bl + 8 * (P4_CH(s) + 2 * kg) + 4);
            float h[8];
            h[0] = (__uint_as_float(w.x << 16) - mean) * rstd * ga.x + ba.x; h[1] = (__uint_as_float(w.x & 0xffff0000u) - mean) * rstd * ga.y + ba.y;
            h[2] = (__uint_as_float(w.y << 16) - mean) * rstd * ga.z + ba.z; h[3] = (__uint_as_float(w.y & 0xffff0000u) - mean) * rstd * ga.w + ba.w;
            h[4] = (__uint_as_float(w.z << 16) - mean) * rstd * gb.x + bb.x; h[5] = (__uint_as_float(w.z & 0xffff0000u) - mean) * rstd * gb.y + bb.y;
            h[6] = (__uint_as_float(w.w << 16) - mean) * rstd * gb.z + bb.z; h[7] = (__uint_as_float(w.w & 0xffff0000u) - mean) * rstd * gb.w + bb.w;
            u32x4 hh, hl;
            hh.x = pk2(h[0], h[1]); hh.y = pk2(h[2], h[3]); hh.z = pk2(h[4], h[5]); hh.w = pk2(h[6], h[7]);
            hl.x = pk2(h[0] - __uint_as_float(hh.x << 16), h[1] - __uint_as_float(hh.x & 0xffff0000u)); hl.y = pk2(h[2] - __uint_as_float(hh.y << 16), h[3] - __uint_as_float(hh.y & 0xffff0000u));
            hl.z = pk2(h[4] - __uint_as_float(hh.z << 16), h[5] - __uint_as_float(hh.z & 0xffff0000u)); hl.w = pk2(h[6] - __uint_as_float(hh.w << 16), h[7] - __uint_as_float(hh.w & 0xffff0000u));
            const bf16x8 bh = __builtin_bit_cast(bf16x8, hh), bl = __builtin_bit_cast(bf16x8, hl);
            const unsigned co = 16u * ((unsigned)(P4_CH(s) + 2 * kg) ^ (unsigned)tok);
#pragma unroll
            for (int eh = 0; eh < 2; ++eh) {
                const bf16x8 wh = *(const LAS bf16x8*)(wimg + eh * 32768 + co), wl = *(const LAS bf16x8*)(wimg + 65536 + eh * 32768 + co);
                acc[eh] = __builtin_amdgcn_mfma_f32_16x16x32_bf16(wh, bh, acc[eh], 0, 0, 0);
                acc[eh] = __builtin_amdgcn_mfma_f32_16x16x32_bf16(wl, bh, acc[eh], 0, 0, 0);
                acc[eh] = __builtin_amdgcn_mfma_f32_16x16x32_bf16(wh, bl, acc[eh], 0, 0, 0);
            }
        }
#if defined(MEAS_P4)
        if (MEAS_P4 == 2 && F.wave == 0 && lane == 0) ((volatile LAS unsigned*)(F.lds + MISC_OFF))[16] += (unsigned)(__builtin_amdgcn_s_memrealtime() - tq0_);
#endif
        float lg[8];
#pragma unroll
        for (int eh = 0; eh < 2; ++eh)
#pragma unroll
            for (int r = 0; r < 4; ++r) lg[eh * 4 + r] = acc[eh][r] + rb[16 * eh + 4 * kg + r];
        unsigned used = 0u; float tv[4]; int ti[4];
#pragma unroll
        for (int k = 0; k < 4; ++k) {
            float best = -INFINITY; int bi = 1 << 20;
#pragma unroll
            for (int j = 0; j < 8; ++j) { const int e = 16 * (j >> 2) + 4 * kg + (j & 3); const bool ok = !((used >> j) & 1u) && (lg[j] > best || (lg[j] == best && e < bi)); best = ok ? lg[j] : best; bi = ok ? e : bi; }
#pragma unroll
            for (int off = 16; off <= 32; off <<= 1) { const float ov = __shfl_xor(best, off); const int oi = __shfl_xor(bi, off); const bool tk = ov > best || (ov == best && oi < bi); best = tk ? ov : best; bi = tk ? oi : bi; }
            tv[k] = best; ti[k] = bi;
#pragma unroll
            for (int j = 0; j < 8; ++j) { const int e = 16 * (j >> 2) + 4 * kg + (j & 3); if (e == bi) used |= 1u << j; }
        }
        const float e1 = __expf(tv[1] - tv[0]), e2 = __expf(tv[2] - tv[0]), e3 = __expf(tv[3] - tv[0]);
        const float inv = 1.f / (1.f + e1 + e2 + e3);
        {
            const int me = kg == 0 ? ti[0] : kg == 1 ? ti[1] : kg == 2 ? ti[2] : ti[3];
            const float mg = (kg == 0 ? 1.f : kg == 1 ? e1 : kg == 2 ? e2 : e3) * inv;
            const int pos = __hip_atomic_fetch_add(lcnt + me, 1, __ATOMIC_RELAXED, __HIP_MEMORY_SCOPE_WORKGROUP);
            ent_e[tl * 4 + kg] = me; ent_p[tl * 4 + kg] = pos; GATE[t * 4 + kg] = mg;
        }
        __syncthreads();
        if (F.tid() < 32) lbase[F.tid()] = atomicAdd(CNT + F.tid(), lcnt[F.tid()]);
        __syncthreads();
        { const int e = ent_e[F.tid()]; LIST[(size_t)e * NTOK + lbase[e] + ent_p[F.tid()]] = (batch * 128 + (F.tid() >> 2)) * 4 + (F.tid() & 3); }
    }
}

#undef P4_CH
__device__ __forceinline__ void p7_final(const Frame& F, const Args& a) {
    const u16* U = (const u16*)(a.ws + WS_U); const unsigned char* YS = a.ws + WS_YS; const float* g1 = a.in[11]; const float* b1 = a.in[12]; const float* g2 = a.in[19]; const float* b2 = a.in[20];
    const int lane = lane_id(), gw = F.bid * NWAVES + F.wave, NGW = F.G * NWAVES;
    typedef float f32x2 __attribute__((ext_vector_type(2)));
    for (int t = gw; t < NTOK; t += NGW) {
        float v[16]; float s = 0.f;
        unsigned y[4][4];
#pragma unroll
        for (int k = 0; k < 4; ++k)
#pragma unroll
            for (int j = 0; j < 4; ++j) y[k][j] = ((const unsigned*)(YS + ((size_t)t * 4 + k) * DM) + lane)[64 * j];
#pragma unroll
        for (int j = 0; j < 4; ++j) { const u32x2 w = ((const u32x2*)(U + (size_t)t * DM) + lane)[64 * j];
            v[4 * j] = __uint_as_float(w.x << 16); v[4 * j + 1] = __uint_as_float(w.x & 0xffff0000u); v[4 * j + 2] = __uint_as_float(w.y << 16); v[4 * j + 3] = __uint_as_float(w.y & 0xffff0000u);
            s += (v[4 * j] + v[4 * j + 1]) + (v[4 * j + 2] + v[4 * j + 3]); }
        { const float mean1 = wave_sum(s) * (1.f / DM); float q = 0.f;
#pragma unroll
          for (int i = 0; i < 16; ++i) { v[i] -= mean1; q += v[i] * v[i]; }
          const float rstd1 = 1.f / sqrtf(wave_sum(q) * (1.f / DM) + LN_EPS);
          s = 0.f;
#pragma unroll
          for (int j = 0; j < 4; ++j) {
              const f32x4 gg = ((const f32x4*)g1)[lane + 64 * j], bb = ((const f32x4*)b1)[lane + 64 * j];
              float a0 = 0.f, a1 = 0.f, a2 = 0.f, a3 = 0.f;
#pragma unroll
              for (int k = 0; k < 4; ++k) {
                  const f32x2 lo = __builtin_amdgcn_cvt_pk_f32_fp8((int)y[k][j], false), hi = __builtin_amdgcn_cvt_pk_f32_fp8((int)y[k][j], true);
                  a0 += lo.x; a1 += lo.y; a2 += hi.x; a3 += hi.y;
              }
              a0 = fmaf(a0, 1.0f / 64.0f, DN_ALPHA * (v[4 * j] * rstd1 * gg.x + bb.x)); a1 = fmaf(a1, 1.0f / 64.0f, DN_ALPHA * (v[4 * j + 1] * rstd1 * gg.y + bb.y));
              a2 = fmaf(a2, 1.0f / 64.0f, DN_ALPHA * (v[4 * j + 2] * rstd1 * gg.z + bb.z)); a3 = fmaf(a3, 1.0f / 64.0f, DN_ALPHA * (v[4 * j + 3] * rstd1 * gg.w + bb.w));
              v[4 * j] = a0; v[4 * j + 1] = a1; v[4 * j + 2] = a2; v[4 * j + 3] = a3; s += (a0 + a1) + (a2 + a3);
          } }
        const float mean = wave_sum(s) * (1.f / DM); float s2 = 0.f;
#pragma unroll
        for (int i = 0; i < 16; ++i) { v[i] -= mean; s2 += v[i] * v[i]; }
        const float rstd = 1.f / sqrtf(wave_sum(s2) * (1.f / DM) + LN_EPS);
        f32x4* o = (f32x4*)(a.out + (size_t)t * DM) + lane;
#pragma unroll
        for (int j = 0; j < 4; ++j) {
            const f32x4 gg = ((const f32x4*)g2)[lane + 64 * j], bb = ((const f32x4*)b2)[lane + 64 * j];
            o[64 * j] = (f32x4){v[4 * j] * rstd * gg.x + bb.x, v[4 * j + 1] * rstd * gg.y + bb.y, v[4 * j + 2] * rstd * gg.z + bb.z, v[4 * j + 3] * rstd * gg.w + bb.w};
        }
    }
}


namespace att {
typedef float f32x16 __attribute__((ext_vector_type(16)));
typedef short s16x4 __attribute__((ext_vector_type(4)));
typedef short v4i16_t __attribute__((ext_vector_type(4)));
constexpr int KV_BUF = 32768, X_OFF = 65536, WSF_OFF = TAB_OFF, TBL_OFF = TAB_OFF + 2048;
constexpr float THR = 6.0f;
constexpr int DONE_OFF = TAB_OFF + 2048 + 4 * 1280 * 4;
__device__ __forceinline__ int crow(int r, int hi) { return (r & 3) + 8 * (r >> 2) + 4 * hi; }
__device__ __forceinline__ unsigned cvtpk(float lo, float hi) { typedef float f2 __attribute__((ext_vector_type(2))); typedef __bf16 b2 __attribute__((ext_vector_type(2))); f2 v = {lo, hi}; b2 b = __builtin_convertvector(v, b2); return __builtin_bit_cast(unsigned, b); }
__device__ __forceinline__ s16x4 vtr(LAS const unsigned char* p) { return __builtin_bit_cast(s16x4, __builtin_amdgcn_ds_read_tr16_b64_v4i16((LAS v4i16_t*)p)); }
__device__ __forceinline__ float swapmax(float m) { auto rr = __builtin_amdgcn_permlane32_swap(__float_as_uint(m), __float_as_uint(m), false, false); return fmaxf(__uint_as_float(rr[0]), __uint_as_float(rr[1])); }
__device__ __forceinline__ float swapsum(float m) { auto rr = __builtin_amdgcn_permlane32_swap(__float_as_uint(m), __float_as_uint(m), false, false); return __uint_as_float(rr[0]) + __uint_as_float(rr[1]); }

__device__ __forceinline__ void glds16(const void* g, unsigned lds_base) {
    unsigned sv; asm volatile("s_mov_b32 %0, m0\n\ts_mov_b32 m0, %2\n\ts_nop 0\n\tglobal_load_lds_dwordx4 %1, off\n\ts_mov_b32 m0, %0" : "=&s"(sv) : "v"(g), "s"(lds_base) : "memory"); }

template <bool ISA>
__device__ __forceinline__ void attn_unit(const Frame& F, const u16* QKV, u16* O, int b, int hx, int jq, float lam, const float* subg, const float* relb, const float* KN, int* qnext, volatile LAS int* qslot) {
    constexpr int DVB = ISA ? 4 : 2;
#ifdef MEAS_ATT
    const unsigned long long tu0_ = __builtin_amdgcn_s_memrealtime();
#endif
    const int lane = lane_id(), w = F.wave, sub = w >> 2, rg = w & 3, r32 = lane & 31, hi = lane >> 5;
    const int q0 = jq * 128, cq = 2 * jq + (rg >> 1);
    const int qpos = q0 + rg * 32 + r32;
    const size_t tok0 = (size_t)b * SEQ;
    const int qcol = (ISA ? hx * 128 : 1536 + hx * 128) + sub * 64;
    const int kcol0 = ISA ? 512 + hx * 128 : 2048 + hx * 128, vcol0 = ISA ? 1024 + hx * 128 : 2560 + hx * 128;
    const int ktop = 2 * jq + 1, kbot = ISA ? 0 : (2 * jq - 8 > 0 ? 2 * jq - 8 : 0);
    const int NTs = ktop - kbot + 1;
    LAS unsigned char* lds = F.lds;
    unsigned soff[2];
#pragma unroll
    for (int i = 0; i < 2; ++i) { const unsigned row = 4u * (8u * i + w) + (lane >> 4); const unsigned f = ((row & 3u) << 2) | ((row >> 2) & 3u); soff[i] = row * (QKVP * 2) + (((unsigned)lane & 15u) ^ f) * 16u; }
    const char* kvbase = (const char*)QKV + (tok0 * QKVP + kcol0) * 2;
    const unsigned ldsw = (unsigned)(w & 3) * 1024u;
    const unsigned ldsb0 = (unsigned)(unsigned long)lds;
#define ATT_ISSUE(kt, buf) do { if (w < 4) { const char* kb_ = kvbase + (size_t)(kt) * 64 * QKVP * 2; const char* vb_ = kb_ + (vcol0 - kcol0) * 2; \
        _Pragma("unroll") for (int i_ = 0; i_ < 2; ++i_) _Pragma("unroll") for (int h_ = 0; h_ < 2; ++h_) { \
            glds16(kb_ + soff[i_] + h_ * 16 * QKVP * 2, (unsigned)__builtin_amdgcn_readfirstlane((int)(ldsb0 + (unsigned)(buf) * KV_BUF + i_ * 8192 + h_ * 4096 + ldsw))); \
            glds16(vb_ + soff[i_] + h_ * 16 * QKVP * 2, (unsigned)__builtin_amdgcn_readfirstlane((int)(ldsb0 + (unsigned)(buf) * KV_BUF + 16384 + i_ * 8192 + h_ * 4096 + ldsw))); } } } while (0)
    ATT_ISSUE(ktop, 0);
    if (NTs > 1) ATT_ISSUE(ktop - 1, 1);
    bf16x8 qf[4];
    { const u16* qp = QKV + (tok0 + q0 + rg * 32 + r32) * QKVP + qcol + 8 * hi;
#pragma unroll
      for (int s = 0; s < 4; ++s) qf[s] = *(const bf16x8*)(qp + 16 * s); }
    const unsigned fr_ = ((r32 & 3u) << 2) | ((r32 >> 2) & 3u);
    unsigned kad[4];
#pragma unroll
    for (int s = 0; s < 4; ++s) kad[s] = 256u * r32 + 16u * ((8u * sub + 2u * s + hi) ^ fr_);
    const unsigned qd = (lane & 15) >> 2, pd = lane & 3, blk = (lane >> 4) & 1, xlow = 2 * blk + (pd >> 1);
    unsigned vad[DVB][2];
#pragma unroll
    for (int c = 0; c < DVB; ++c)
#pragma unroll
        for (int t = 0; t < 2; ++t) { const unsigned ci = ISA ? (unsigned)c : (unsigned)(2 * sub + c);
            vad[c][t] = 2048u * t + 256u * (4u * hi + qd) + 64u * (ci ^ qd) + 16u * (xlow ^ ((2u * t + hi) & 3u)) + 8u * (pd & 1u); }
    const float sl2 = ISA ? exp2f(-2.0f * (float)(hx + 1)) * LOG2E : 0.f;
    LAS float* wsf = (LAS float*)(lds + WSF_OFF) + w * 64;
    float mrun = -INFINITY, lrun = 0.f;
    float sfxv = 0.f;
    LAS int* donecnt = (LAS int*)(lds + DONE_OFF);
    bool wdone = false; float mlow = INFINITY;
    float knl = 0.f;
    if (ISA) {
        knl = (lane <= ktop) ? KN[((size_t)b * 64 + lane) * 8 + hx * 2 + sub] : 0.f;
        if (w == 0 && lane < 3) donecnt[lane] = 0;
    }
#define ATT_BOUND() do { float qq = 0.f; \
        _Pragma("unroll") for (int s = 0; s < 4; ++s) _Pragma("unroll") for (int j = 0; j < 8; ++j) { const float x = bf2f((u16)qf[s][j]); qq = fmaf(x, x, qq); } \
        qq = swapsum(qq); \
        _Pragma("unroll") for (int o_ = 1; o_ < 32; o_ <<= 1) qq = fmaxf(qq, __shfl_xor(qq, o_)); \
        float kn = knl; \
        _Pragma("unroll") for (int o_ = 1; o_ < 64; o_ <<= 1) { const float t_ = __shfl_up(kn, o_); if (lane >= o_) kn = fmaxf(kn, t_); } \
        sfxv = sqrtf(qq * kn) * 1.02f; } while (0)
    f32x16 o[DVB];
#pragma unroll
    for (int c = 0; c < DVB; ++c)
#pragma unroll
        for (int r = 0; r < 16; ++r) o[c][r] = 0.f;

    int buf = 0;
#ifdef MEAS_ATT
    if (MEAS_ATT == 7 && w == MEAS_W && lane == 0) ((volatile LAS unsigned*)(lds + MISC_OFF))[16] += (unsigned)(__builtin_amdgcn_s_memrealtime() - tu0_);
#endif
    for (int i = 0; i < NTs; ++i) {
        const int kt = ktop - i;
        const int nbuf = buf == 2 ? 0 : buf + 1;
#ifdef MEAS_ATT
        const unsigned long long ta_ = __builtin_amdgcn_s_memrealtime();
#endif
        if (i + 1 < NTs) asm volatile("s_waitcnt vmcnt(8)" ::: "memory"); else asm volatile("s_waitcnt vmcnt(0)" ::: "memory");
#ifdef MEAS_ATT
        const unsigned long long tb_ = __builtin_amdgcn_s_memrealtime();
#endif
        __syncthreads();
#ifdef MEAS_ATT
        const unsigned long long tc_ = __builtin_amdgcn_s_memrealtime();
        if (w == MEAS_W && lane == 0) { if (MEAS_ATT == 1) ((volatile LAS unsigned*)(lds + MISC_OFF))[16] += (unsigned)(tb_ - ta_); if (MEAS_ATT == 2) ((volatile LAS unsigned*)(lds + MISC_OFF))[16] += (unsigned)(tc_ - tb_); }
#endif
        LAS const unsigned char* kbuf = lds + buf * KV_BUF; LAS const unsigned char* vbuf = kbuf + 16384;
        bf16x8 kf0[4], kf1[4];
#pragma unroll
        for (int s = 0; s < 4; ++s) { kf0[s] = *(const LAS bf16x8*)(kbuf + kad[s]); kf1[s] = *(const LAS bf16x8*)(kbuf + kad[s] + 8192); }
        int dcnt = 0;
        if (ISA) { if (i > 0) dcnt = donecnt[(i - 1) % 3];
                   if (w == 0 && lane == 0) donecnt[(i + 1) % 3] = 0; }
        bool active = ISA ? (kt <= cq) : (kt <= cq && kt >= cq - 8);
        if (ISA && active && !wdone && kt < cq) {
            const float bnd = __int_as_float(__builtin_amdgcn_readlane(__float_as_int(sfxv), kt)) + sl2 * (float)(kt * 64 + 63 - (q0 + rg * 32)) - mlow;
            if (bnd < -150.0f) wdone = true;
        }
        if (ISA && wdone) { active = false; if (lane == 0) __hip_atomic_fetch_add(donecnt + (i % 3), 1, __ATOMIC_RELAXED, __HIP_MEMORY_SCOPE_WORKGROUP); }
        if (active) {
            f32x16 p0, p1;
#pragma unroll
            for (int r = 0; r < 16; ++r) { p0[r] = 0.f; p1[r] = 0.f; }
#pragma unroll
            for (int s = 0; s < 4; ++s) {
                p0 = __builtin_amdgcn_mfma_f32_32x32x16_bf16(kf0[s], qf[s], p0, 0, 0, 0);
                p1 = __builtin_amdgcn_mfma_f32_32x32x16_bf16(kf1[s], qf[s], p1, 0, 0, 0);
            }
#ifdef MEAS_ATT
            __builtin_amdgcn_sched_barrier(0);
            const unsigned long long t1_ = __builtin_amdgcn_s_memrealtime();
            __builtin_amdgcn_sched_barrier(0);
            if (MEAS_ATT == 4 && w == MEAS_W && lane == 0) ((volatile LAS unsigned*)(lds + MISC_OFF))[16] += (unsigned)(t1_ - tc_);
#endif
            constexpr int NPV = DVB * 4, VPF = 6;
            s16x4 vlo[VPF], vhi[VPF];
#pragma unroll
            for (int j = 0; j < VPF; ++j) { vlo[j] = vtr(vbuf + vad[j >> 2][0] + 4096 * (j & 3)); vhi[j] = vtr(vbuf + vad[j >> 2][1] + 4096 * (j & 3)); }
            if (ISA) {
                const float dl = (float)(kt * 64 + 4 * hi - qpos);
#pragma unroll
                for (int r = 0; r < 16; ++r) { const float kc = (float)((r & 3) + 8 * (r >> 2)); p0[r] = fmaf(-sl2, fabsf(dl + kc), p0[r]); p1[r] = fmaf(-sl2, fabsf(dl + kc + 32.0f), p1[r]); }
            } else {
                LAS const float* tb = (LAS const float*)(lds + TBL_OFF) + hx * 1280 + sub * 640 + (qpos + 64 - kt * 64 - 4 * hi - 63);
#pragma unroll
                for (int r = 0; r < 16; ++r) { const int kc = (r & 3) + 8 * (r >> 2); p0[r] += tb[63 - kc]; p1[r] += tb[63 - 32 - kc]; }
            }
            float mx = fmaxf(p0[0], p1[0]);
#pragma unroll
            for (int r = 1; r < 16; ++r) mx = fmaxf(mx, fmaxf(p0[r], p1[r]));
            const float mt = swapmax(mx);
            if (__any(mt > mrun + THR)) {
                const float mnew = fmaxf(mrun, mt), alpha = __builtin_amdgcn_exp2f(mrun - mnew);
                lrun *= alpha; mrun = mnew;
                if (ISA) { float ml = mrun;
#pragma unroll
                    for (int o_ = 1; o_ < 32; o_ <<= 1) ml = fminf(ml, __shfl_xor(ml, o_));
                    mlow = ml; }
                if (hi == 0) wsf[r32] = alpha;
#pragma unroll
                for (int r = 0; r < 16; ++r) { const float a_ = wsf[crow(r, hi)];
#pragma unroll
                    for (int c = 0; c < DVB; ++c) o[c][r] *= a_; }
            }
            float ps = 0.f;
#pragma unroll
            for (int r = 0; r < 16; ++r) { p0[r] = __builtin_amdgcn_exp2f(p0[r] - mrun); p1[r] = __builtin_amdgcn_exp2f(p1[r] - mrun); ps += p0[r] + p1[r]; }
            lrun += ps;
            u32x4 pw[4];
#pragma unroll
            for (int q = 0; q < 4; ++q) { pw[0][q] = cvtpk(p0[2 * q], p0[2 * q + 1]); pw[1][q] = cvtpk(p0[8 + 2 * q], p0[8 + 2 * q + 1]); pw[2][q] = cvtpk(p1[2 * q], p1[2 * q + 1]); pw[3][q] = cvtpk(p1[8 + 2 * q], p1[8 + 2 * q + 1]); }
#ifdef MEAS_ATT
            __builtin_amdgcn_sched_barrier(0);
            const unsigned long long t2_ = __builtin_amdgcn_s_memrealtime();
            __builtin_amdgcn_sched_barrier(0);
            if (MEAS_ATT == 5 && w == MEAS_W && lane == 0) ((volatile LAS unsigned*)(lds + MISC_OFF))[16] += (unsigned)(t2_ - t1_);
#endif
#pragma unroll
            for (int j = 0; j < NPV; ++j) {
                const s16x4 lo = vlo[j % VPF], h4 = vhi[j % VPF];
                const bf16x8 vf = (bf16x8){lo[0], lo[1], lo[2], lo[3], h4[0], h4[1], h4[2], h4[3]};
                if (j + VPF < NPV) { const int jn = j + VPF; vlo[j % VPF] = vtr(vbuf + vad[jn >> 2][0] + 4096 * (jn & 3)); vhi[j % VPF] = vtr(vbuf + vad[jn >> 2][1] + 4096 * (jn & 3)); }
                o[j >> 2] = __builtin_amdgcn_mfma_f32_32x32x16_bf16(__builtin_bit_cast(bf16x8, pw[j & 3]), vf, o[j >> 2], 0, 0, 0);
            }
#ifdef MEAS_ATT
            __builtin_amdgcn_sched_barrier(0);
            if (MEAS_ATT == 6 && w == MEAS_W && lane == 0) ((volatile LAS unsigned*)(lds + MISC_OFF))[16] += (unsigned)(__builtin_amdgcn_s_memrealtime() - t2_);
#endif
        }
#ifdef MEAS_ATT
        if (MEAS_ATT == 3 && w == MEAS_W && lane == 0) { asm volatile("s_nop 0" :: "v"(o[0][0]), "v"(o[DVB - 1][15])); ((volatile LAS unsigned*)(lds + MISC_OFF))[16] += (unsigned)(__builtin_amdgcn_s_memrealtime() - tc_); }
#endif
        if (ISA && i == 0) ATT_BOUND();
        if (ISA && __builtin_amdgcn_readfirstlane(dcnt) == 8) break;
        if (i + 2 < NTs) ATT_ISSUE(kt - 2, nbuf == 2 ? 0 : nbuf + 1);
        buf = nbuf;
    }
#ifdef MEAS_ATT
    const unsigned long long tu1_ = __builtin_amdgcn_s_memrealtime();
#endif
    asm volatile("s_waitcnt vmcnt(0)" ::: "memory");
    int pre_ = 0;
    if (F.tid() == 0) pre_ = atomicAdd(qnext, 1);
    float gg[4] = {0.f, 0.f, 0.f, 0.f};
    if (ISA && sub == 0) {
#pragma unroll
        for (int c = 0; c < 4; ++c) gg[c] = subg[32 * c + r32] * (0.8f * 16.0f);
    }
    { const float lt = swapsum(lrun); const float inv = __builtin_amdgcn_rcpf(lt);
      if (hi == 0) wsf[r32] = inv;
#pragma unroll
      for (int r = 0; r < 16; ++r) { const float a_ = wsf[crow(r, hi)];
#pragma unroll
          for (int c = 0; c < DVB; ++c) o[c][r] *= a_; } }
    __syncthreads();
#ifdef MEAS_ATT
    if (MEAS_ATT == 9 && w == MEAS_W && lane == 0) ((volatile LAS unsigned*)(lds + MISC_OFF))[16] += (unsigned)(__builtin_amdgcn_s_memrealtime() - tu1_);
#endif
    if (ISA) {
        LAS f32x4* X4 = (LAS f32x4*)(lds + X_OFF) + rg * 1024;
        if (sub == 1) {
#pragma unroll
            for (int c = 0; c < 4; ++c)
#pragma unroll
                for (int g = 0; g < 4; ++g) X4[(c * 4 + g) * 64 + lane] = (f32x4){o[c][4 * g], o[c][4 * g + 1], o[c][4 * g + 2], o[c][4 * g + 3]};
        }
        __syncthreads();
        if (sub == 0) {
            float ss[16];
#pragma unroll
            for (int r = 0; r < 16; ++r) ss[r] = 0.f;
#pragma unroll
            for (int c = 0; c < 4; ++c)
#pragma unroll
                for (int g = 0; g < 4; ++g) { const f32x4 x = X4[(c * 4 + g) * 64 + lane];
#pragma unroll
                    for (int e = 0; e < 4; ++e) { const int r = 4 * g + e; const float y = o[c][r] - lam * x[e]; o[c][r] = y; ss[r] += y * y; } }
#pragma unroll
            for (int r = 0; r < 16; ++r) {
                float v = ss[r];
                v += __int_as_float(__builtin_amdgcn_update_dpp(0, __float_as_int(v), 0x128, 0xf, 0xf, true));
                v += __int_as_float(__builtin_amdgcn_update_dpp(0, __float_as_int(v), 0x124, 0xf, 0xf, true));
                v += __int_as_float(__builtin_amdgcn_update_dpp(0, __float_as_int(v), 0x122, 0xf, 0xf, true));
                v += __int_as_float(__builtin_amdgcn_update_dpp(0, __float_as_int(v), 0x121, 0xf, 0xf, true));
                v += __int_as_float(__builtin_amdgcn_ds_swizzle(__float_as_int(v), 0x401f));
                ss[r] = __builtin_amdgcn_rsqf(v * (1.0f / 128.0f) + 1e-5f);
            }
            LAS unsigned char* stg = lds + X_OFF + rg * 16384;
            asm volatile("s_waitcnt lgkmcnt(0)" ::: "memory");
#pragma unroll
            for (int c = 0; c < 4; ++c)
#pragma unroll
                for (int r = 0; r < 16; ++r) stg[crow(r, hi) * 128 + 32 * c + r32] = (unsigned char)__builtin_amdgcn_cvt_pk_fp8_f32(pg8::clamp8(o[c][r] * ss[r] * gg[c]), 0.f, 0, false);
            asm volatile("s_waitcnt lgkmcnt(0)" ::: "memory");
            unsigned char* og = (unsigned char*)O + (tok0 + q0 + rg * 32) * DM + hx * 128;
#pragma unroll
            for (int i = 0; i < 4; ++i) { const int row = 8 * i + (lane >> 3), ch = lane & 7; const u32x4 v = *(const LAS u32x4*)(stg + row * 128 + ch * 16); *(u32x4*)(og + (size_t)row * DM + ch * 16) = v; }
        }
    } else {
        LAS unsigned char* stg = lds + X_OFF + w * 4096;
#pragma unroll
        for (int c = 0; c < 2; ++c)
#pragma unroll
            for (int r = 0; r < 16; ++r) stg[crow(r, hi) * 64 + 32 * c + r32] = (unsigned char)__builtin_amdgcn_cvt_pk_fp8_f32(pg8::clamp8(o[c][r] * 16.0f), 0.f, 0, false);
        asm volatile("s_waitcnt lgkmcnt(0)" ::: "memory");
        unsigned char* og = (unsigned char*)O + (tok0 + q0 + rg * 32) * DM + 512 + (2 * hx + sub) * 64;
#pragma unroll
        for (int i = 0; i < 2; ++i) { const int row = 16 * i + (lane >> 2), ch = lane & 3; const u32x4 v = *(const LAS u32x4*)(stg + row * 64 + ch * 16); *(u32x4*)(og + (size_t)row * DM + ch * 16) = v; }
    }
    if (F.tid() == 0) *qslot = pre_;
    __syncthreads();
#ifdef MEAS_ATT
    if (MEAS_ATT == 8 && w == MEAS_W && lane == 0) ((volatile LAS unsigned*)(lds + MISC_OFF))[16] += (unsigned)(__builtin_amdgcn_s_memrealtime() - tu1_);
#endif
#undef ATT_ISSUE
#undef ATT_BOUND
}

__device__ __forceinline__ void p2_attention(const Frame& F, const Args& a) {
    const u16* QKV = (const u16*)(a.ws + WS_QKV); u16* O = (u16*)(a.ws + WS_O); const float* KN = (const float*)(a.ws + WS_KN);
    float d1 = 0.f, d2 = 0.f;
    for (int i = 0; i < 64; ++i) { d1 += a.in[4][i] * a.in[5][i]; d2 += a.in[6][i] * a.in[7][i]; }
    const float lam = expf(d1) - expf(d2) + 0.2f;
    int* Q = (int*)(F.ctl + CW_Q) + 64 * (F.bid & 7); int* CQ = (int*)(F.ctl + CW_CQ);
    volatile LAS int* slot = (volatile LAS int*)(F.lds + MISC_OFF + 128);
    const int b = F.bid & 7;
    constexpr int NCONV = 8, NBATCH_C = (P0_NITEMS - P0_DENSE_ITEMS) / 64;
    { LAS float* tbl = (LAS float*)(F.lds + TBL_OFF); const float* relb = a.in[9];
      for (int i = F.tid(); i < 4 * 1280; i += NTHR) { const int hd2 = i / 640, idx = i % 640; int rel = idx - 64; rel = rel < -256 ? -256 : (rel > 256 ? 256 : rel); tbl[i] = relb[hd2 * 513 + rel + 256] * LOG2E; }
      __syncthreads(); }
    bool att_left = true, conv_left = true;
    const bool conv_first = (F.bid >> 3) < NCONV;
    bool do_conv = conv_first;
    bool have = false;
    while (att_left || conv_left) {
        if (do_conv && conv_left) {
            if (!have) { if (F.tid() == 0) *slot = atomicAdd(CQ, 1); __syncthreads(); }
            const int cb = __builtin_amdgcn_readfirstlane(*slot);
            __syncthreads();
            if (cb >= NBATCH_C) { conv_left = false; do_conv = false; have = false; continue; }
            int pre = 0;
            if (F.tid() == 0) pre = atomicAdd(CQ, 1);
            LAS float* scr = (LAS float*)(F.lds + RING_OFF + F.wave * 8704);
            const int lane = lane_id();
            cvt_batch8(a, P0_DENSE_ITEMS + cb * 64 + F.wave * 8, scr, lane);
            if (F.tid() == 0) *slot = pre;
            __syncthreads();
            have = true;
        } else if (att_left) {
            if (!have) { if (F.tid() == 0) *slot = atomicAdd(Q, 1); __syncthreads(); }
            const int idx = __builtin_amdgcn_readfirstlane(*slot);
            __syncthreads();
            if (idx >= 256) { att_left = false; do_conv = true; have = false; continue; }
            if (idx < 128) {
                const int hxa = idx < 64 ? 3 - (idx & 1) : (idx < 96 ? 1 : 0), jqa = idx < 64 ? 31 - (idx >> 1) : 31 - ((idx - 64) & 31);
                attn_unit<true>(F, QKV, O, b, hxa, jqa, lam, a.in[8], a.in[9], KN, Q, slot);
            } else { const int i2 = idx - 128; attn_unit<false>(F, QKV, O, b, i2 & 3, 31 - (i2 >> 2), lam, a.in[8], a.in[9], KN, Q, slot); }
            have = true;
        } else { do_conv = true; have = false; }
    }
}
}
#ifndef REP_MASK
#define REP_MASK 0
#endif
__global__ void __launch_bounds__(NTHR, 2) mk_fwd(Args args) {
    extern __shared__ __attribute__((aligned(16))) unsigned char lds_raw[];
    Frame F;
    F.lds = (LAS unsigned char*)lds_raw; F.MISC = (volatile LAS unsigned*)(F.lds + MISC_OFF);
    F.wave = __builtin_amdgcn_readfirstlane((int)threadIdx.x >> 6); F.G = gridDim.x; F.bid = blockIdx.x;
    F.ctl = (gu32*)(args.ws + WS_CTL);
    for (int u = F.tid(); u < 256; u += NTHR) ((LAS unsigned*)(F.lds + MISC_OFF))[u] = 0u;
    __syncthreads();
    const int lo = args.ph_lo, hi = args.ph_hi;
    const bool multi = (hi - lo) > 1;
    XcdBarrier bar; bar.bar = (unsigned*)(F.ctl + CW_BAR) + args.li * XCD_BAR_WORDS; bar.x = 0; bar.st = nullptr; bar.wave = F.wave;
    if (multi) bar = xcd_barrier_post((unsigned*)(F.ctl + CW_BAR) + args.li * XCD_BAR_WORDS, F.MISC + 8, F.wave);
#if defined(MEAS_PHASE)
    unsigned long long tp0_ = 0;
#define MEAS_T0() do { tp0_ = __builtin_amdgcn_s_memrealtime(); } while (0)
#define MEAS_T1(k) do { if (MEAS_PHASE == (k) && F.wave == 0 && lane_id() == 0) ((volatile LAS unsigned*)(F.lds + MISC_OFF))[16] += (unsigned)(__builtin_amdgcn_s_memrealtime() - tp0_); } while (0)
#else
#define MEAS_T0() do {} while (0)
#define MEAS_T1(k) do {} while (0)
#endif
#define IN(k) (lo <= (k) && (k) < hi)
#define SEAM(k) do { if (IN(k) && IN((k) + 1)) xcd_barrier(bar); } while (0)
    unsigned char* ws = args.ws;
    if (IN(0)) { MEAS_T0(); p0_prologue(F, args); if (REP_MASK & 1) p0_prologue(F, args); MEAS_T1(0); SEAM(0); }
    if (IN(1)) {
        MEAS_T0();
        PDenseT<false, 0> S; S.A = (const u16*)(ws + WS_H0); S.Bt = (const u16*)(ws + WS_WIN); S.out = (u16*)(ws + WS_QKV); S.H0 = nullptr; S.KN = (float*)(ws + WS_KN); S.ord.init(NTOK, QKVP, F.G, F.bid);
        pg8::gemm_phase(F.lds + RING_OFF, S, F.wave); if (REP_MASK & 2) pg8::gemm_phase(F.lds + RING_OFF, S, F.wave); MEAS_T1(1); SEAM(1);
    }
    if (IN(2)) {
        MEAS_T0(); att::p2_attention(F, args); MEAS_T1(2);
        SEAM(2); }
    if (IN(3)) {
        MEAS_T0();
        PDenseT<true, 1> S; S.A = (const void*)(ws + WS_O); S.Bt = (const void*)(ws + WS_WOUT); S.out = (u16*)(ws + WS_U); S.H0 = (const u16*)(ws + WS_H0); S.KN = nullptr; S.ord.init(NTOK, DM, F.G, F.bid);
        pg8::gemm_phase(F.lds + RING_OFF, S, F.wave); if (REP_MASK & 8) pg8::gemm_phase(F.lds + RING_OFF, S, F.wave); MEAS_T1(3); SEAM(3);
    }
    if (IN(4)) { MEAS_T0(); p4_router(F, args); MEAS_T1(4); SEAM(4); }
    if (IN(5)) {
        MEAS_T0();
        const MoeTab T = moe_tab(F.lds); moe_tables(T, (const int*)(F.ctl + CW_CNT), F.wave);
        PMoe<1> S; S.A = ws + WS_H1Q; S.Bt = ws + WS_W1; S.out = (void*)(ws + WS_ACT); S.list = (const int*)(ws + WS_LIST); S.gate = nullptr; S.bias = args.in[16]; S.T = T; S.c = F.bid; S.ntot = __builtin_amdgcn_readfirstlane(T.tb[NEXP]);
        S.prepare(F.wave);
        pg8::gemm_phase(F.lds + RING_OFF, S, F.wave); if (REP_MASK & 32) pg8::gemm_phase(F.lds + RING_OFF, S, F.wave); MEAS_T1(5); SEAM(5);
    }
    if (IN(6)) {
        MEAS_T0();
        const MoeTab T = moe_tab(F.lds); moe_tables(T, (const int*)(F.ctl + CW_CNT), F.wave);
        PMoe<0> S; S.A = ws + WS_ACT; S.Bt = ws + WS_W2; S.out = (void*)(ws + WS_YS); S.list = (const int*)(ws + WS_LIST); S.gate = (const float*)(ws + WS_GATE); S.bias = args.in[18]; S.T = T; S.c = F.bid; S.ntot = __builtin_amdgcn_readfirstlane(T.tb[NEXP]);
        S.prepare(F.wave);
        pg8::gemm_phase(F.lds + RING_OFF, S, F.wave); if (REP_MASK & 64) pg8::gemm_phase(F.lds + RING_OFF, S, F.wave); MEAS_T1(6); SEAM(6);
    }
    if (IN(7)) { MEAS_T0(); p7_final(F, args); if (REP_MASK & 128) p7_final(F, args); MEAS_T1(7); }
#if (defined(MEAS_P4) || defined(MEAS_ATT) || defined(MEAS_GEPI) || defined(MEAS_P0)) && !defined(MEAS_PHASE)
#define MEAS_PHASE 99
#define MEAS_MUL 4
#endif
#if defined(MEAS_PHASE)
    { __syncthreads(); const unsigned acc_ = ((volatile LAS unsigned*)(F.lds + MISC_OFF))[16]; const unsigned long long t0_ = __builtin_amdgcn_s_memrealtime();
      while (__builtin_amdgcn_s_memrealtime() - t0_ < (unsigned long long)acc_ * MEAS_MUL) __builtin_amdgcn_s_sleep(16); }
#endif
#undef IN
#undef SEAM
}

extern "C" void kernel_launch(void* const* d_in, const int* in_sizes, int n_in, void* d_out, int out_size, void* d_ws, size_t ws_size, hipStream_t stream) {
    static int grid = 0;
    if (grid == 0) {
        if (n_in != 21 || in_sizes[0] != NTOK * DM || out_size != NTOK * DM || ws_size < WS_END) { fprintf(stderr, "kernel_launch: unexpected shapes / workspace (%d inputs, ws %zu)\n", n_in, ws_size); grid = -1; return; }
        int dev = 0, cus = 0, per_cu = 0;
        if (hipGetDevice(&dev) != hipSuccess || hipDeviceGetAttribute(&cus, hipDeviceAttributeMultiprocessorCount, dev) != hipSuccess) { grid = -1; return; }
        if (hipFuncSetAttribute((const void*)mk_fwd, hipFuncAttributeMaxDynamicSharedMemorySize, LDS_BYTES) != hipSuccess) { fprintf(stderr, "kernel_launch: hipFuncSetAttribute failed\n"); grid = -1; return; }
        if (hipOccupancyMaxActiveBlocksPerMultiprocessor(&per_cu, (const void*)mk_fwd, NTHR, LDS_BYTES) != hipSuccess || per_cu < 1) { fprintf(stderr, "kernel_launch: occupancy query says %d blocks per CU\n", per_cu); (void)hipGetLastError(); grid = -1; return; }
        if (cus < 256) { fprintf(stderr, "kernel_launch: needs 256 CUs, device has %d\n", cus); grid = -1; return; }
        grid = 256;
    }
    if (grid < 0) return;
    const float* lq1 = (const float*)d_in[4]; const float* lk1 = (const float*)d_in[5]; const float* lq2 = (const float*)d_in[6]; const float* lk2 = (const float*)d_in[7];
    const float* subg = (const float*)d_in[8]; const float* relb = (const float*)d_in[9];
    char* ws = (char*)d_ws;
    u16* QKV = (u16*)(ws + WS_QKV); u16* O = (u16*)(ws + WS_O);
    (void)hipMemsetAsync(ws + WS_CTL, 0, CTL_BYTES, stream);
    Args a{};
    for (int i = 0; i < 21; ++i) a.in[i] = (const float*)d_in[i];
    a.out = (float*)d_out; a.ws = (unsigned char*)d_ws;
    int nl = 0;
    auto run = [&](int lo, int hi) { a.ph_lo = lo; a.ph_hi = hi; a.li = nl++; hipLaunchKernelGGL(mk_fwd, dim3(grid), dim3(NTHR), LDS_BYTES, stream, a); };
    run(0, 8);
}
```
